# Optimizing an MI355X kernel written in HIP

```python
import jax, jax.numpy as jnp
from jax import lax
import numpy as np

D_MODEL = 1024
BATCH = 8
SEQ = 4096
DEPTH = 1

HEAD_DIM = 64
N_HEADS_DSA = (D_MODEL // 2) // HEAD_DIM
N_HEADS_MOBA = (D_MODEL // 2) // HEAD_DIM
W_DSA = N_HEADS_DSA * HEAD_DIM
W_MOBA = N_HEADS_MOBA * HEAD_DIM
N_IDX_HEADS = 4
IDX_DIM = 64
DSA_TOPK = 256
MOBA_BLOCK = 256
MOBA_TOPK = 3
D_FF = ((8 * D_MODEL // 3 + 255) // 256) * 256
D_PLE = 256
ROPE_THETA = 10000.0
EPS = 1e-6
DSA_Q_BLOCK = 128
MOBA_Q_BLOCK = 16
IN_SPLITS = (W_DSA, HEAD_DIM, HEAD_DIM, N_IDX_HEADS * IDX_DIM, IDX_DIM, N_IDX_HEADS,
             W_MOBA, W_MOBA, W_MOBA)
N_IN = sum(IN_SPLITS)

kernel_name = "hymba_dsa_moba_hybrid_layer"


def rmsnorm(x, g):
    xf = x.astype(jnp.float32)
    y = xf * lax.rsqrt(jnp.mean(xf * xf, axis=-1, keepdims=True) + EPS)
    return (y * g.astype(jnp.float32)).astype(x.dtype)


def layernorm(x, g):
    xf = x.astype(jnp.float32)
    mu = jnp.mean(xf, axis=-1, keepdims=True)
    var = jnp.mean(jnp.square(xf - mu), axis=-1, keepdims=True)
    return ((xf - mu) * lax.rsqrt(var + EPS) * g.astype(jnp.float32)).astype(x.dtype)


def rope(x, pos):
    half = x.shape[-1] // 2
    inv = ROPE_THETA ** (-jnp.arange(half, dtype=jnp.float32) / half)
    ang = pos.astype(jnp.float32)[:, None] * inv[None, :]
    cos = jnp.cos(ang)[:, None, :]
    sin = jnp.sin(ang)[:, None, :]
    x1 = x[..., :half].astype(jnp.float32)
    x2 = x[..., half:].astype(jnp.float32)
    return jnp.concatenate([x1 * cos - x2 * sin, x2 * cos + x1 * sin], axis=-1).astype(x.dtype)


def dsa_attention(q, k, v, q_idx, k_idx, w_idx):
    B, L, H, D = q.shape
    top = min(DSA_TOPK, L // 4)
    n_blocks = L // DSA_Q_BLOCK
    key_pos = jnp.arange(L)
    b_ix = jnp.arange(B)[:, None, None]
    w_s = w_idx.astype(jnp.float32) * (N_IDX_HEADS ** -0.5) * (IDX_DIM ** -0.5)
    scale = D ** -0.5

    def one_block(c):
        t0 = c * DSA_Q_BLOCK
        qb = lax.dynamic_slice_in_dim(q, t0, DSA_Q_BLOCK, axis=1)
        qib = lax.dynamic_slice_in_dim(q_idx, t0, DSA_Q_BLOCK, axis=1)
        wb = lax.dynamic_slice_in_dim(w_s, t0, DSA_Q_BLOCK, axis=1)
        qpos = t0 + jnp.arange(DSA_Q_BLOCK)
        causal = key_pos[None, :] <= qpos[:, None]
        rel = jax.nn.relu(jnp.einsum('bthd,bsd->bths', qib, k_idx).astype(jnp.float32))
        score = jnp.einsum('bth,bths->bts', wb, rel)
        score = jnp.where(causal[None], score, -jnp.inf)
        _, idx = lax.top_k(score, top)
        ks = k[b_ix, idx]
        vs = v[b_ix, idx]
        valid = idx <= qpos[None, :, None]
        logits = jnp.einsum('bthd,btkd->bthk', qb, ks).astype(jnp.float32) * scale
        logits = jnp.where(valid[:, :, None, :], logits, -jnp.inf)
        prob = jax.nn.softmax(logits, axis=-1).astype(v.dtype)
        return jnp.einsum('bthk,btkd->bthd', prob, vs)

    out = lax.map(one_block, jnp.arange(n_blocks))
    return out.transpose(1, 0, 2, 3, 4).reshape(B, L, H, D)


def moba_attention(q, k, v):
    B, L, H, D = q.shape
    nb = -(-L // MOBA_BLOCK)
    pad = nb * MOBA_BLOCK - L
    kp = jnp.pad(k, ((0, 0), (0, pad), (0, 0), (0, 0)))
    vp = jnp.pad(v, ((0, 0), (0, pad), (0, 0), (0, 0)))
    k_blk = kp.reshape(B, nb, MOBA_BLOCK, H, D).transpose(0, 3, 1, 2, 4)
    v_blk = vp.reshape(B, nb, MOBA_BLOCK, H, D).transpose(0, 3, 1, 2, 4)
    k_mean = jnp.mean(k_blk.astype(jnp.float32), axis=3)
    n_sel = min(MOBA_TOPK, nb - 1)
    b_ix = jnp.arange(B)[:, None, None, None]
    h_ix = jnp.arange(H)[None, None, :, None]
    blk_ids = jnp.arange(nb)
    own_off = jnp.arange(MOBA_BLOCK)
    scale = D ** -0.5
    n_chunks = L // MOBA_Q_BLOCK

    def one_chunk(c):
        t0 = c * MOBA_Q_BLOCK
        j = t0 // MOBA_BLOCK
        qb = lax.dynamic_slice_in_dim(q, t0, MOBA_Q_BLOCK, axis=1)
        qpos = t0 + jnp.arange(MOBA_Q_BLOCK)
        k_own = lax.dynamic_slice_in_dim(kp, j * MOBA_BLOCK, MOBA_BLOCK, axis=1)
        v_own = lax.dynamic_slice_in_dim(vp, j * MOBA_BLOCK, MOBA_BLOCK, axis=1)
        own_mask = (j * MOBA_BLOCK + own_off)[None, :] <= qpos[:, None]
        l_own = jnp.einsum('bthd,bshd->bths', qb, k_own).astype(jnp.float32) * scale
        l_own = jnp.where(own_mask[None, :, None, :], l_own, -jnp.inf)
        if n_sel == 0:
            prob = jax.nn.softmax(l_own, axis=-1).astype(v.dtype)
            return jnp.einsum('bths,bshd->bthd', prob, v_own)
        gate = jnp.einsum('bthd,bhnd->bthn', qb.astype(jnp.float32), k_mean)
        gate = jnp.where(blk_ids < j, gate, -jnp.inf)
        _, sel = lax.top_k(gate, n_sel)
        valid = sel < j
        k_sel = k_blk[b_ix, h_ix, sel]
        v_sel = v_blk[b_ix, h_ix, sel]
        l_past = jnp.einsum('bthd,bthnsd->bthns', qb, k_sel).astype(jnp.float32) * scale
        l_past = jnp.where(valid[..., None], l_past, -jnp.inf)
        l_past = l_past.reshape(B, MOBA_Q_BLOCK, H, n_sel * MOBA_BLOCK)
        prob = jax.nn.softmax(jnp.concatenate([l_past, l_own], axis=-1), axis=-1).astype(v.dtype)
        p_past = prob[..., :n_sel * MOBA_BLOCK]
        p_own = prob[..., n_sel * MOBA_BLOCK:]
        v_sel = v_sel.reshape(B, MOBA_Q_BLOCK, H, n_sel * MOBA_BLOCK, D)
        return (jnp.einsum('bthk,bthkd->bthd', p_past, v_sel)
                + jnp.einsum('bths,bshd->bthd', p_own, v_own))

    out = lax.map(one_chunk, jnp.arange(n_chunks))
    return out.transpose(1, 0, 2, 3, 4).reshape(B, L, H, D)


def setup_inputs(seed: int = 0) -> dict:
    key = jax.random.key(seed)
    ks = jax.random.split(key, 16)
    f32 = jnp.float32
    nrm = lambda k, shape, fan_in: jax.random.normal(k, shape, f32) * (fan_in ** -0.5)
    gain = lambda k, n: 1.0 + 0.02 * jax.random.normal(k, (DEPTH, n), f32)
    return {
        "x": jax.random.normal(ks[0], (BATCH, SEQ, D_MODEL), f32),
        "p": jax.random.normal(ks[1], (DEPTH, BATCH, SEQ, D_PLE), f32),
        "g_attn": gain(ks[2], D_MODEL),
        "w_in": nrm(ks[3], (DEPTH, D_MODEL, N_IN), D_MODEL),
        "g_idx_k": gain(ks[4], IDX_DIM),
        "w_out": nrm(ks[5], (DEPTH, W_DSA + W_MOBA, D_MODEL), W_DSA + W_MOBA),
        "g_ffn": gain(ks[6], D_MODEL),
        "w_gate": nrm(ks[7], (DEPTH, D_MODEL, D_FF), D_MODEL),
        "w_up": nrm(ks[8], (DEPTH, D_MODEL, D_FF), D_MODEL),
        "w_down": nrm(ks[9], (DEPTH, D_FF, D_MODEL), D_FF),
        "g_ple": gain(ks[10], D_MODEL),
        "w_ple_gate": nrm(ks[11], (DEPTH, D_MODEL, D_MODEL), D_MODEL),
        "w_ple_proj": nrm(ks[12], (DEPTH, D_PLE, D_MODEL), D_PLE),
        "g_final": 1.0 + 0.02 * jax.random.normal(ks[13], (D_MODEL,), f32),
    }


def reference(x, p, g_attn, w_in, g_idx_k, w_out, g_ffn, w_gate, w_up, w_down,
              g_ple, w_ple_gate, w_ple_proj, g_final):
    B, L, _ = x.shape
    pos = jnp.arange(L)
    offs = [int(o) for o in np.cumsum(IN_SPLITS)[:-1]]
    h = x
    for i in range(DEPTH):
        a = rmsnorm(h, g_attn[i])
        proj = a @ w_in[i]
        qa, ka, va, qi, ki, wi, qb, kb, vb = jnp.split(proj, offs, axis=-1)
        qa = rope(qa.reshape(B, L, N_HEADS_DSA, HEAD_DIM), pos)
        ka = rope(ka.reshape(B, L, 1, HEAD_DIM), pos)[:, :, 0]
        qi = rope(qi.reshape(B, L, N_IDX_HEADS, IDX_DIM), pos)
        ki = rope(layernorm(ki, g_idx_k[i]).reshape(B, L, 1, IDX_DIM), pos)[:, :, 0]
        qb = rope(qb.reshape(B, L, N_HEADS_MOBA, HEAD_DIM), pos)
        kb = rope(kb.reshape(B, L, N_HEADS_MOBA, HEAD_DIM), pos)
        vb = vb.reshape(B, L, N_HEADS_MOBA, HEAD_DIM)
        y_a = dsa_attention(qa, ka, va, qi, ki, wi).reshape(B, L, W_DSA)
        y_b = moba_attention(qb, kb, vb).reshape(B, L, W_MOBA)
        h = h + jnp.concatenate([y_a, y_b], axis=-1) @ w_out[i]
        f = rmsnorm(h, g_ffn[i])
        h = h + (jax.nn.silu(f @ w_gate[i]) * (f @ w_up[i])) @ w_down[i]
        u = rmsnorm(h, g_ple[i])
        h = h + jax.nn.sigmoid(u @ w_ple_gate[i]) * (p[i] @ w_ple_proj[i])
    return rmsnorm(h, g_final)
```

```cpp
#include <hip/hip_runtime.h>
#include <hip/hip_cooperative_groups.h>
#include <cstdio>
#include <cstdint>
namespace cg = cooperative_groups;

#ifndef MK_COOP
#define MK_COOP 1
#endif

#define LAS __attribute__((address_space(3)))
typedef _Float16 h16;
typedef _Float16 h16x8 __attribute__((ext_vector_type(8)));
typedef _Float16 h16x4 __attribute__((ext_vector_type(4)));
typedef _Float16 h16x2 __attribute__((ext_vector_type(2)));
typedef short s16x8 __attribute__((ext_vector_type(8)));
typedef short s16x4 __attribute__((ext_vector_type(4)));
typedef float f32x2 __attribute__((ext_vector_type(2)));
typedef float f32x4 __attribute__((ext_vector_type(4)));
typedef float f32x16 __attribute__((ext_vector_type(16)));
typedef unsigned u32x2 __attribute__((ext_vector_type(2)));
typedef unsigned u32x4 __attribute__((ext_vector_type(4)));

constexpr int BATCH = 8, SEQ = 4096, DM = 1024, NTOK = BATCH * SEQ, NIN = 2560, NIN_SRC = 2500, DFF = 2816, DPLE = 256;
constexpr float EPS = 1e-6f;
constexpr float C2 = 0.125f * 1.4426950408889634f;
constexpr float NEG_INF = -__builtin_huge_valf();

constexpr size_t MiB = 1u << 20;
constexpr size_t WS_WIN = 1 * MiB, WS_WOUT = 6 * MiB, WS_WGU = 8 * MiB, WS_WDN = 19 * MiB, WS_WPG = 25 * MiB, WS_WPP = 27 * MiB;
constexpr size_t WS_ROPE = 28 * MiB, WS_RS0 = 29 * MiB, WS_SSP1 = 30 * MiB, WS_SSP2 = 32 * MiB, WS_SSP3 = 34 * MiB, WS_KMP = 36 * MiB, WS_WI = 37 * MiB;
constexpr size_t WS_PH = 38 * MiB, WS_PP = 54 * MiB, WS_XH = 118 * MiB  , WS_Y = 182 * MiB  ;
constexpr size_t WS_QA = 246 * MiB, WS_KA = 278 * MiB, WS_VA = 282 * MiB, WS_QI = 286 * MiB, WS_KI = 302 * MiB, WS_QB = 306 * MiB, WS_KB = 338 * MiB, WS_VB = 370 * MiB;
constexpr size_t WS_ACT = 246 * MiB  , WS_END = 422 * MiB;

__constant__ float ROPE_INV[32] = {0x1.0000000000000p+0f, 0x1.7ff2220000000p-1f, 0x1.1feb340000000p-1f, 0x1.afd1360000000p-2f, 0x1.43d1360000000p-2f, 0x1.e5a8480000000p-3f, 0x1.6c310e0000000p-3f, 0x1.111aee0000000p-3f,
    0x1.99999a0000000p-4f, 0x1.33281c0000000p-4f, 0x1.ccab860000000p-5f, 0x1.59742a0000000p-5f, 0x1.030dc40000000p-5f, 0x1.8486a00000000p-6f, 0x1.235a720000000p-6f, 0x1.b4f7e20000000p-7f,
    0x1.47ae140000000p-7f, 0x1.eb73600000000p-8f, 0x1.7089380000000p-8f, 0x1.145cee0000000p-8f, 0x1.9e7c6e0000000p-9f, 0x1.36d21a0000000p-9f, 0x1.d22a500000000p-10f, 0x1.5d931c0000000p-10f,
    0x1.0624de0000000p-10f, 0x1.8929180000000p-11f, 0x1.26d42c0000000p-11f, 0x1.ba2e4c0000000p-12f, 0x1.4b96be0000000p-12f, 0x1.f150280000000p-13f, 0x1.74eea60000000p-13f, 0x1.17a8e40000000p-13f};
__device__ __forceinline__ unsigned pkh(float lo, float hi) { h16x2 v = {(h16)lo, (h16)hi}; return __builtin_bit_cast(unsigned, v); }
__device__ __forceinline__ float wave_sum(float v) {
#pragma unroll
    for (int o = 1; o < 64; o <<= 1) v += __shfl_xor(v, o);
    return v;
}
__device__ __forceinline__ float fast_sigmoid(float x) { return __builtin_amdgcn_rcpf(1.0f + __builtin_amdgcn_exp2f(-1.4426950408889634f * x)); }

namespace pg8 {
constexpr int BM = 256, BK = 64, HALF = 128, HTB = HALF * BK * 2, STAGE_BYTES = 8 * HTB, NXCD = 8, WGM = 8;
__host__ __device__ __forceinline__ int lds_byte(int r, int c) { const int st = (r >> 4) * 2 + (c >> 5), rr = r & 15, cc = c & 31, ob = rr * 64 + cc * 2; return st * 1024 + (ob ^ (((ob >> 9) & 1) << 5)); }
__host__ __device__ __forceinline__ void stage_rc(int b, int& R, int& C) { const int st = b / 1024, sb = b % 1024, swz = sb ^ (((sb >> 9) & 1) << 5); R = (st >> 1) * 16 + swz / 64; C = (st & 1) * 32 + (swz % 64) / 2; }
__host__ __device__ __forceinline__ int perm32(int rho) { const int n = rho >> 4, i = rho & 15; return 8 * (i >> 2) + 4 * n + (i & 3); }
struct Unit { int pm, pn; };
struct Gemm { const h16* A; const h16* Bt; int M, N, K; };
struct StaticOrder {
    int nM, nN, nwg, G, c;
    __host__ __device__ void init(int M, int N, int G_, int c_) { nM = M / BM; nN = N / BM; nwg = nM * nN; G = G_; c = c_; }
    __host__ __device__ bool next(int i, Unit& u) const {
        const long L = (long)i * G + c; if (L >= nwg) return false;
        int wgid = (int)L; { const int q = nwg / NXCD, r = nwg % NXCD, xcd = wgid % NXCD, off = wgid / NXCD; wgid = (xcd < r ? xcd * (q + 1) : r * (q + 1) + (xcd - r) * q) + off; }
        const int nig = WGM * nN, gid = wgid / nig, fm = gid * WGM, gsz = (nM - fm) < WGM ? (nM - fm) : WGM;
        u.pm = fm + ((wgid % nig) % gsz); u.pn = (wgid % nig) / gsz; return true;
    }
};
template <class Epi>
__device__ __forceinline__ void gemm_phase(LAS unsigned char* lds, const Gemm g, const StaticOrder& S, const Epi& E) {
    const int tid = threadIdx.x, wid = __builtin_amdgcn_readfirstlane(tid >> 6), lane = tid & 63, wr = wid >> 2, wc = wid & 3, fr = lane & 15, fq = lane >> 4;
    const int K = g.K, nt = K / BK;
    unsigned voffA[2], voffB[2];
#pragma unroll
    for (int i = 0; i < 2; ++i) { int R, C; stage_rc(tid * 16 + i * 8192, R, C); const int Rb = (R & ~31) + perm32(R & 31);
        voffA[i] = (unsigned)(R * K + C) * 2u; voffB[i] = (unsigned)(Rb * K + C) * 2u; }
    const size_t kstep = (size_t)(BK * 2);
    const size_t hstep = (size_t)HALF * K * 2;
    const size_t tstep = 2 * hstep;
    const unsigned ldsw = (unsigned)wid * 1024u;
    const int aoff = lds_byte(wr * 64 + fr, fq * 8), boff = lds_byte(wc * 32 + fr, fq * 8);
#define PG8_SA(b, h) (((b) * 2 + (h)) * HTB)
#define PG8_SB(b, h) ((4 + (b) * 2 + (h)) * HTB)
#define PG8_STAGE(bufoff, gbase, voff) do { _Pragma("unroll") for (int _i = 0; _i < 2; ++_i) \
        __builtin_amdgcn_global_load_lds((const unsigned*)((const char*)(gbase) + (voff)[_i]), (LAS unsigned*)(lds + (bufoff) + ldsw + _i * 8192), 16, 0, 0); } while (0)
#define PG8_LDA(dst, b, h) do { _Pragma("unroll") for (int m = 0; m < 4; ++m) _Pragma("unroll") for (int k = 0; k < 2; ++k) dst[m][k] = *(const LAS s16x8*)(lds + PG8_SA(b, h) + aoff + m * 2048 + k * 1024); } while (0)
#define PG8_LDB(dst, b, h) do { _Pragma("unroll") for (int n = 0; n < 2; ++n) _Pragma("unroll") for (int k = 0; k < 2; ++k) dst[n][k] = *(const LAS s16x8*)(lds + PG8_SB(b, h) + boff + n * 2048 + k * 1024); } while (0)
#define PG8_MMA(ai, bj, At, Bt) do { __builtin_amdgcn_s_setprio(1); _Pragma("unroll") for (int m = 0; m < 4; ++m) _Pragma("unroll") for (int n = 0; n < 2; ++n) _Pragma("unroll") for (int k = 0; k < 2; ++k) \
        acc[ai][bj][m][n] = __builtin_amdgcn_mfma_f32_16x16x32_f16(__builtin_bit_cast(h16x8, Bt[n][k]), __builtin_bit_cast(h16x8, At[m][k]), acc[ai][bj][m][n], 0, 0, 0); __builtin_amdgcn_s_setprio(0); } while (0)
#define PG8_WAIT_V(n) asm volatile("s_waitcnt vmcnt(" #n ")" ::: "memory")
#define PG8_WAIT_L(n) asm volatile("s_waitcnt lgkmcnt(" #n ")" ::: "memory")
#define PG8_BAR __builtin_amdgcn_s_barrier()
#define PG8_SCHED __builtin_amdgcn_sched_barrier(0)
    Unit cur, nxt; int ui = 0;
    if (!S.next(0, cur)) return;
    f32x4 acc[2][2][4][2];
#pragma unroll
    for (int a = 0; a < 2; ++a)
#pragma unroll
        for (int b = 0; b < 2; ++b)
#pragma unroll
            for (int m = 0; m < 4; ++m)
#pragma unroll
                for (int n = 0; n < 2; ++n) acc[a][b][m][n] = (f32x4){0.f, 0.f, 0.f, 0.f};
    s16x8 At[4][2], B0[2][2], B1[2][2];
    const char* cA = (const char*)g.A + (size_t)cur.pm * tstep; const char* cB = (const char*)g.Bt + (size_t)cur.pn * tstep;
    PG8_STAGE(PG8_SB(0, 0), cB, voffB); PG8_STAGE(PG8_SB(0, 1), cB + hstep, voffB); PG8_STAGE(PG8_SA(0, 0), cA, voffA); PG8_STAGE(PG8_SA(0, 1), cA + hstep, voffA);
    if (wr == 1) PG8_BAR;
    PG8_WAIT_V(2); PG8_BAR;
    PG8_STAGE(PG8_SB(1, 0), cB + kstep, voffB); PG8_STAGE(PG8_SA(1, 0), cA + kstep, voffA); PG8_STAGE(PG8_SB(1, 1), cB + hstep + kstep, voffB);
    PG8_WAIT_V(6); PG8_BAR;
    for (;;) {
        const bool has_next = S.next(ui + 1, nxt);
        const char* nA = has_next ? (const char*)g.A + (size_t)nxt.pm * tstep : cA; const char* nB = has_next ? (const char*)g.Bt + (size_t)nxt.pn * tstep : cB;
#pragma unroll 1
        for (int t = 0; t < nt; t += 2) {
            const bool last = (t == nt - 2);
            const char* a1 = cA + (size_t)(t + 1) * kstep;
            const char* a2 = last ? nA : cA + (size_t)(t + 2) * kstep; const char* b2 = last ? nB : cB + (size_t)(t + 2) * kstep;
            const char* a3 = a2 + kstep; const char* b3 = b2 + kstep;
            PG8_LDB(B0, 0, 0); PG8_LDB(B1, 0, 1); PG8_SCHED; PG8_LDA(At, 0, 0); PG8_STAGE(PG8_SA(1, 1), a1 + hstep, voffA);
            PG8_WAIT_V(8); PG8_WAIT_L(0); PG8_BAR; PG8_MMA(0, 0, At, B0); PG8_MMA(0, 1, At, B1); PG8_BAR; PG8_SCHED;
            PG8_LDA(At, 0, 1); PG8_STAGE(PG8_SB(0, 0), b2, voffB); PG8_STAGE(PG8_SB(0, 1), b2 + hstep, voffB); PG8_STAGE(PG8_SA(0, 0), a2, voffA);
            PG8_WAIT_V(8); PG8_WAIT_L(0); PG8_BAR; PG8_MMA(1, 0, At, B0); PG8_MMA(1, 1, At, B1); PG8_BAR; PG8_SCHED;
            PG8_LDB(B0, 1, 0); PG8_LDB(B1, 1, 1); PG8_SCHED; PG8_LDA(At, 1, 0); PG8_STAGE(PG8_SA(0, 1), a2 + hstep, voffA);
            PG8_WAIT_V(8); PG8_WAIT_L(0); PG8_BAR; PG8_MMA(0, 0, At, B0); PG8_MMA(0, 1, At, B1); PG8_BAR; PG8_SCHED;
            PG8_LDA(At, 1, 1); PG8_STAGE(PG8_SB(1, 0), b3, voffB); PG8_STAGE(PG8_SB(1, 1), b3 + hstep, voffB); PG8_STAGE(PG8_SA(1, 0), a3, voffA);
            PG8_WAIT_V(8); PG8_WAIT_L(0); PG8_BAR; PG8_MMA(1, 0, At, B0); PG8_MMA(1, 1, At, B1); PG8_BAR; PG8_SCHED;
        }
        if (wr == 0) PG8_BAR;
        E(acc, cur, wr, wc, fr, fq);
        if (!has_next) break;
#pragma unroll
        for (int a = 0; a < 2; ++a)
#pragma unroll
            for (int b = 0; b < 2; ++b)
#pragma unroll
                for (int m = 0; m < 4; ++m)
#pragma unroll
                    for (int n = 0; n < 2; ++n) acc[a][b][m][n] = (f32x4){0.f, 0.f, 0.f, 0.f};
        cur = nxt; cA = nA; cB = nB; ++ui;
        if (wr == 1) PG8_BAR;
    }
    PG8_WAIT_V(0);
    PG8_BAR;
#undef PG8_SA
#undef PG8_SB
#undef PG8_STAGE
#undef PG8_LDA
#undef PG8_LDB
#undef PG8_MMA
#undef PG8_WAIT_V
#undef PG8_WAIT_L
#undef PG8_BAR
#undef PG8_SCHED
}

typedef const f32x4 (&AccRef)[2][2][4][2];

struct EpiPlain {
    h16* O; int ldc;
    __device__ __forceinline__ void operator()(AccRef acc, const Unit& u, int wr, int wc, int fr, int fq) const {
        const int row0 = u.pm * BM + wr * 64 + fr, col0 = u.pn * BM + wc * 32 + 8 * fq;
#pragma unroll
        for (int ai = 0; ai < 2; ++ai)
#pragma unroll
            for (int m = 0; m < 4; ++m) { h16* rowp = O + (size_t)(row0 + ai * HALF + m * 16) * ldc + col0;
#pragma unroll
                for (int bj = 0; bj < 2; ++bj) { const f32x4 v0 = acc[ai][bj][m][0], v1 = acc[ai][bj][m][1];
                    u32x4 w; w.x = pkh(v0[0], v0[1]); w.y = pkh(v0[2], v0[3]); w.z = pkh(v1[0], v1[1]); w.w = pkh(v1[2], v1[3]);
                    *(u32x4*)(rowp + bj * HALF) = w; } }
    }
};

struct EpiInProj {
    const float* rs0; const float* rope; const float* gidx;
    h16 *QA, *KA, *VA, *QI, *KI, *QB, *KB, *VB; float* WI; float* kmp;
    __device__ __forceinline__ void operator()(AccRef acc, const Unit& u, int wr, int wc, int fr_in, int fq_in) const {
        int fr = fr_in, fq = fq_in; asm volatile("" : "+v"(fr), "+v"(fq));
        const int pn = u.pn;
        int type = 0; h16* dst = VA; int pitch = 64, cb = 0; float scl = 1.f; bool iskb = false;
        if (pn < 2) { type = 1; dst = QA; pitch = 512; cb = 256 * pn + 64 * wc; scl = C2; }
        else if (pn == 2) { if (wc == 0) { type = 1; dst = KA; } else if (wc == 1) { type = 0; dst = VA; } else if (wc == 2) { type = 2; dst = KI; } else { type = 3; } }
        else if (pn == 3) { type = 1; dst = QI; pitch = 256; cb = 64 * wc; }
        else if (pn < 6) { type = 1; dst = QB; pitch = 512; cb = 256 * (pn - 4) + 64 * wc; scl = C2; }
        else if (pn < 8) { type = 1; dst = KB; pitch = 512; cb = 256 * (pn - 6) + 64 * wc; iskb = true; }
        else { type = 0; dst = VB; pitch = 512; cb = 256 * (pn - 8) + 64 * wc; }
        float ks[2][2][4];
#pragma unroll
        for (int bj = 0; bj < 2; ++bj)
#pragma unroll
            for (int n = 0; n < 2; ++n)
#pragma unroll
                for (int e = 0; e < 4; ++e) ks[bj][n][e] = 0.f;
        float gl[2][2][4];
        if (type == 2) {
#pragma unroll
            for (int bj = 0; bj < 2; ++bj)
#pragma unroll
                for (int n = 0; n < 2; ++n)
#pragma unroll
                    for (int e = 0; e < 4; ++e) gl[bj][n][e] = gidx[32 * bj + 8 * fq + 4 * n + e];
        }
#pragma unroll
        for (int ai = 0; ai < 2; ++ai)
#pragma unroll
            for (int m = 0; m < 4; ++m) {
                const int row = u.pm * BM + ai * HALF + wr * 64 + m * 16 + fr;
                const float s = rs0[row];
                float v[2][2][4];
#pragma unroll
                for (int bj = 0; bj < 2; ++bj)
#pragma unroll
                    for (int n = 0; n < 2; ++n)
#pragma unroll
                        for (int e = 0; e < 4; ++e) v[bj][n][e] = acc[ai][bj][m][n][e] * s;
                if (type == 3) {
                    if (fq == 0) *(f32x4*)(WI + (size_t)row * 4) = (f32x4){v[0][0][0] * 0.0625f, v[0][0][1] * 0.0625f, v[0][0][2] * 0.0625f, v[0][0][3] * 0.0625f};
                    continue;
                }
                if (type == 2) {
                    float sum = 0.f;
#pragma unroll
                    for (int bj = 0; bj < 2; ++bj)
#pragma unroll
                        for (int n = 0; n < 2; ++n)
#pragma unroll
                            for (int e = 0; e < 4; ++e) sum += v[bj][n][e];
                    sum += __shfl_xor(sum, 16); sum += __shfl_xor(sum, 32);
                    const float mean = sum * (1.f / 64.f); float q = 0.f;
#pragma unroll
                    for (int bj = 0; bj < 2; ++bj)
#pragma unroll
                        for (int n = 0; n < 2; ++n)
#pragma unroll
                            for (int e = 0; e < 4; ++e) { v[bj][n][e] -= mean; q += v[bj][n][e] * v[bj][n][e]; }
                    q += __shfl_xor(q, 16); q += __shfl_xor(q, 32);
                    const float rstd = 1.0f / sqrtf(q * (1.f / 64.f) + EPS);
#pragma unroll
                    for (int bj = 0; bj < 2; ++bj)
#pragma unroll
                        for (int n = 0; n < 2; ++n)
#pragma unroll
                            for (int e = 0; e < 4; ++e) v[bj][n][e] = v[bj][n][e] * rstd * gl[bj][n][e];
                }
                if (type >= 1) {
                    const int pos = row & (SEQ - 1);
                    const f32x4* cs = (const f32x4*)(rope + ((size_t)pos * 32 + 8 * fq) * 2);
#pragma unroll
                    for (int n = 0; n < 2; ++n) { const f32x4 c01 = cs[2 * n], c23 = cs[2 * n + 1];
                        const float cc[4] = {c01[0], c01[2], c23[0], c23[2]}, sn[4] = {c01[1], c01[3], c23[1], c23[3]};
#pragma unroll
                        for (int e = 0; e < 4; ++e) { const float lo = v[0][n][e], hi = v[1][n][e]; v[0][n][e] = lo * cc[e] - hi * sn[e]; v[1][n][e] = hi * cc[e] + lo * sn[e]; } }
                }
#pragma unroll
                for (int bj = 0; bj < 2; ++bj) {
#pragma unroll
                    for (int n = 0; n < 2; ++n)
#pragma unroll
                        for (int e = 0; e < 4; ++e) { v[bj][n][e] *= scl; ks[bj][n][e] += v[bj][n][e]; }
                    u32x4 w; w.x = pkh(v[bj][0][0], v[bj][0][1]); w.y = pkh(v[bj][0][2], v[bj][0][3]); w.z = pkh(v[bj][1][0], v[bj][1][1]); w.w = pkh(v[bj][1][2], v[bj][1][3]);
                    *(u32x4*)(dst + (size_t)row * pitch + cb + 32 * bj + 8 * fq) = w;
                }
                __builtin_amdgcn_sched_barrier(0);
            }
        if (iskb) {
#pragma unroll
            for (int bj = 0; bj < 2; ++bj)
#pragma unroll
                for (int n = 0; n < 2; ++n)
#pragma unroll
                    for (int e = 0; e < 4; ++e) { float t = ks[bj][n][e]; t += __shfl_xor(t, 1); t += __shfl_xor(t, 2); t += __shfl_xor(t, 4); t += __shfl_xor(t, 8); ks[bj][n][e] = t; }
            if (fr == 0) { const int head = 4 * (pn - 6) + wc; float* o = kmp + (((size_t)u.pm * 2 + wr) * 8 + head) * 64;
#pragma unroll
                for (int bj = 0; bj < 2; ++bj)
#pragma unroll
                    for (int n = 0; n < 2; ++n) *(f32x4*)(o + 32 * bj + 8 * fq + 4 * n) = (f32x4){ks[bj][n][0], ks[bj][n][1], ks[bj][n][2], ks[bj][n][3]}; }
        }
    }
};

template <bool BASE_F32> struct EpiRes {
    const void* base; h16* out; float* ssp;
    __device__ __forceinline__ void operator()(AccRef acc, const Unit& u, int wr, int wc, int fr, int fq) const {
        const int col0 = u.pn * BM + wc * 32 + 8 * fq;
#pragma unroll
        for (int ai = 0; ai < 2; ++ai)
#pragma unroll
            for (int m = 0; m < 4; ++m) { const int row = u.pm * BM + ai * HALF + wr * 64 + m * 16 + fr; float ss = 0.f;
#pragma unroll
                for (int bj = 0; bj < 2; ++bj) { const size_t off = (size_t)row * DM + col0 + bj * HALF; float b[8];
                    if (BASE_F32) { const f32x4 b0 = *(const f32x4*)((const float*)base + off), b1 = *(const f32x4*)((const float*)base + off + 4);
                        b[0] = b0[0]; b[1] = b0[1]; b[2] = b0[2]; b[3] = b0[3]; b[4] = b1[0]; b[5] = b1[1]; b[6] = b1[2]; b[7] = b1[3]; }
                    else { const h16x8 hb = *(const h16x8*)((const h16*)base + off);
#pragma unroll
                        for (int e = 0; e < 8; ++e) b[e] = (float)hb[e]; }
                    float v[8];
#pragma unroll
                    for (int e = 0; e < 8; ++e) { v[e] = b[e] + acc[ai][bj][m][e >> 2][e & 3]; ss += v[e] * v[e]; }
                    u32x4 w; w.x = pkh(v[0], v[1]); w.y = pkh(v[2], v[3]); w.z = pkh(v[4], v[5]); w.w = pkh(v[6], v[7]);
                    *(u32x4*)(out + off) = w; }
                ss += __shfl_xor(ss, 16); ss += __shfl_xor(ss, 32);
                if (fq == 0) ssp[(size_t)row * 16 + u.pn * 4 + wc] = ss; }
    }
};
__device__ __forceinline__ float row_rstd(const float* ssp, int row) {
    const f32x4* p = (const f32x4*)(ssp + (size_t)row * 16); const f32x4 a = p[0], b = p[1], c = p[2], d = p[3];
    const float s = ((a[0] + a[1]) + (a[2] + a[3])) + ((b[0] + b[1]) + (b[2] + b[3])) + ((c[0] + c[1]) + (c[2] + c[3])) + ((d[0] + d[1]) + (d[2] + d[3]));
    return 1.0f / sqrtf(s * (1.0f / DM) + EPS);
}
struct EpiSwiGLU {
    const float* ssp; h16* act;
    __device__ __forceinline__ void operator()(AccRef acc, const Unit& u, int wr, int wc, int fr, int fq) const {
        const int col0 = u.pn * HALF + wc * 32 + 8 * fq;
#pragma unroll
        for (int ai = 0; ai < 2; ++ai)
#pragma unroll
            for (int m = 0; m < 4; ++m) { const int row = u.pm * BM + ai * HALF + wr * 64 + m * 16 + fr; const float s = row_rstd(ssp, row); float v[8];
#pragma unroll
                for (int e = 0; e < 8; ++e) { const float gt = acc[ai][0][m][e >> 2][e & 3] * s, up = acc[ai][1][m][e >> 2][e & 3] * s; v[e] = gt * fast_sigmoid(gt) * up; }
                u32x4 w; w.x = pkh(v[0], v[1]); w.y = pkh(v[2], v[3]); w.z = pkh(v[4], v[5]); w.w = pkh(v[6], v[7]);
                *(u32x4*)(act + (size_t)row * DFF + col0) = w; }
    }
};
struct EpiPLE {
    const float* ssp2; const h16* h2; const h16* pp; float* out; float* ssp3;
    __device__ __forceinline__ void operator()(AccRef acc, const Unit& u, int wr, int wc, int fr, int fq) const {
        const int col0 = u.pn * BM + wc * 32 + 8 * fq;
#pragma unroll
        for (int ai = 0; ai < 2; ++ai)
#pragma unroll
            for (int m = 0; m < 4; ++m) { const int row = u.pm * BM + ai * HALF + wr * 64 + m * 16 + fr; const float s = row_rstd(ssp2, row); float ss = 0.f;
#pragma unroll
                for (int bj = 0; bj < 2; ++bj) { const size_t off = (size_t)row * DM + col0 + bj * HALF;
                    const h16x8 hb = *(const h16x8*)(h2 + off), pb = *(const h16x8*)(pp + off); float v[8];
#pragma unroll
                    for (int e = 0; e < 8; ++e) { v[e] = (float)hb[e] + fast_sigmoid(acc[ai][bj][m][e >> 2][e & 3] * s) * (float)pb[e]; ss += v[e] * v[e]; }
                    *(f32x4*)(out + off) = (f32x4){v[0], v[1], v[2], v[3]}; *(f32x4*)(out + off + 4) = (f32x4){v[4], v[5], v[6], v[7]}; }
                ss += __shfl_xor(ss, 16); ss += __shfl_xor(ss, 32);
                if (fq == 0) ssp3[(size_t)row * 16 + u.pn * 4 + wc] = ss; }
    }
};
}

template <class ColMap>
__device__ __forceinline__ void transpose_items(int K, int Nsrc, h16* WT, int Nrows, ColMap cm, const float* __restrict__ kscale, LAS float* scr, int gw, int NGW, int lane) {
    const int nblk = Nrows / 32, items = (K / 64) * nblk;
    for (int it = gw; it < items; it += NGW) {
        const int kb = it / nblk, nb = it % nblk, k0 = 64 * kb, n0 = 32 * nb;
        const float* src = cm(n0 + (lane & 31));
#pragma unroll 8
        for (int i = 0; i < 32; ++i) { const int kk = 2 * i + (lane >> 5); float v = 0.f;
            if (src) { v = src[(size_t)(k0 + kk) * Nsrc]; if (kscale) v *= kscale[k0 + kk]; }
            scr[kk * 33 + (lane & 31)] = v; }
        asm volatile("s_waitcnt lgkmcnt(0)" ::: "memory");
        const int c = lane & 7;
#pragma unroll
        for (int j = 0; j < 4; ++j) { const int n = (lane >> 3) + 8 * j; const LAS float* s = scr + (8 * c) * 33 + n;
            u32x4 o; o.x = pkh(s[0 * 33], s[1 * 33]); o.y = pkh(s[2 * 33], s[3 * 33]); o.z = pkh(s[4 * 33], s[5 * 33]); o.w = pkh(s[6 * 33], s[7 * 33]);
            *(u32x4*)(WT + (size_t)(n0 + n) * K + k0 + 8 * c) = o; }
        asm volatile("s_waitcnt lgkmcnt(0)" ::: "memory");
    }
}
__device__ __forceinline__ int win_colmap(int np) {
    const int pn = np >> 8, p = np & 255, bj = p >> 7, wc = (p >> 5) & 3, r = p & 31;
    const int LC = 256 * pn + 64 * wc + 32 * bj + r;
    if (LC < 512) return LC;
    if (LC < 576) return LC;
    if (LC < 640) return LC;
    if (LC < 704) return 896 + (LC - 640);
    if (LC < 708) return 960 + (LC - 704);
    if (LC < 768) return -1;
    if (LC < 1024) return 640 + (LC - 768);
    if (LC < 1536) return 964 + (LC - 1024);
    if (LC < 2048) return 1476 + (LC - 1536);
    return 1988 + (LC - 2048);
}

constexpr int DSA_LDS_RED = 0  , DSA_LDS_FRED = 1024  , DSA_LDS_CNT = 2048  , DSA_LDS_LIST = 2176  , DSA_LDS_VBUF = 10496  , DSA_LDS_QF = 84224  ;
constexpr int VROW = 144;

struct AttnPtrs { const h16 *QA, *KA, *VA, *QI, *KI, *QB, *KB, *VB; const float* WI; const float* kmp; h16* Y; };

__device__ __forceinline__ void cnt_ge(int& c, float s, float tau) { asm volatile("v_cmp_ge_f32 vcc, %1, %2\n\tv_addc_co_u32 %0, vcc, 0, %0, vcc" : "+v"(c) : "v"(s), "v"(tau) : "vcc"); }
__device__ __forceinline__ void cnt_gt(int& c, float s, float tau) { asm volatile("v_cmp_gt_f32 vcc, %1, %2\n\tv_addc_co_u32 %0, vcc, 0, %0, vcc" : "+v"(c) : "v"(s), "v"(tau) : "vcc"); }
__device__ __forceinline__ void cnt_tie(int& c, float s, float t3, int key, int im) { unsigned long long tmp;
    asm volatile("v_cmp_eq_f32 vcc, %2, %3\n\tv_cmp_le_i32 %1, %4, %5\n\ts_and_b64 vcc, vcc, %1\n\tv_addc_co_u32 %0, vcc, 0, %0, vcc" : "+v"(c), "=&s"(tmp) : "v"(s), "v"(t3), "v"(key), "v"(im) : "vcc"); }
__device__ __forceinline__ int dsa_count_ge(const f32x4 (&S)[8][4], int nch, float tau) {
    int c = 0;
#pragma unroll
    for (int ch = 0; ch < 8; ++ch) if (ch < nch) {
#pragma unroll
        for (int tt = 0; tt < 4; ++tt)
#pragma unroll
            for (int i = 0; i < 4; ++i) cnt_ge(c, S[ch][tt][i], tau);
    }
    return c;
}
__device__ __forceinline__ int dsa_total(int c, LAS unsigned* red, int par, int wid, int q16, int g) {
    c += __shfl_xor(c, 16); c += __shfl_xor(c, 32);
    if (g == 0) red[(par * 8 + wid) * 16 + q16] = (unsigned)c;
    __syncthreads();
    int t = 0;
#pragma unroll
    for (int w = 0; w < 8; ++w) t += (int)red[(par * 8 + w) * 16 + q16];
    return t;
}

__device__ __forceinline__ void dsa_unit(LAS unsigned char* lds, const AttnPtrs& P, int b, int qt) {
    const int tid = threadIdx.x, lane = tid & 63, wid = __builtin_amdgcn_readfirstlane(tid >> 6), q16 = lane & 15, g = lane >> 4;
    LAS unsigned* red = (LAS unsigned*)(lds + DSA_LDS_RED); LAS float* fred = (LAS float*)(lds + DSA_LDS_FRED);
    LAS unsigned* cnt = (LAS unsigned*)(lds + DSA_LDS_CNT); LAS unsigned short* list = (LAS unsigned short*)(lds + DSA_LDS_LIST);
    const int t0 = qt * 16, myq = t0 + q16; const size_t brow = (size_t)b * SEQ;
    const int nch = (t0 + 15) / 512 + 1;
    if (tid < 16) cnt[tid] = 0u;
    f32x4 S[8][4];
#pragma unroll
    for (int ch = 0; ch < 8; ++ch)
#pragma unroll
        for (int tt = 0; tt < 4; ++tt) S[ch][tt] = (f32x4){NEG_INF, NEG_INF, NEG_INF, NEG_INF};
    float smax = NEG_INF, smin = -NEG_INF;
    {
        LAS h16x8* qfl = (LAS h16x8*)(lds + DSA_LDS_QF);
        qfl[wid * 64 + lane] = *(const h16x8*)(P.QI + (brow + myq) * 256 + (wid >> 1) * 64 + (wid & 1) * 32 + g * 8);
        __syncthreads();
        const f32x4 wv = *(const f32x4*)(P.WI + (brow + myq) * 4);
#ifndef X_NOSCORE
        h16x8 pa0 = *(const h16x8*)(P.KI + (brow + 64 * wid + q16) * 64 + g * 8), pa1 = *(const h16x8*)(P.KI + (brow + 64 * wid + q16) * 64 + 32 + g * 8);
#pragma unroll
        for (int ch = 0; ch < 8; ++ch) if (ch < nch) {
#pragma unroll
            for (int tt = 0; tt < 4; ++tt) {
                const int kt = 512 * ch + 64 * wid + 16 * tt;
                const h16x8 a0 = pa0, a1 = pa1;
                { const int nidx = ch * 4 + tt + 1; int kn = 512 * (nidx >> 2) + 64 * wid + 16 * (nidx & 3); kn = kn < SEQ - 16 ? kn : SEQ - 16;
                  pa0 = *(const h16x8*)(P.KI + (brow + kn + q16) * 64 + g * 8); pa1 = *(const h16x8*)(P.KI + (brow + kn + q16) * 64 + 32 + g * 8); }
                if (kt <= t0 + 15) {
                    f32x4 sc = {0.f, 0.f, 0.f, 0.f};
#pragma unroll
                    for (int h = 0; h < 4; ++h) { f32x4 acc = {0.f, 0.f, 0.f, 0.f};
                        const h16x8 b0 = qfl[(2 * h) * 64 + lane], b1 = qfl[(2 * h + 1) * 64 + lane];
                        acc = __builtin_amdgcn_mfma_f32_16x16x32_f16(a0, b0, acc, 0, 0, 0);
                        acc = __builtin_amdgcn_mfma_f32_16x16x32_f16(a1, b1, acc, 0, 0, 0);
#pragma unroll
                        for (int i = 0; i < 4; ++i) sc[i] += wv[h] * __builtin_fmaxf(acc[i], 0.f); }
                    const int key0 = kt + 4 * g;
#pragma unroll
                    for (int i = 0; i < 4; ++i) { const bool ok = (key0 + i) <= myq; const float v = ok ? sc[i] : NEG_INF; sc[i] = v; smax = __builtin_fmaxf(smax, v); smin = __builtin_fminf(smin, ok ? v : -NEG_INF); }
                    S[ch][tt] = sc;
                }
                __builtin_amdgcn_sched_barrier(0);
            }
        }
#endif
    }
    smax = __builtin_fmaxf(smax, __shfl_xor(smax, 16)); smax = __builtin_fmaxf(smax, __shfl_xor(smax, 32));
    smin = __builtin_fminf(smin, __shfl_xor(smin, 16)); smin = __builtin_fminf(smin, __shfl_xor(smin, 32));
    if (g == 0) { fred[(wid * 16 + q16) * 2] = smax; fred[(wid * 16 + q16) * 2 + 1] = smin; }
    __syncthreads();
#pragma unroll
    for (int w = 0; w < 8; ++w) { smax = __builtin_fmaxf(smax, fred[(w * 16 + q16) * 2]); smin = __builtin_fminf(smin, fred[(w * 16 + q16) * 2 + 1]); }
    const int nv = myq + 1; int par = 0;
    float T1 = -NEG_INF, T2 = -NEG_INF, T3 = -NEG_INF;
    int mode = 0;
    float lo = 0.f, hi = 0.f;
    {
        int c2 = 0, c3 = 0; float zero_v = 0.f; asm volatile("" : "+v"(zero_v));
#pragma unroll
        for (int ch = 0; ch < 8; ++ch) if (ch < nch) {
#pragma unroll
            for (int tt = 0; tt < 4; ++tt)
#pragma unroll
                for (int i = 0; i < 4; ++i) { const float s = S[ch][tt][i]; cnt_ge(c2, s, zero_v); cnt_gt(c3, s, zero_v); }
        }
        const int tot = dsa_total(c2 + (c3 << 16), red, par, wid, q16, g); par ^= 1;
        const int cge = tot & 0xffff, cgt = tot >> 16;
        if (nv <= 256) { mode = 1; T2 = -3.0e38f; }
        else if (cgt == 256) { mode = 1; T1 = 0.f; }
        else if (cge == 256) { mode = 1; T2 = 0.f; }
        else if (cgt < 256 && cge > 256) { mode = 2; T1 = 0.f; T3 = 0.f; }
        else if (cgt > 256) { lo = 0.f; hi = __uint_as_float(__float_as_uint(smax) + 1u); }
        else { lo = smin; hi = 0.f; }
    }
#ifndef X_NOBIS
    while (__any(mode == 0)) {
        const float mid = (mode == 0) ? (lo + (hi - lo) * 0.5f) : -NEG_INF;
        const int c = dsa_total(dsa_count_ge(S, nch, mid), red, par, wid, q16, g); par ^= 1;
        if (mode == 0) {
            if (c == 256) { mode = 1; T2 = mid; }
            else { if (c > 256) lo = mid; else hi = mid;
                   const float nm = lo + (hi - lo) * 0.5f;
                   if (!(nm > lo && nm < hi)) { mode = 2; T1 = lo; T3 = lo; } }
        }
    }
#endif
    int istar = -1;
#ifndef X_NOTIE
    if (__any(mode == 2)) {
        const int kb0 = 64 * wid + 4 * g;
        int cg = 0;
#pragma unroll
        for (int ch = 0; ch < 8; ++ch) if (ch < nch) {
#pragma unroll
            for (int tt = 0; tt < 4; ++tt)
#pragma unroll
                for (int i = 0; i < 4; ++i) cnt_gt(cg, S[ch][tt][i], T1);
        }
        cg = dsa_total(cg, red, par, wid, q16, g); par ^= 1;
        const int R = 256 - cg; int ilo = -1, ihi = myq;
        while (__any(mode == 2 && ihi - ilo > 1)) {
            const int im = (mode == 2) ? ((ilo + ihi) >> 1) : -1;
            int c = 0;
#pragma unroll
            for (int ch = 0; ch < 8; ++ch) if (ch < nch) {
#pragma unroll
                for (int tt = 0; tt < 4; ++tt)
#pragma unroll
                    for (int i = 0; i < 4; ++i) cnt_tie(c, S[ch][tt][i], T3, kb0, im - (512 * ch + 16 * tt + i));
            }
            c = dsa_total(c, red, par, wid, q16, g); par ^= 1;
            if (mode == 2 && ihi - ilo > 1) { if (c >= R) ihi = im; else ilo = im; }
        }
        if (mode == 2) istar = ihi;
    }
#endif
#ifndef X_NOEMIT
    {
        const int kb0 = 64 * wid + 4 * g;
#pragma unroll
        for (int ch = 0; ch < 8; ++ch) if (ch < nch) {
#pragma unroll
            for (int tt = 0; tt < 4; ++tt)
#pragma unroll
                for (int i = 0; i < 4; ++i) { const float s = S[ch][tt][i]; const int key = kb0 + 512 * ch + 16 * tt + i;
                    const bool sel = (s > T1) || (s >= T2) || (s == T3 && key <= istar);
                    if (sel) { const unsigned pos = __hip_atomic_fetch_add(cnt + q16, 1u, __ATOMIC_RELAXED, __HIP_MEMORY_SCOPE_WORKGROUP); if (pos < 256u) list[q16 * 256 + pos] = (unsigned short)key; } }
        }
    }
    __syncthreads();
#endif
#ifndef X_NOATT
    int lane_o = lane;
    {
    LAS unsigned char* vbuf = lds + DSA_LDS_VBUF + wid * (2 * 32 * VROW);
#pragma unroll 1
    for (int qq = 0; qq < 2; ++qq) {
        asm volatile("" : "+v"(lane_o));
        const int lane = lane_o, q16 = lane & 15, g = lane >> 4;
        const int ql = 2 * wid + qq; const int qpos = t0 + ql; const int n = (qpos + 1 < 256) ? qpos + 1 : 256;
        const LAS unsigned short* ql_list = list + ql * 256;
        const int head = q16 & 7;
        h16x8 qf[2];
#pragma unroll
        for (int ks = 0; ks < 2; ++ks) qf[ks] = *(const h16x8*)(P.QA + (brow + qpos) * 512 + head * 64 + ks * 32 + g * 8);
        f32x4 L[16];
        {
            h16x8 ka[2][2][2];
#pragma unroll
            for (int u = 0; u < 2; ++u) { const int e = 16 * u + q16; const int key = (e < n) ? (int)ql_list[e] : 0;
                ka[0][u][0] = *(const h16x8*)(P.KA + (brow + key) * 64 + g * 8); ka[0][u][1] = *(const h16x8*)(P.KA + (brow + key) * 64 + 32 + g * 8); }
#pragma unroll
            for (int gi = 0; gi < 8; ++gi) {
                if (gi < 7) {
#pragma unroll
                    for (int u = 0; u < 2; ++u) { const int e = 16 * (2 * (gi + 1) + u) + q16; const int key = (e < n) ? (int)ql_list[e] : 0;
                        ka[(gi + 1) & 1][u][0] = *(const h16x8*)(P.KA + (brow + key) * 64 + g * 8); ka[(gi + 1) & 1][u][1] = *(const h16x8*)(P.KA + (brow + key) * 64 + 32 + g * 8); }
                }
#pragma unroll
                for (int u = 0; u < 2; ++u) { const int T = 2 * gi + u;
                    f32x4 acc = {0.f, 0.f, 0.f, 0.f};
                    acc = __builtin_amdgcn_mfma_f32_16x16x32_f16(ka[gi & 1][u][0], qf[0], acc, 0, 0, 0);
                    acc = __builtin_amdgcn_mfma_f32_16x16x32_f16(ka[gi & 1][u][1], qf[1], acc, 0, 0, 0);
#pragma unroll
                    for (int i = 0; i < 4; ++i) if (16 * T + 4 * g + i >= n) acc[i] = NEG_INF;
                    L[T] = acc; }
                __builtin_amdgcn_sched_barrier(0);
            }
        }
        float mx = NEG_INF;
#pragma unroll
        for (int T = 0; T < 16; ++T)
#pragma unroll
            for (int i = 0; i < 4; ++i) mx = __builtin_fmaxf(mx, L[T][i]);
        mx = __builtin_fmaxf(mx, __shfl_xor(mx, 16)); mx = __builtin_fmaxf(mx, __shfl_xor(mx, 32));
        float lsum = 0.f;
#pragma unroll
        for (int T = 0; T < 16; ++T)
#pragma unroll
            for (int i = 0; i < 4; ++i) { const float p = __builtin_amdgcn_exp2f(L[T][i] - mx); L[T][i] = p; lsum += p; }
        lsum += __shfl_xor(lsum, 16); lsum += __shfl_xor(lsum, 32);
        __builtin_amdgcn_sched_barrier(0);
        f32x4 O[4];
#pragma unroll
        for (int db = 0; db < 4; ++db) O[db] = (f32x4){0.f, 0.f, 0.f, 0.f};
        u32x4 vreg[4];
#pragma unroll
        for (int i = 0; i < 4; ++i) { const int j = lane >> 3; const int e = 16 * (j >> 2) + 4 * i + (j & 3); const int key = (e < n) ? (int)ql_list[e] : 0;
            vreg[i] = *(const u32x4*)(P.VA + (brow + key) * 64 + 8 * (lane & 7)); }
#pragma unroll
        for (int cc = 0; cc < 8; ++cc) {
            LAS unsigned char* vb = vbuf + (cc & 1) * (32 * VROW);
#pragma unroll
            for (int i = 0; i < 4; ++i) *(LAS u32x4*)(vb + (8 * i + (lane >> 3)) * VROW + 16 * (lane & 7)) = vreg[i];
            if (cc < 7) {
#pragma unroll
                for (int i = 0; i < 4; ++i) { const int j = lane >> 3; const int e = 16 * (2 * (cc + 1) + (j >> 2)) + 4 * i + (j & 3); const int key = (e < n) ? (int)ql_list[e] : 0;
                    vreg[i] = *(const u32x4*)(P.VA + (brow + key) * 64 + 8 * (lane & 7)); }
            }
            asm volatile("s_waitcnt lgkmcnt(0)" ::: "memory");
            h16x8 pa;
#pragma unroll
            for (int i = 0; i < 4; ++i) { pa[i] = (h16)L[2 * cc][i]; pa[4 + i] = (h16)L[2 * cc + 1][i]; }
#pragma unroll
            for (int db = 0; db < 4; ++db) {
                const LAS unsigned char* pb = vb + (8 * g + ((lane & 15) >> 2)) * VROW + (16 * db + 4 * (lane & 3)) * 2;
                const s16x4 lo4 = __builtin_amdgcn_ds_read_tr16_b64_v4i16((LAS s16x4*)pb);
                const s16x4 hi4 = __builtin_amdgcn_ds_read_tr16_b64_v4i16((LAS s16x4*)(pb + 4 * VROW));
                const s16x8 bf = {lo4[0], lo4[1], lo4[2], lo4[3], hi4[0], hi4[1], hi4[2], hi4[3]};
                O[db] = __builtin_amdgcn_mfma_f32_16x16x32_f16(pa, __builtin_bit_cast(h16x8, bf), O[db], 0, 0, 0);
            }
            __builtin_amdgcn_sched_barrier(0);
        }
#pragma unroll
        for (int i = 0; i < 4; ++i) { const float lh = __shfl(lsum, (4 * g + i) & 7); const float rl = 1.0f / lh;
            if (g < 2) {
#pragma unroll
                for (int db = 0; db < 4; ++db) P.Y[(brow + qpos) * DM + (4 * g + i) * 64 + 16 * db + q16] = (h16)(O[db][i] * rl); } }
    }
    }
#endif
    __syncthreads();
}

constexpr int MB_LDS_KM = 0  , MB_LDS_KV = 4096  , MB_TILE = 64 * VROW;
__device__ __forceinline__ int crow(int r, int hi) { return (r & 3) + 8 * (r >> 2) + 4 * hi; }

__device__ __forceinline__ void moba_unit(LAS unsigned char* lds, const AttnPtrs& P, int b, int h, int j) {
    const int tid = threadIdx.x, lane = tid & 63, wid = __builtin_amdgcn_readfirstlane(tid >> 6), r32 = lane & 31, hi = lane >> 5;
    const size_t brow = (size_t)b * SEQ; const int q0 = 256 * j; const int qrel = 32 * wid + r32; const size_t qrow = brow + q0 + qrel;
    LAS float* km = (LAS float*)(lds + MB_LDS_KM);
    for (int i = tid; i < 16 * 64; i += 512) { const int n = i >> 6, d = i & 63; const size_t pm = (size_t)b * 16 + n;
        km[i] = (P.kmp[((pm * 2 + 0) * 8 + h) * 64 + d] + P.kmp[((pm * 2 + 1) * 8 + h) * 64 + d]) * (1.0f / 256.0f); }
    __syncthreads();
    h16x8 qf[4];
#pragma unroll
    for (int d0 = 0; d0 < 4; ++d0) qf[d0] = *(const h16x8*)(P.QB + qrow * 512 + h * 64 + d0 * 16 + hi * 8);
    unsigned selmask = 0u;
    {
        float gate[8];
#pragma unroll
        for (int nb = 0; nb < 8; ++nb) gate[nb] = 0.f;
#pragma unroll
        for (int c8 = 0; c8 < 8; ++c8) {
            const h16x8 qv = *(const h16x8*)(P.QB + qrow * 512 + h * 64 + c8 * 8);
#pragma unroll
            for (int nb = 0; nb < 8; ++nb) { const LAS float* kr = km + (8 * hi + nb) * 64 + c8 * 8;
#pragma unroll
                for (int e = 0; e < 8; ++e) gate[nb] += (float)qv[e] * kr[e]; }
        }
        float gall[16];
#pragma unroll
        for (int nb = 0; nb < 8; ++nb) { const float o = __shfl_xor(gate[nb], 32); gall[nb] = hi ? o : gate[nb]; gall[8 + nb] = hi ? gate[nb] : o; }
#pragma unroll
        for (int n = 0; n < 16; ++n) if (n >= j) gall[n] = NEG_INF;
#pragma unroll
        for (int pick = 0; pick < 3; ++pick) { float best = NEG_INF; int bi = -1;
#pragma unroll
            for (int n = 0; n < 16; ++n) if (gall[n] > best) { best = gall[n]; bi = n; }
            if (bi >= 0) { selmask |= 1u << bi;
#pragma unroll
                for (int n = 0; n < 16; ++n) if (n == bi) gall[n] = NEG_INF; } }
    }
    const int NT = 4 * (j + 1);
    const h16* Kg = P.KB + brow * 512 + h * 64; const h16* Vg = P.VB + brow * 512 + h * 64;
    const int lrow = tid >> 3, lch = tid & 7;
    auto tile_key0 = [&](int t) { return (t < 4) ? (q0 + 64 * t) : (64 * (t - 4)); };
    u32x4 kreg, vreg;
    { const int k0 = tile_key0(0); kreg = *(const u32x4*)(Kg + (size_t)(k0 + lrow) * 512 + lch * 8); vreg = *(const u32x4*)(Vg + (size_t)(k0 + lrow) * 512 + lch * 8); }
    { LAS unsigned char* kb = lds + MB_LDS_KV; *(LAS u32x4*)(kb + lrow * VROW + lch * 16) = kreg; *(LAS u32x4*)(kb + MB_TILE + lrow * VROW + lch * 16) = vreg; }
    __syncthreads();
    float mrun = NEG_INF, lrun = 0.f; f32x16 o[2]; o[0] = f32x16{}; o[1] = f32x16{};
#pragma unroll 1
    for (int t = 0; t < NT; ++t) {
        if (t + 1 < NT) { const int k0 = tile_key0(t + 1); kreg = *(const u32x4*)(Kg + (size_t)(k0 + lrow) * 512 + lch * 8); vreg = *(const u32x4*)(Vg + (size_t)(k0 + lrow) * 512 + lch * 8); }
        const LAS unsigned char* kb = lds + MB_LDS_KV + (t & 1) * (2 * MB_TILE); const LAS unsigned char* vb = kb + MB_TILE;
        bool active;
        if (t < 4) active = (64 * t) <= (32 * wid + 31);
        else active = __any((selmask >> ((t - 4) >> 2)) & 1u);
        if (active) {
            f32x16 p0 = f32x16{}, p1 = f32x16{};
#pragma unroll
            for (int d0 = 0; d0 < 4; ++d0) {
                const h16x8 k0f = *(const LAS h16x8*)(kb + r32 * VROW + (16 * d0 + 8 * hi) * 2);
                const h16x8 k1f = *(const LAS h16x8*)(kb + (32 + r32) * VROW + (16 * d0 + 8 * hi) * 2);
                p0 = __builtin_amdgcn_mfma_f32_32x32x16_f16(k0f, qf[d0], p0, 0, 0, 0);
                p1 = __builtin_amdgcn_mfma_f32_32x32x16_f16(k1f, qf[d0], p1, 0, 0, 0);
            }
            if (t < 4) {
#pragma unroll
                for (int r = 0; r < 16; ++r) { const int kv = 64 * t + crow(r, hi); if (kv > qrel) p0[r] = NEG_INF; if (kv + 32 > qrel) p1[r] = NEG_INF; }
            } else if (!((selmask >> ((t - 4) >> 2)) & 1u)) {
#pragma unroll
                for (int r = 0; r < 16; ++r) { p0[r] = NEG_INF; p1[r] = NEG_INF; }
            }
            float mt = NEG_INF;
#pragma unroll
            for (int r = 0; r < 16; ++r) mt = __builtin_fmaxf(mt, __builtin_fmaxf(p0[r], p1[r]));
            mt = __builtin_fmaxf(mt, __shfl_xor(mt, 32));
            const float mnew = __builtin_fmaxf(mrun, mt);
            const float alpha = (mnew == NEG_INF) ? 1.0f : __builtin_amdgcn_exp2f(mrun - mnew);
            const float msub = (mnew == NEG_INF) ? 0.f : mnew;
            float ps = 0.f;
#pragma unroll
            for (int r = 0; r < 16; ++r) { p0[r] = __builtin_amdgcn_exp2f(p0[r] - msub); p1[r] = __builtin_amdgcn_exp2f(p1[r] - msub); ps += p0[r] + p1[r]; }
            lrun = lrun * alpha + ps; mrun = mnew;
            if (__any(alpha != 1.0f)) {
#pragma unroll
                for (int r = 0; r < 16; ++r) { o[0][r] *= alpha; o[1][r] *= alpha; }
            }
#pragma unroll
            for (int kt = 0; kt < 2; ++kt)
#pragma unroll
                for (int s = 0; s < 2; ++s) {
                    h16x8 pb;
#pragma unroll
                    for (int e = 0; e < 8; ++e) pb[e] = (h16)(kt ? p1[8 * s + e] : p0[8 * s + e]);
#pragma unroll
                    for (int db = 0; db < 2; ++db) {
                        const LAS unsigned char* pa = vb + (32 * kt + 16 * s + 4 * hi + ((lane & 15) >> 2)) * VROW + (32 * db + 16 * ((lane >> 4) & 1) + 4 * (lane & 3)) * 2;
                        const s16x4 lo4 = __builtin_amdgcn_ds_read_tr16_b64_v4i16((LAS s16x4*)pa);
                        const s16x4 hi4 = __builtin_amdgcn_ds_read_tr16_b64_v4i16((LAS s16x4*)(pa + 8 * VROW));
                        const s16x8 af = {lo4[0], lo4[1], lo4[2], lo4[3], hi4[0], hi4[1], hi4[2], hi4[3]};
                        o[db] = __builtin_amdgcn_mfma_f32_32x32x16_f16(__builtin_bit_cast(h16x8, af), pb, o[db], 0, 0, 0);
                    }
                }
        }
        if (t + 1 < NT) { LAS unsigned char* nb = lds + MB_LDS_KV + ((t + 1) & 1) * (2 * MB_TILE); *(LAS u32x4*)(nb + lrow * VROW + lch * 16) = kreg; *(LAS u32x4*)(nb + MB_TILE + lrow * VROW + lch * 16) = vreg; }
        __syncthreads();
    }
    lrun += __shfl_xor(lrun, 32);
    const float rl = 1.0f / lrun;
    h16* yrow = P.Y + qrow * DM + 512 + h * 64;
#pragma unroll
    for (int db = 0; db < 2; ++db)
#pragma unroll
        for (int rg = 0; rg < 4; ++rg) { u32x2 w; w.x = pkh(o[db][4 * rg] * rl, o[db][4 * rg + 1] * rl); w.y = pkh(o[db][4 * rg + 2] * rl, o[db][4 * rg + 3] * rl);
            *(u32x2*)(yrow + 32 * db + 8 * rg + 4 * hi) = w; }
}

constexpr int LDS_BYTES = 147456;
struct Args { const float* in[14]; float* out; unsigned char* ws; int ph_lo, ph_hi; };

__global__ void __launch_bounds__(512, 2) hymba_fwd(Args args) {
    extern __shared__ __attribute__((aligned(16))) unsigned char lds_raw[];
    LAS unsigned char* lds = (LAS unsigned char*)lds_raw;
    cg::grid_group grid = cg::this_grid();
    const int tid = threadIdx.x, lane = tid & 63, wave = __builtin_amdgcn_readfirstlane(tid >> 6);
    const int G = gridDim.x, bx = blockIdx.x;
    unsigned char* ws = args.ws;
    const float* x = args.in[0]; const float* p_in = args.in[1]; const float* g_attn = args.in[2]; const float* w_in = args.in[3]; const float* g_idx = args.in[4];
    const float* w_out = args.in[5]; const float* g_ffn = args.in[6]; const float* w_gate = args.in[7]; const float* w_up = args.in[8]; const float* w_down = args.in[9];
    const float* g_ple = args.in[10]; const float* w_pg = args.in[11]; const float* w_pp = args.in[12]; const float* g_final = args.in[13];
    h16* Wt_in = (h16*)(ws + WS_WIN); h16* Wt_out = (h16*)(ws + WS_WOUT); h16* Wt_gu = (h16*)(ws + WS_WGU); h16* Wt_dn = (h16*)(ws + WS_WDN); h16* Wt_pg = (h16*)(ws + WS_WPG); h16* Wt_pp = (h16*)(ws + WS_WPP);
    float* rope = (float*)(ws + WS_ROPE); float* rs0 = (float*)(ws + WS_RS0); float* ssp1 = (float*)(ws + WS_SSP1); float* ssp2 = (float*)(ws + WS_SSP2); float* ssp3 = (float*)(ws + WS_SSP3);
    float* kmp = (float*)(ws + WS_KMP); float* WI = (float*)(ws + WS_WI);
    h16* PH = (h16*)(ws + WS_PH); h16* PP = (h16*)(ws + WS_PP); h16* XH = (h16*)(ws + WS_XH); h16* H1 = XH; h16* Y = (h16*)(ws + WS_Y); h16* H2 = Y;
    h16* QA = (h16*)(ws + WS_QA); h16* KA = (h16*)(ws + WS_KA); h16* VA = (h16*)(ws + WS_VA); h16* QI = (h16*)(ws + WS_QI); h16* KI = (h16*)(ws + WS_KI);
    h16* QB = (h16*)(ws + WS_QB); h16* KB = (h16*)(ws + WS_KB); h16* VB = (h16*)(ws + WS_VB); h16* ACT = (h16*)(ws + WS_ACT);
    const int lo = args.ph_lo, hi_ph = args.ph_hi;
#ifndef PH_MASK
#define PH_MASK 0xff
#endif
#define IN(k) (((PH_MASK >> (k)) & 1) && lo <= (k) && (k) < hi_ph)
#define SEAM(k) do { if (IN(k) && IN((k) + 1)) grid.sync(); } while (0)

    if (IN(0)) {
        LAS float* scr = (LAS float*)(lds + wave * 16384);
        const int gw = bx * 8 + wave, NGW = G * 8;
        transpose_items(DM, NIN_SRC, Wt_in, NIN, [=](int np) -> const float* { const int c = win_colmap(np); return c >= 0 ? w_in + c : nullptr; }, g_attn, scr, gw, NGW, lane);
        transpose_items(DM, DM, Wt_out, DM, [=](int np) -> const float* { return w_out + np; }, nullptr, scr, gw, NGW, lane);
        transpose_items(DM, DFF, Wt_gu, 2 * DFF, [=](int np) -> const float* { const int p = np & 255, t = np >> 8; return (p < 128) ? (w_gate + t * 128 + p) : (w_up + t * 128 + p - 128); }, g_ffn, scr, gw, NGW, lane);
        transpose_items(DFF, DM, Wt_dn, DM, [=](int np) -> const float* { return w_down + np; }, nullptr, scr, gw, NGW, lane);
        transpose_items(DM, DM, Wt_pg, DM, [=](int np) -> const float* { return w_pg + np; }, g_ple, scr, gw, NGW, lane);
        transpose_items(DPLE, DM, Wt_pp, DM, [=](int np) -> const float* { return w_pp + np; }, nullptr, scr, gw, NGW, lane);
        for (int m = gw; m < NTOK; m += NGW) {
            const f32x4* xr = (const f32x4*)(x + (size_t)m * DM) + lane; f32x4 v[4]; float s = 0.f;
#pragma unroll
            for (int jj = 0; jj < 4; ++jj) { v[jj] = xr[64 * jj]; s += (v[jj].x * v[jj].x + v[jj].y * v[jj].y) + (v[jj].z * v[jj].z + v[jj].w * v[jj].w); }
            s = wave_sum(s);
            if (lane == 0) rs0[m] = 1.0f / sqrtf(s * (1.0f / DM) + EPS);
            u32x2* o8 = (u32x2*)(XH + (size_t)m * DM) + lane;
#pragma unroll
            for (int jj = 0; jj < 4; ++jj) { u32x2 w; w.x = pkh(v[jj].x, v[jj].y); w.y = pkh(v[jj].z, v[jj].w); o8[64 * jj] = w; }
        }
        for (int m = gw; m < NTOK; m += NGW) { const f32x4 v = *((const f32x4*)(p_in + (size_t)m * DPLE) + lane); u32x2 w; w.x = pkh(v.x, v.y); w.y = pkh(v.z, v.w); *((u32x2*)(PH + (size_t)m * DPLE) + lane) = w; }
        for (int i = bx * 512 + tid; i < SEQ * 32; i += G * 512) {
            const int pos = i >> 5, jx = i & 31;
            const float inv = ROPE_INV[jx];
            const float ang = (float)pos * inv;
            const double a = (double)ang; const double kq = __builtin_rint(a * 0.15915494309189535);
            double r = __builtin_fma(-kq, 6.283185307179586, a); r = __builtin_fma(-kq, 2.4492935982947064e-16, r);
            const double r2 = r * r; double sn = 0.0, cs = 0.0;
            double ts = 1.0, tc = 1.0;
#pragma unroll
            for (int n = 13; n >= 1; --n) { ts = 1.0 - ts * r2 / (double)((2 * n) * (2 * n + 1)); tc = 1.0 - tc * r2 / (double)((2 * n - 1) * (2 * n)); }
            sn = r * ts; cs = tc;
            rope[(size_t)i * 2] = (float)cs; rope[(size_t)i * 2 + 1] = (float)sn;
        }
    }
    SEAM(0);
    if (IN(1)) {
        { pg8::Gemm g{XH, Wt_in, NTOK, NIN, DM}; pg8::StaticOrder S; S.init(NTOK, NIN, G, bx);
          pg8::EpiInProj E{rs0, rope, g_idx, QA, KA, VA, QI, KI, QB, KB, VB, WI, kmp};
          pg8::gemm_phase(lds, g, S, E); }
        { pg8::Gemm g{PH, Wt_pp, NTOK, DM, DPLE}; pg8::StaticOrder S; S.init(NTOK, DM, G, bx);
          pg8::EpiPlain E{PP, DM};
          pg8::gemm_phase(lds, g, S, E); }
    }
    SEAM(1);
    if (IN(2)) {
        AttnPtrs P{QA, KA, VA, QI, KI, QB, KB, VB, WI, kmp, Y};
        const int b = bx & 7, r = bx >> 3;
        const int nr = G >> 3;
#ifndef NO_DSA
        for (int s = r; s < 128; s += nr) { dsa_unit(lds, P, b, s); dsa_unit(lds, P, b, 255 - s); }
#endif
#ifndef NO_MOBA
        for (int uu = r; uu < 64; uu += nr) { const int h = uu >> 3, s = uu & 7; moba_unit(lds, P, b, h, s); __syncthreads(); moba_unit(lds, P, b, h, 15 - s); __syncthreads(); }
#endif
    }
    SEAM(2);
    if (IN(3)) {
        pg8::Gemm g{Y, Wt_out, NTOK, DM, DM}; pg8::StaticOrder S; S.init(NTOK, DM, G, bx);
        pg8::EpiRes<true> E{x, H1, ssp1};
        pg8::gemm_phase(lds, g, S, E);
    }
    SEAM(3);
    if (IN(4)) {
        pg8::Gemm g{H1, Wt_gu, NTOK, 2 * DFF, DM}; pg8::StaticOrder S; S.init(NTOK, 2 * DFF, G, bx);
        pg8::EpiSwiGLU E{ssp1, ACT};
        pg8::gemm_phase(lds, g, S, E);
    }
    SEAM(4);
    if (IN(5)) {
        pg8::Gemm g{ACT, Wt_dn, NTOK, DM, DFF}; pg8::StaticOrder S; S.init(NTOK, DM, G, bx);
        pg8::EpiRes<false> E{H1, H2, ssp2};
        pg8::gemm_phase(lds, g, S, E);
    }
    SEAM(5);
    if (IN(6)) {
        pg8::Gemm g{H2, Wt_pg, NTOK, DM, DM}; pg8::StaticOrder S; S.init(NTOK, DM, G, bx);
        pg8::EpiPLE E{ssp2, H2, PP, args.out, ssp3};
        pg8::gemm_phase(lds, g, S, E);
    }
    SEAM(6);
    if (IN(7)) {
        const int gw = bx * 8 + wave, NGW = G * 8;
        f32x4 gf[4];
#pragma unroll
        for (int jj = 0; jj < 4; ++jj) gf[jj] = *((const f32x4*)g_final + lane + 64 * jj);
        for (int m = gw; m < NTOK; m += NGW) {
            const float s = pg8::row_rstd(ssp3, m);
            f32x4* o = (f32x4*)(args.out + (size_t)m * DM) + lane;
#pragma unroll
            for (int jj = 0; jj < 4; ++jj) { f32x4 v = o[64 * jj]; v = v * s * gf[jj]; o[64 * jj] = v; }
        }
    }
#undef IN
#undef SEAM
}

extern "C" void kernel_launch(void* const* d_in, const int* in_sizes, int n_in, void* d_out, int out_size, void* d_ws, size_t ws_size, hipStream_t stream) {
    static int grid = 0;
    if (grid == 0) {
        if (n_in != 14 || out_size != NTOK * DM || ws_size < WS_END) { fprintf(stderr, "kernel_launch: unexpected shapes (n_in %d out %d ws %zu)\n", n_in, out_size, ws_size); grid = -1; return; }
        int dev = 0, cus = 0, per_cu = 0;
        (void)hipGetDevice(&dev);
        (void)hipDeviceGetAttribute(&cus, hipDeviceAttributeMultiprocessorCount, dev);
        (void)hipFuncSetAttribute((const void*)hymba_fwd, hipFuncAttributeMaxDynamicSharedMemorySize, LDS_BYTES);
        (void)hipOccupancyMaxActiveBlocksPerMultiprocessor(&per_cu, (const void*)hymba_fwd, 512, LDS_BYTES);
        if (per_cu < 1) { fprintf(stderr, "kernel_launch: occupancy query says %d blocks/CU\n", per_cu); }
        grid = cus;
        if (grid % 8 != 0 || grid > 256) grid = (grid / 8) * 8 > 256 ? 256 : (grid / 8) * 8;
    }
    if (grid <= 0) return;
    Args a{};
    for (int i = 0; i < 14; ++i) a.in[i] = (const float*)d_in[i];
    a.out = (float*)d_out; a.ws = (unsigned char*)d_ws;
#if MK_COOP
    a.ph_lo = 0; a.ph_hi = 8;
    void* kargs[] = {&a};
    hipError_t e = hipLaunchCooperativeKernel((const void*)hymba_fwd, dim3(grid), dim3(512), kargs, LDS_BYTES, stream);
    if (e != hipSuccess) fprintf(stderr, "cooperative launch failed: %s (grid %d)\n", hipGetErrorString(e), grid);
#else
    for (int ph = 0; ph < 8; ++ph) { a.ph_lo = ph; a.ph_hi = ph + 1; hipLaunchKernelGGL(hymba_fwd, dim3(grid), dim3(512), LDS_BYTES, stream, a); }
#endif
}
```

```cpp
#include <hip/hip_runtime.h>
#include <hip/hip_cooperative_groups.h>
#include <cstdio>
#include <cstdint>
namespace cg = cooperative_groups;

#ifndef REP_DSA
#define REP_DSA 1
#endif
#ifndef REP_MOBA
#define REP_MOBA 1
#endif
#ifndef REP_ATT
#define REP_ATT 1
#endif
#ifndef REP_SC
#define REP_SC 1
#endif
#ifndef REP_SEL
#define REP_SEL 1
#endif
#ifndef REP_EM
#define REP_EM 1
#endif
#ifndef MK_COOP
#define MK_COOP 1
#endif

#define LAS __attribute__((address_space(3)))
typedef _Float16 h16;
typedef _Float16 h16x8 __attribute__((ext_vector_type(8)));
typedef _Float16 h16x4 __attribute__((ext_vector_type(4)));
typedef _Float16 h16x2 __attribute__((ext_vector_type(2)));
typedef short s16x8 __attribute__((ext_vector_type(8)));
typedef short s16x4 __attribute__((ext_vector_type(4)));
typedef float f32x2 __attribute__((ext_vector_type(2)));
typedef float f32x4 __attribute__((ext_vector_type(4)));
typedef float f32x16 __attribute__((ext_vector_type(16)));
typedef unsigned u32x2 __attribute__((ext_vector_type(2)));
typedef unsigned u32x4 __attribute__((ext_vector_type(4)));

constexpr int BATCH = 8, SEQ = 4096, DM = 1024, NTOK = BATCH * SEQ, NIN = 2560, NIN_SRC = 2500, DFF = 2816, DPLE = 256;
constexpr float EPS = 1e-6f;
constexpr float C2 = 0.125f * 1.4426950408889634f;
constexpr float NEG_INF = -__builtin_huge_valf();

constexpr size_t MiB = 1u << 20;
constexpr size_t WS_WIN = 1 * MiB, WS_WOUT = 6 * MiB, WS_WGU = 8 * MiB, WS_WDN = 19 * MiB, WS_WPG = 25 * MiB, WS_WPP = 27 * MiB;
constexpr size_t WS_ROPE = 28 * MiB, WS_RS0 = 29 * MiB, WS_SSP1 = 30 * MiB, WS_SSP2 = 32 * MiB, WS_SSP3 = 34 * MiB, WS_KMP = 36 * MiB, WS_WI = 37 * MiB;
constexpr size_t WS_PH = 38 * MiB, WS_PP = 54 * MiB, WS_XH = 118 * MiB  , WS_Y = 182 * MiB  ;
constexpr size_t WS_QA = 246 * MiB, WS_KA = 278 * MiB, WS_VA = 282 * MiB, WS_QI = 286 * MiB, WS_KI = 302 * MiB, WS_QB = 306 * MiB, WS_KB = 338 * MiB, WS_VB = 370 * MiB;
constexpr size_t WS_ACT = 246 * MiB  , WS_END = 422 * MiB;

__constant__ float ROPE_INV[32] = {0x1.0000000000000p+0f, 0x1.7ff2220000000p-1f, 0x1.1feb340000000p-1f, 0x1.afd1360000000p-2f, 0x1.43d1360000000p-2f, 0x1.e5a8480000000p-3f, 0x1.6c310e0000000p-3f, 0x1.111aee0000000p-3f,
    0x1.99999a0000000p-4f, 0x1.33281c0000000p-4f, 0x1.ccab860000000p-5f, 0x1.59742a0000000p-5f, 0x1.030dc40000000p-5f, 0x1.8486a00000000p-6f, 0x1.235a720000000p-6f, 0x1.b4f7e20000000p-7f,
    0x1.47ae140000000p-7f, 0x1.eb73600000000p-8f, 0x1.7089380000000p-8f, 0x1.145cee0000000p-8f, 0x1.9e7c6e0000000p-9f, 0x1.36d21a0000000p-9f, 0x1.d22a500000000p-10f, 0x1.5d931c0000000p-10f,
    0x1.0624de0000000p-10f, 0x1.8929180000000p-11f, 0x1.26d42c0000000p-11f, 0x1.ba2e4c0000000p-12f, 0x1.4b96be0000000p-12f, 0x1.f150280000000p-13f, 0x1.74eea60000000p-13f, 0x1.17a8e40000000p-13f};
__device__ __forceinline__ unsigned pkh(float lo, float hi) { h16x2 v = {(h16)lo, (h16)hi}; return __builtin_bit_cast(unsigned, v); }
__device__ __forceinline__ float wave_sum(float v) {
#pragma unroll
    for (int o = 1; o < 64; o <<= 1) v += __shfl_xor(v, o);
    return v;
}
__device__ __forceinline__ float fast_sigmoid(float x) { return __builtin_amdgcn_rcpf(1.0f + __builtin_amdgcn_exp2f(-1.4426950408889634f * x)); }

namespace pg8 {
constexpr int BM = 256, BK = 64, HALF = 128, HTB = HALF * BK * 2, STAGE_BYTES = 8 * HTB, NXCD = 8, WGM = 8;
__host__ __device__ __forceinline__ int lds_byte(int r, int c) { const int st = (r >> 4) * 2 + (c >> 5), rr = r & 15, cc = c & 31, ob = rr * 64 + cc * 2; return st * 1024 + (ob ^ (((ob >> 9) & 1) << 5)); }
__host__ __device__ __forceinline__ void stage_rc(int b, int& R, int& C) { const int st = b / 1024, sb = b % 1024, swz = sb ^ (((sb >> 9) & 1) << 5); R = (st >> 1) * 16 + swz / 64; C = (st & 1) * 32 + (swz % 64) / 2; }
__host__ __device__ __forceinline__ int perm32(int rho) { const int n = rho >> 4, i = rho & 15; return 8 * (i >> 2) + 4 * n + (i & 3); }
struct Unit { int pm, pn; };
struct Gemm { const h16* A; const h16* Bt; int M, N, K; };
struct StaticOrder {
    int nM, nN, nwg, G, c;
    __host__ __device__ void init(int M, int N, int G_, int c_) { nM = M / BM; nN = N / BM; nwg = nM * nN; G = G_; c = c_; }
    __host__ __device__ bool next(int i, Unit& u) const {
        const long L = (long)i * G + c; if (L >= nwg) return false;
        int wgid = (int)L; { const int q = nwg / NXCD, r = nwg % NXCD, xcd = wgid % NXCD, off = wgid / NXCD; wgid = (xcd < r ? xcd * (q + 1) : r * (q + 1) + (xcd - r) * q) + off; }
        const int nig = WGM * nN, gid = wgid / nig, fm = gid * WGM, gsz = (nM - fm) < WGM ? (nM - fm) : WGM;
        u.pm = fm + ((wgid % nig) % gsz); u.pn = (wgid % nig) / gsz; return true;
    }
};
template <class Epi>
__device__ __forceinline__ void gemm_phase(LAS unsigned char* lds, const Gemm g, const StaticOrder& S, const Epi& E) {
    const int tid = threadIdx.x, wid = __builtin_amdgcn_readfirstlane(tid >> 6), lane = tid & 63, wr = wid >> 2, wc = wid & 3, fr = lane & 15, fq = lane >> 4;
    const int K = g.K, nt = K / BK;
    unsigned voffA[2], voffB[2];
#pragma unroll
    for (int i = 0; i < 2; ++i) { int R, C; stage_rc(tid * 16 + i * 8192, R, C); const int Rb = (R & ~31) + perm32(R & 31);
        voffA[i] = (unsigned)(R * K + C) * 2u; voffB[i] = (unsigned)(Rb * K + C) * 2u; }
    const size_t kstep = (size_t)(BK * 2);
    const size_t hstep = (size_t)HALF * K * 2;
    const size_t tstep = 2 * hstep;
    const unsigned ldsw = (unsigned)wid * 1024u;
    const int aoff = lds_byte(wr * 64 + fr, fq * 8), boff = lds_byte(wc * 32 + fr, fq * 8);
#define PG8_SA(b, h) (((b) * 2 + (h)) * HTB)
#define PG8_SB(b, h) ((4 + (b) * 2 + (h)) * HTB)
#define PG8_STAGE(bufoff, gbase, voff) do { _Pragma("unroll") for (int _i = 0; _i < 2; ++_i) \
        __builtin_amdgcn_global_load_lds((const unsigned*)((const char*)(gbase) + (voff)[_i]), (LAS unsigned*)(lds + (bufoff) + ldsw + _i * 8192), 16, 0, 0); } while (0)
#define PG8_LDA(dst, b, h) do { _Pragma("unroll") for (int m = 0; m < 4; ++m) _Pragma("unroll") for (int k = 0; k < 2; ++k) dst[m][k] = *(const LAS s16x8*)(lds + PG8_SA(b, h) + aoff + m * 2048 + k * 1024); } while (0)
#define PG8_LDB(dst, b, h) do { _Pragma("unroll") for (int n = 0; n < 2; ++n) _Pragma("unroll") for (int k = 0; k < 2; ++k) dst[n][k] = *(const LAS s16x8*)(lds + PG8_SB(b, h) + boff + n * 2048 + k * 1024); } while (0)
#define PG8_MMA(ai, bj, At, Bt) do { __builtin_amdgcn_s_setprio(1); _Pragma("unroll") for (int m = 0; m < 4; ++m) _Pragma("unroll") for (int n = 0; n < 2; ++n) _Pragma("unroll") for (int k = 0; k < 2; ++k) \
        acc[ai][bj][m][n] = __builtin_amdgcn_mfma_f32_16x16x32_f16(__builtin_bit_cast(h16x8, Bt[n][k]), __builtin_bit_cast(h16x8, At[m][k]), acc[ai][bj][m][n], 0, 0, 0); __builtin_amdgcn_s_setprio(0); } while (0)
#define PG8_WAIT_V(n) asm volatile("s_waitcnt vmcnt(" #n ")" ::: "memory")
#define PG8_WAIT_L(n) asm volatile("s_waitcnt lgkmcnt(" #n ")" ::: "memory")
#define PG8_BAR __builtin_amdgcn_s_barrier()
#define PG8_SCHED __builtin_amdgcn_sched_barrier(0)
    Unit cur, nxt; int ui = 0;
    if (!S.next(0, cur)) return;
    f32x4 acc[2][2][4][2];
#pragma unroll
    for (int a = 0; a < 2; ++a)
#pragma unroll
        for (int b = 0; b < 2; ++b)
#pragma unroll
            for (int m = 0; m < 4; ++m)
#pragma unroll
                for (int n = 0; n < 2; ++n) acc[a][b][m][n] = (f32x4){0.f, 0.f, 0.f, 0.f};
    s16x8 At[4][2], B0[2][2], B1[2][2];
    const char* cA = (const char*)g.A + (size_t)cur.pm * tstep; const char* cB = (const char*)g.Bt + (size_t)cur.pn * tstep;
    PG8_STAGE(PG8_SB(0, 0), cB, voffB); PG8_STAGE(PG8_SB(0, 1), cB + hstep, voffB); PG8_STAGE(PG8_SA(0, 0), cA, voffA); PG8_STAGE(PG8_SA(0, 1), cA + hstep, voffA);
    if (wr == 1) PG8_BAR;
    PG8_WAIT_V(2); PG8_BAR;
    PG8_STAGE(PG8_SB(1, 0), cB + kstep, voffB); PG8_STAGE(PG8_SA(1, 0), cA + kstep, voffA); PG8_STAGE(PG8_SB(1, 1), cB + hstep + kstep, voffB);
    PG8_WAIT_V(6); PG8_BAR;
    for (;;) {
        const bool has_next = S.next(ui + 1, nxt);
        const char* nA = has_next ? (const char*)g.A + (size_t)nxt.pm * tstep : cA; const char* nB = has_next ? (const char*)g.Bt + (size_t)nxt.pn * tstep : cB;
#pragma unroll 1
        for (int t = 0; t < nt; t += 2) {
            const bool last = (t == nt - 2);
            const char* a1 = cA + (size_t)(t + 1) * kstep;
            const char* a2 = last ? nA : cA + (size_t)(t + 2) * kstep; const char* b2 = last ? nB : cB + (size_t)(t + 2) * kstep;
            const char* a3 = a2 + kstep; const char* b3 = b2 + kstep;
            PG8_LDB(B0, 0, 0); PG8_LDB(B1, 0, 1); PG8_SCHED; PG8_LDA(At, 0, 0); PG8_STAGE(PG8_SA(1, 1), a1 + hstep, voffA);
            PG8_WAIT_V(8); PG8_WAIT_L(0); PG8_BAR; PG8_MMA(0, 0, At, B0); PG8_MMA(0, 1, At, B1); PG8_BAR; PG8_SCHED;
            PG8_LDA(At, 0, 1); PG8_STAGE(PG8_SB(0, 0), b2, voffB); PG8_STAGE(PG8_SB(0, 1), b2 + hstep, voffB); PG8_STAGE(PG8_SA(0, 0), a2, voffA);
            PG8_WAIT_V(8); PG8_WAIT_L(0); PG8_BAR; PG8_MMA(1, 0, At, B0); PG8_MMA(1, 1, At, B1); PG8_BAR; PG8_SCHED;
            PG8_LDB(B0, 1, 0); PG8_LDB(B1, 1, 1); PG8_SCHED; PG8_LDA(At, 1, 0); PG8_STAGE(PG8_SA(0, 1), a2 + hstep, voffA);
            PG8_WAIT_V(8); PG8_WAIT_L(0); PG8_BAR; PG8_MMA(0, 0, At, B0); PG8_MMA(0, 1, At, B1); PG8_BAR; PG8_SCHED;
            PG8_LDA(At, 1, 1); PG8_STAGE(PG8_SB(1, 0), b3, voffB); PG8_STAGE(PG8_SB(1, 1), b3 + hstep, voffB); PG8_STAGE(PG8_SA(1, 0), a3, voffA);
            PG8_WAIT_V(8); PG8_WAIT_L(0); PG8_BAR; PG8_MMA(1, 0, At, B0); PG8_MMA(1, 1, At, B1); PG8_BAR; PG8_SCHED;
        }
        if (wr == 0) PG8_BAR;
        E(acc, cur, wr, wc, fr, fq);
        if (!has_next) break;
#pragma unroll
        for (int a = 0; a < 2; ++a)
#pragma unroll
            for (int b = 0; b < 2; ++b)
#pragma unroll
                for (int m = 0; m < 4; ++m)
#pragma unroll
                    for (int n = 0; n < 2; ++n) acc[a][b][m][n] = (f32x4){0.f, 0.f, 0.f, 0.f};
        cur = nxt; cA = nA; cB = nB; ++ui;
        if (wr == 1) PG8_BAR;
    }
    PG8_WAIT_V(0);
    PG8_BAR;
#undef PG8_SA
#undef PG8_SB
#undef PG8_STAGE
#undef PG8_LDA
#undef PG8_LDB
#undef PG8_MMA
#undef PG8_WAIT_V
#undef PG8_WAIT_L
#undef PG8_BAR
#undef PG8_SCHED
}

typedef const f32x4 (&AccRef)[2][2][4][2];

struct EpiPlain {
    h16* O; int ldc;
    __device__ __forceinline__ void operator()(AccRef acc, const Unit& u, int wr, int wc, int fr, int fq) const {
        const int row0 = u.pm * BM + wr * 64 + fr, col0 = u.pn * BM + wc * 32 + 8 * fq;
#pragma unroll
        for (int ai = 0; ai < 2; ++ai)
#pragma unroll
            for (int m = 0; m < 4; ++m) { h16* rowp = O + (size_t)(row0 + ai * HALF + m * 16) * ldc + col0;
#pragma unroll
                for (int bj = 0; bj < 2; ++bj) { const f32x4 v0 = acc[ai][bj][m][0], v1 = acc[ai][bj][m][1];
                    u32x4 w; w.x = pkh(v0[0], v0[1]); w.y = pkh(v0[2], v0[3]); w.z = pkh(v1[0], v1[1]); w.w = pkh(v1[2], v1[3]);
                    *(u32x4*)(rowp + bj * HALF) = w; } }
    }
};

struct EpiInProj {
    const float* rs0; const float* rope; const float* gidx;
    h16 *QA, *KA, *VA, *QI, *KI, *QB, *KB, *VB; float* WI; float* kmp;
    __device__ __forceinline__ void operator()(AccRef acc, const Unit& u, int wr, int wc, int fr_in, int fq_in) const {
        int fr = fr_in, fq = fq_in; asm volatile("" : "+v"(fr), "+v"(fq));
        const int pn = u.pn;
        int type = 0; h16* dst = VA; int pitch = 64, cb = 0; float scl = 1.f; bool iskb = false;
        if (pn < 2) { type = 1; dst = QA; pitch = 512; cb = 256 * pn + 64 * wc; scl = C2; }
        else if (pn == 2) { if (wc == 0) { type = 1; dst = KA; } else if (wc == 1) { type = 0; dst = VA; } else if (wc == 2) { type = 2; dst = KI; } else { type = 3; } }
        else if (pn == 3) { type = 1; dst = QI; pitch = 256; cb = 64 * wc; }
        else if (pn < 6) { type = 1; dst = QB; pitch = 512; cb = 256 * (pn - 4) + 64 * wc; scl = C2; }
        else if (pn < 8) { type = 1; dst = KB; pitch = 512; cb = 256 * (pn - 6) + 64 * wc; iskb = true; }
        else { type = 0; dst = VB; pitch = 512; cb = 256 * (pn - 8) + 64 * wc; }
        float ks[2][2][4];
#pragma unroll
        for (int bj = 0; bj < 2; ++bj)
#pragma unroll
            for (int n = 0; n < 2; ++n)
#pragma unroll
                for (int e = 0; e < 4; ++e) ks[bj][n][e] = 0.f;
        float gl[2][2][4];
        if (type == 2) {
#pragma unroll
            for (int bj = 0; bj < 2; ++bj)
#pragma unroll
                for (int n = 0; n < 2; ++n)
#pragma unroll
                    for (int e = 0; e < 4; ++e) gl[bj][n][e] = gidx[32 * bj + 8 * fq + 4 * n + e];
        }
#pragma unroll
        for (int ai = 0; ai < 2; ++ai)
#pragma unroll
            for (int m = 0; m < 4; ++m) {
                const int row = u.pm * BM + ai * HALF + wr * 64 + m * 16 + fr;
                const float s = rs0[row];
                float v[2][2][4];
#pragma unroll
                for (int bj = 0; bj < 2; ++bj)
#pragma unroll
                    for (int n = 0; n < 2; ++n)
#pragma unroll
                        for (int e = 0; e < 4; ++e) v[bj][n][e] = acc[ai][bj][m][n][e] * s;
                if (type == 3) {
                    if (fq == 0) *(f32x4*)(WI + (size_t)row * 4) = (f32x4){v[0][0][0] * 0.0625f, v[0][0][1] * 0.0625f, v[0][0][2] * 0.0625f, v[0][0][3] * 0.0625f};
                    continue;
                }
                if (type == 2) {
                    float sum = 0.f;
#pragma unroll
                    for (int bj = 0; bj < 2; ++bj)
#pragma unroll
                        for (int n = 0; n < 2; ++n)
#pragma unroll
                            for (int e = 0; e < 4; ++e) sum += v[bj][n][e];
                    sum += __shfl_xor(sum, 16); sum += __shfl_xor(sum, 32);
                    const float mean = sum * (1.f / 64.f); float q = 0.f;
#pragma unroll
                    for (int bj = 0; bj < 2; ++bj)
#pragma unroll
                        for (int n = 0; n < 2; ++n)
#pragma unroll
                            for (int e = 0; e < 4; ++e) { v[bj][n][e] -= mean; q += v[bj][n][e] * v[bj][n][e]; }
                    q += __shfl_xor(q, 16); q += __shfl_xor(q, 32);
                    const float rstd = 1.0f / sqrtf(q * (1.f / 64.f) + EPS);
#pragma unroll
                    for (int bj = 0; bj < 2; ++bj)
#pragma unroll
                        for (int n = 0; n < 2; ++n)
#pragma unroll
                            for (int e = 0; e < 4; ++e) v[bj][n][e] = v[bj][n][e] * rstd * gl[bj][n][e];
                }
                if (type >= 1) {
                    const int pos = row & (SEQ - 1);
                    const f32x4* cs = (const f32x4*)(rope + ((size_t)pos * 32 + 8 * fq) * 2);
#pragma unroll
                    for (int n = 0; n < 2; ++n) { const f32x4 c01 = cs[2 * n], c23 = cs[2 * n + 1];
                        const float cc[4] = {c01[0], c01[2], c23[0], c23[2]}, sn[4] = {c01[1], c01[3], c23[1], c23[3]};
#pragma unroll
                        for (int e = 0; e < 4; ++e) { const float lo = v[0][n][e], hi = v[1][n][e]; v[0][n][e] = lo * cc[e] - hi * sn[e]; v[1][n][e] = hi * cc[e] + lo * sn[e]; } }
                }
#pragma unroll
                for (int bj = 0; bj < 2; ++bj) {
#pragma unroll
                    for (int n = 0; n < 2; ++n)
#pragma unroll
                        for (int e = 0; e < 4; ++e) { v[bj][n][e] *= scl; ks[bj][n][e] += v[bj][n][e]; }
                    u32x4 w; w.x = pkh(v[bj][0][0], v[bj][0][1]); w.y = pkh(v[bj][0][2], v[bj][0][3]); w.z = pkh(v[bj][1][0], v[bj][1][1]); w.w = pkh(v[bj][1][2], v[bj][1][3]);
                    *(u32x4*)(dst + (size_t)row * pitch + cb + 32 * bj + 8 * fq) = w;
                }
                __builtin_amdgcn_sched_barrier(0);
            }
        if (iskb) {
#pragma unroll
            for (int bj = 0; bj < 2; ++bj)
#pragma unroll
                for (int n = 0; n < 2; ++n)
#pragma unroll
                    for (int e = 0; e < 4; ++e) { float t = ks[bj][n][e]; t += __shfl_xor(t, 1); t += __shfl_xor(t, 2); t += __shfl_xor(t, 4); t += __shfl_xor(t, 8); ks[bj][n][e] = t; }
            if (fr == 0) { const int head = 4 * (pn - 6) + wc; float* o = kmp + (((size_t)u.pm * 2 + wr) * 8 + head) * 64;
#pragma unroll
                for (int bj = 0; bj < 2; ++bj)
#pragma unroll
                    for (int n = 0; n < 2; ++n) *(f32x4*)(o + 32 * bj + 8 * fq + 4 * n) = (f32x4){ks[bj][n][0], ks[bj][n][1], ks[bj][n][2], ks[bj][n][3]}; }
        }
    }
};

template <bool BASE_F32> struct EpiRes {
    const void* base; h16* out; float* ssp;
    __device__ __forceinline__ void operator()(AccRef acc, const Unit& u, int wr, int wc, int fr, int fq) const {
        const int col0 = u.pn * BM + wc * 32 + 8 * fq;
#pragma unroll
        for (int ai = 0; ai < 2; ++ai)
#pragma unroll
            for (int m = 0; m < 4; ++m) { const int row = u.pm * BM + ai * HALF + wr * 64 + m * 16 + fr; float ss = 0.f;
#pragma unroll
                for (int bj = 0; bj < 2; ++bj) { const size_t off = (size_t)row * DM + col0 + bj * HALF; float b[8];
                    if (BASE_F32) { const f32x4 b0 = *(const f32x4*)((const float*)base + off), b1 = *(const f32x4*)((const float*)base + off + 4);
                        b[0] = b0[0]; b[1] = b0[1]; b[2] = b0[2]; b[3] = b0[3]; b[4] = b1[0]; b[5] = b1[1]; b[6] = b1[2]; b[7] = b1[3]; }
                    else { const h16x8 hb = *(const h16x8*)((const h16*)base + off);
#pragma unroll
                        for (int e = 0; e < 8; ++e) b[e] = (float)hb[e]; }
                    float v[8];
#pragma unroll
                    for (int e = 0; e < 8; ++e) { v[e] = b[e] + acc[ai][bj][m][e >> 2][e & 3]; ss += v[e] * v[e]; }
                    u32x4 w; w.x = pkh(v[0], v[1]); w.y = pkh(v[2], v[3]); w.z = pkh(v[4], v[5]); w.w = pkh(v[6], v[7]);
                    *(u32x4*)(out + off) = w; }
                ss += __shfl_xor(ss, 16); ss += __shfl_xor(ss, 32);
                if (fq == 0) ssp[(size_t)row * 16 + u.pn * 4 + wc] = ss; }
    }
};
__device__ __forceinline__ float row_rstd(const float* ssp, int row) {
    const f32x4* p = (const f32x4*)(ssp + (size_t)row * 16); const f32x4 a = p[0], b = p[1], c = p[2], d = p[3];
    const float s = ((a[0] + a[1]) + (a[2] + a[3])) + ((b[0] + b[1]) + (b[2] + b[3])) + ((c[0] + c[1]) + (c[2] + c[3])) + ((d[0] + d[1]) + (d[2] + d[3]));
    return 1.0f / sqrtf(s * (1.0f / DM) + EPS);
}
struct EpiSwiGLU {
    const float* ssp; h16* act;
    __device__ __forceinline__ void operator()(AccRef acc, const Unit& u, int wr, int wc, int fr, int fq) const {
        const int col0 = u.pn * HALF + wc * 32 + 8 * fq;
#pragma unroll
        for (int ai = 0; ai < 2; ++ai)
#pragma unroll
            for (int m = 0; m < 4; ++m) { const int row = u.pm * BM + ai * HALF + wr * 64 + m * 16 + fr; const float s = row_rstd(ssp, row); float v[8];
#pragma unroll
                for (int e = 0; e < 8; ++e) { const float gt = acc[ai][0][m][e >> 2][e & 3] * s, up = acc[ai][1][m][e >> 2][e & 3] * s; v[e] = gt * fast_sigmoid(gt) * up; }
                u32x4 w; w.x = pkh(v[0], v[1]); w.y = pkh(v[2], v[3]); w.z = pkh(v[4], v[5]); w.w = pkh(v[6], v[7]);
                *(u32x4*)(act + (size_t)row * DFF + col0) = w; }
    }
};
struct EpiPLE {
    const float* ssp2; const h16* h2; const h16* pp; float* out; float* ssp3;
    __device__ __forceinline__ void operator()(AccRef acc, const Unit& u, int wr, int wc, int fr, int fq) const {
        const int col0 = u.pn * BM + wc * 32 + 8 * fq;
#pragma unroll
        for (int ai = 0; ai < 2; ++ai)
#pragma unroll
            for (int m = 0; m < 4; ++m) { const int row = u.pm * BM + ai * HALF + wr * 64 + m * 16 + fr; const float s = row_rstd(ssp2, row); float ss = 0.f;
#pragma unroll
                for (int bj = 0; bj < 2; ++bj) { const size_t off = (size_t)row * DM + col0 + bj * HALF;
                    const h16x8 hb = *(const h16x8*)(h2 + off), pb = *(const h16x8*)(pp + off); float v[8];
#pragma unroll
                    for (int e = 0; e < 8; ++e) { v[e] = (float)hb[e] + fast_sigmoid(acc[ai][bj][m][e >> 2][e & 3] * s) * (float)pb[e]; ss += v[e] * v[e]; }
                    *(f32x4*)(out + off) = (f32x4){v[0], v[1], v[2], v[3]}; *(f32x4*)(out + off + 4) = (f32x4){v[4], v[5], v[6], v[7]}; }
                ss += __shfl_xor(ss, 16); ss += __shfl_xor(ss, 32);
                if (fq == 0) ssp3[(size_t)row * 16 + u.pn * 4 + wc] = ss; }
    }
};
}

template <class ColMap>
__device__ __forceinline__ void transpose_items(int K, int Nsrc, h16* WT, int Nrows, ColMap cm, const float* __restrict__ kscale, LAS float* scr, int gw, int NGW, int lane) {
    const int nblk = Nrows / 32, items = (K / 64) * nblk;
    for (int it = gw; it < items; it += NGW) {
        const int kb = it / nblk, nb = it % nblk, k0 = 64 * kb, n0 = 32 * nb;
        const float* src = cm(n0 + (lane & 31));
#pragma unroll 8
        for (int i = 0; i < 32; ++i) { const int kk = 2 * i + (lane >> 5); float v = 0.f;
            if (src) { v = src[(size_t)(k0 + kk) * Nsrc]; if (kscale) v *= kscale[k0 + kk]; }
            scr[kk * 33 + (lane & 31)] = v; }
        asm volatile("s_waitcnt lgkmcnt(0)" ::: "memory");
        const int c = lane & 7;
#pragma unroll
        for (int j = 0; j < 4; ++j) { const int n = (lane >> 3) + 8 * j; const LAS float* s = scr + (8 * c) * 33 + n;
            u32x4 o; o.x = pkh(s[0 * 33], s[1 * 33]); o.y = pkh(s[2 * 33], s[3 * 33]); o.z = pkh(s[4 * 33], s[5 * 33]); o.w = pkh(s[6 * 33], s[7 * 33]);
            *(u32x4*)(WT + (size_t)(n0 + n) * K + k0 + 8 * c) = o; }
        asm volatile("s_waitcnt lgkmcnt(0)" ::: "memory");
    }
}
__device__ __forceinline__ int win_colmap(int np) {
    const int pn = np >> 8, p = np & 255, bj = p >> 7, wc = (p >> 5) & 3, r = p & 31;
    const int LC = 256 * pn + 64 * wc + 32 * bj + r;
    if (LC < 512) return LC;
    if (LC < 576) return LC;
    if (LC < 640) return LC;
    if (LC < 704) return 896 + (LC - 640);
    if (LC < 708) return 960 + (LC - 704);
    if (LC < 768) return -1;
    if (LC < 1024) return 640 + (LC - 768);
    if (LC < 1536) return 964 + (LC - 1024);
    if (LC < 2048) return 1476 + (LC - 1536);
    return 1988 + (LC - 2048);
}

constexpr int DSA_LDS_RED = 0  , DSA_LDS_FRED = 1024  , DSA_LDS_CNT = 2048  , DSA_LDS_LIST = 2176  , DSA_LDS_VBUF = 10496  , DSA_LDS_QF = 84224  ;
constexpr int VROW = 144;

struct AttnPtrs { const h16 *QA, *KA, *VA, *QI, *KI, *QB, *KB, *VB; const float* WI; const float* kmp; h16* Y; };

__device__ __forceinline__ void cnt_ge(int& c, float s, float tau) { asm volatile("v_cmp_ge_f32 vcc, %1, %2\n\tv_addc_co_u32 %0, vcc, 0, %0, vcc" : "+v"(c) : "v"(s), "v"(tau) : "vcc"); }
__device__ __forceinline__ void cnt_gt(int& c, float s, float tau) { asm volatile("v_cmp_gt_f32 vcc, %1, %2\n\tv_addc_co_u32 %0, vcc, 0, %0, vcc" : "+v"(c) : "v"(s), "v"(tau) : "vcc"); }
__device__ __forceinline__ void cnt_tie(int& c, float s, float t3, int key, int im) { unsigned long long tmp;
    asm volatile("v_cmp_eq_f32 vcc, %2, %3\n\tv_cmp_le_i32 %1, %4, %5\n\ts_and_b64 vcc, vcc, %1\n\tv_addc_co_u32 %0, vcc, 0, %0, vcc" : "+v"(c), "=&s"(tmp) : "v"(s), "v"(t3), "v"(key), "v"(im) : "vcc"); }
__device__ __forceinline__ int dsa_count_ge(const f32x4 (&S)[8][4], int nch, float tau) {
    int c = 0;
#pragma unroll
    for (int ch = 0; ch < 8; ++ch) if (ch < nch) {
#pragma unroll
        for (int tt = 0; tt < 4; ++tt)
#pragma unroll
            for (int i = 0; i < 4; ++i) cnt_ge(c, S[ch][tt][i], tau);
    }
    return c;
}
__device__ __forceinline__ int dsa_total(int c, LAS unsigned* red, int par, int wid, int q16, int g) {
    c += __shfl_xor(c, 16); c += __shfl_xor(c, 32);
    if (g == 0) red[(par * 8 + wid) * 16 + q16] = (unsigned)c;
    __syncthreads();
    int t = 0;
#pragma unroll
    for (int w = 0; w < 8; ++w) t += (int)red[(par * 8 + w) * 16 + q16];
    return t;
}

__device__ __forceinline__ void dsa_unit(LAS unsigned char* lds, const AttnPtrs& P, int b, int qt) {
    const int tid = threadIdx.x, lane = tid & 63, wid = __builtin_amdgcn_readfirstlane(tid >> 6), q16 = lane & 15, g = lane >> 4;
    LAS unsigned* red = (LAS unsigned*)(lds + DSA_LDS_RED); LAS float* fred = (LAS float*)(lds + DSA_LDS_FRED);
    LAS unsigned* cnt = (LAS unsigned*)(lds + DSA_LDS_CNT); LAS unsigned short* list = (LAS unsigned short*)(lds + DSA_LDS_LIST);
    const int t0 = qt * 16, myq = t0 + q16; const size_t brow = (size_t)b * SEQ;
    const int nch = (t0 + 15) / 512 + 1;
    if (tid < 16) cnt[tid] = 0u;
    f32x4 S[8][4];
#pragma unroll
    for (int ch = 0; ch < 8; ++ch)
#pragma unroll
        for (int tt = 0; tt < 4; ++tt) S[ch][tt] = (f32x4){NEG_INF, NEG_INF, NEG_INF, NEG_INF};
    float smax = NEG_INF, smin = -NEG_INF;
    {
        LAS h16x8* qfl = (LAS h16x8*)(lds + DSA_LDS_QF);
        qfl[wid * 64 + lane] = *(const h16x8*)(P.QI + (brow + myq) * 256 + (wid >> 1) * 64 + (wid & 1) * 32 + g * 8);
        __syncthreads();
        const f32x4 wv = *(const f32x4*)(P.WI + (brow + myq) * 4);
#ifndef X_NOSCORE
        for (int rep_sc = 0; rep_sc < REP_SC; ++rep_sc) {
        h16x8 pa0 = *(const h16x8*)(P.KI + (brow + 64 * wid + q16) * 64 + g * 8), pa1 = *(const h16x8*)(P.KI + (brow + 64 * wid + q16) * 64 + 32 + g * 8);
#pragma unroll
        for (int ch = 0; ch < 8; ++ch) if (ch < nch) {
#pragma unroll
            for (int tt = 0; tt < 4; ++tt) {
                const int kt = 512 * ch + 64 * wid + 16 * tt;
                const h16x8 a0 = pa0, a1 = pa1;
                { const int nidx = ch * 4 + tt + 1; int kn = 512 * (nidx >> 2) + 64 * wid + 16 * (nidx & 3); kn = kn < SEQ - 16 ? kn : SEQ - 16;
                  pa0 = *(const h16x8*)(P.KI + (brow + kn + q16) * 64 + g * 8); pa1 = *(const h16x8*)(P.KI + (brow + kn + q16) * 64 + 32 + g * 8); }
                if (kt <= t0 + 15) {
                    f32x4 sc = {0.f, 0.f, 0.f, 0.f};
#pragma unroll
                    for (int h = 0; h < 4; ++h) { f32x4 acc = {0.f, 0.f, 0.f, 0.f};
                        const h16x8 b0 = qfl[(2 * h) * 64 + lane], b1 = qfl[(2 * h + 1) * 64 + lane];
                        acc = __builtin_amdgcn_mfma_f32_16x16x32_f16(a0, b0, acc, 0, 0, 0);
                        acc = __builtin_amdgcn_mfma_f32_16x16x32_f16(a1, b1, acc, 0, 0, 0);
#pragma unroll
                        for (int i = 0; i < 4; ++i) sc[i] += wv[h] * __builtin_fmaxf(acc[i], 0.f); }
                    const int key0 = kt + 4 * g;
#pragma unroll
                    for (int i = 0; i < 4; ++i) { const bool ok = (key0 + i) <= myq; const float v = ok ? sc[i] : NEG_INF; sc[i] = v; smax = __builtin_fmaxf(smax, v); smin = __builtin_fminf(smin, ok ? v : -NEG_INF); }
                    S[ch][tt] = sc;
                }
                __builtin_amdgcn_sched_barrier(0);
            }
        }
        }
#endif
    }
    smax = __builtin_fmaxf(smax, __shfl_xor(smax, 16)); smax = __builtin_fmaxf(smax, __shfl_xor(smax, 32));
    smin = __builtin_fminf(smin, __shfl_xor(smin, 16)); smin = __builtin_fminf(smin, __shfl_xor(smin, 32));
    if (g == 0) { fred[(wid * 16 + q16) * 2] = smax; fred[(wid * 16 + q16) * 2 + 1] = smin; }
    __syncthreads();
#pragma unroll
    for (int w = 0; w < 8; ++w) { smax = __builtin_fmaxf(smax, fred[(w * 16 + q16) * 2]); smin = __builtin_fminf(smin, fred[(w * 16 + q16) * 2 + 1]); }
    const int nv = myq + 1; int par = 0;
    float T1, T2, T3; int mode; float lo, hi; int istar;
    for (int rep_sel = 0; rep_sel < REP_SEL; ++rep_sel) {
    T1 = -NEG_INF; T2 = -NEG_INF; T3 = -NEG_INF; mode = 0; lo = 0.f; hi = 0.f;
    {
        int c2 = 0, c3 = 0; float zero_v = 0.f; asm volatile("" : "+v"(zero_v));
#pragma unroll
        for (int ch = 0; ch < 8; ++ch) if (ch < nch) {
#pragma unroll
            for (int tt = 0; tt < 4; ++tt)
#pragma unroll
                for (int i = 0; i < 4; ++i) { const float s = S[ch][tt][i]; cnt_ge(c2, s, zero_v); cnt_gt(c3, s, zero_v); }
        }
        const int tot = dsa_total(c2 + (c3 << 16), red, par, wid, q16, g); par ^= 1;
        const int cge = tot & 0xffff, cgt = tot >> 16;
        if (nv <= 256) { mode = 1; T2 = -3.0e38f; }
        else if (cgt == 256) { mode = 1; T1 = 0.f; }
        else if (cge == 256) { mode = 1; T2 = 0.f; }
        else if (cgt < 256 && cge > 256) { mode = 2; T1 = 0.f; T3 = 0.f; }
        else if (cgt > 256) { lo = 0.f; hi = __uint_as_float(__float_as_uint(smax) + 1u); }
        else { lo = smin; hi = 0.f; }
    }
#ifndef X_NOBIS
    while (__any(mode == 0)) {
        const float mid = (mode == 0) ? (lo + (hi - lo) * 0.5f) : -NEG_INF;
        const int c = dsa_total(dsa_count_ge(S, nch, mid), red, par, wid, q16, g); par ^= 1;
        if (mode == 0) {
            if (c == 256) { mode = 1; T2 = mid; }
            else { if (c > 256) lo = mid; else hi = mid;
                   const float nm = lo + (hi - lo) * 0.5f;
                   if (!(nm > lo && nm < hi)) { mode = 2; T1 = lo; T3 = lo; } }
        }
    }
#endif
    istar = -1;
#ifndef X_NOTIE
    if (__any(mode == 2)) {
        const int kb0 = 64 * wid + 4 * g;
        int cg = 0;
#pragma unroll
        for (int ch = 0; ch < 8; ++ch) if (ch < nch) {
#pragma unroll
            for (int tt = 0; tt < 4; ++tt)
#pragma unroll
                for (int i = 0; i < 4; ++i) cnt_gt(cg, S[ch][tt][i], T1);
        }
        cg = dsa_total(cg, red, par, wid, q16, g); par ^= 1;
        const int R = 256 - cg; int ilo = -1, ihi = myq;
        while (__any(mode == 2 && ihi - ilo > 1)) {
            const int im = (mode == 2) ? ((ilo + ihi) >> 1) : -1;
            int c = 0;
#pragma unroll
            for (int ch = 0; ch < 8; ++ch) if (ch < nch) {
#pragma unroll
                for (int tt = 0; tt < 4; ++tt)
#pragma unroll
                    for (int i = 0; i < 4; ++i) cnt_tie(c, S[ch][tt][i], T3, kb0, im - (512 * ch + 16 * tt + i));
            }
            c = dsa_total(c, red, par, wid, q16, g); par ^= 1;
            if (mode == 2 && ihi - ilo > 1) { if (c >= R) ihi = im; else ilo = im; }
        }
        if (mode == 2) istar = ihi;
    }
#endif
    }
#ifndef X_NOEMIT
    for (int rep_em = 0; rep_em < REP_EM; ++rep_em) {
        if (rep_em > 0) { __syncthreads(); if (tid < 16) cnt[tid] = 0u; __syncthreads(); }
        const int kb0 = 64 * wid + 4 * g;
#pragma unroll
        for (int ch = 0; ch < 8; ++ch) if (ch < nch) {
#pragma unroll
            for (int tt = 0; tt < 4; ++tt)
#pragma unroll
                for (int i = 0; i < 4; ++i) { const float s = S[ch][tt][i]; const int key = kb0 + 512 * ch + 16 * tt + i;
                    const bool sel = (s > T1) || (s >= T2) || (s == T3 && key <= istar);
                    if (sel) { const unsigned pos = __hip_atomic_fetch_add(cnt + q16, 1u, __ATOMIC_RELAXED, __HIP_MEMORY_SCOPE_WORKGROUP); if (pos < 256u) list[q16 * 256 + pos] = (unsigned short)key; } }
        }
    }
    __syncthreads();
#endif
#ifndef X_NOATT
    int lane_o = lane;
    {
    LAS unsigned char* vbuf = lds + DSA_LDS_VBUF + wid * (2 * 32 * VROW);
#pragma unroll 1
    for (int qq2 = 0; qq2 < 2 * REP_ATT; ++qq2) { const int qq = qq2 & 1;
        asm volatile("" : "+v"(lane_o));
        const int lane = lane_o, q16 = lane & 15, g = lane >> 4;
        const int ql = 2 * wid + qq; const int qpos = t0 + ql; const int n = (qpos + 1 < 256) ? qpos + 1 : 256;
        const LAS unsigned short* ql_list = list + ql * 256;
        const int head = q16 & 7;
        h16x8 qf[2];
#pragma unroll
        for (int ks = 0; ks < 2; ++ks) qf[ks] = *(const h16x8*)(P.QA + (brow + qpos) * 512 + head * 64 + ks * 32 + g * 8);
        f32x4 L[16];
        {
            h16x8 ka[2][2][2];
#pragma unroll
            for (int u = 0; u < 2; ++u) { const int e = 16 * u + q16; const int key = (e < n) ? (int)ql_list[e] : 0;
                ka[0][u][0] = *(const h16x8*)(P.KA + (brow + key) * 64 + g * 8); ka[0][u][1] = *(const h16x8*)(P.KA + (brow + key) * 64 + 32 + g * 8); }
#pragma unroll
            for (int gi = 0; gi < 8; ++gi) {
                if (gi < 7) {
#pragma unroll
                    for (int u = 0; u < 2; ++u) { const int e = 16 * (2 * (gi + 1) + u) + q16; const int key = (e < n) ? (int)ql_list[e] : 0;
                        ka[(gi + 1) & 1][u][0] = *(const h16x8*)(P.KA + (brow + key) * 64 + g * 8); ka[(gi + 1) & 1][u][1] = *(const h16x8*)(P.KA + (brow + key) * 64 + 32 + g * 8); }
                }
#pragma unroll
                for (int u = 0; u < 2; ++u) { const int T = 2 * gi + u;
                    f32x4 acc = {0.f, 0.f, 0.f, 0.f};
                    acc = __builtin_amdgcn_mfma_f32_16x16x32_f16(ka[gi & 1][u][0], qf[0], acc, 0, 0, 0);
                    acc = __builtin_amdgcn_mfma_f32_16x16x32_f16(ka[gi & 1][u][1], qf[1], acc, 0, 0, 0);
#pragma unroll
                    for (int i = 0; i < 4; ++i) if (16 * T + 4 * g + i >= n) acc[i] = NEG_INF;
                    L[T] = acc; }
                __builtin_amdgcn_sched_barrier(0);
            }
        }
        float mx = NEG_INF;
#pragma unroll
        for (int T = 0; T < 16; ++T)
#pragma unroll
            for (int i = 0; i < 4; ++i) mx = __builtin_fmaxf(mx, L[T][i]);
        mx = __builtin_fmaxf(mx, __shfl_xor(mx, 16)); mx = __builtin_fmaxf(mx, __shfl_xor(mx, 32));
        float lsum = 0.f;
#pragma unroll
        for (int T = 0; T < 16; ++T)
#pragma unroll
            for (int i = 0; i < 4; ++i) { const float p = __builtin_amdgcn_exp2f(L[T][i] - mx); L[T][i] = p; lsum += p; }
        lsum += __shfl_xor(lsum, 16); lsum += __shfl_xor(lsum, 32);
        __builtin_amdgcn_sched_barrier(0);
        f32x4 O[4];
#pragma unroll
        for (int db = 0; db < 4; ++db) O[db] = (f32x4){0.f, 0.f, 0.f, 0.f};
        u32x4 vreg[4];
#pragma unroll
        for (int i = 0; i < 4; ++i) { const int j = lane >> 3; const int e = 16 * (j >> 2) + 4 * i + (j & 3); const int key = (e < n) ? (int)ql_list[e] : 0;
            vreg[i] = *(const u32x4*)(P.VA + (brow + key) * 64 + 8 * (lane & 7)); }
#pragma unroll
        for (int cc = 0; cc < 8; ++cc) {
            LAS unsigned char* vb = vbuf + (cc & 1) * (32 * VROW);
#pragma unroll
            for (int i = 0; i < 4; ++i) *(LAS u32x4*)(vb + (8 * i + (lane >> 3)) * VROW + 16 * (lane & 7)) = vreg[i];
            if (cc < 7) {
#pragma unroll
                for (int i = 0; i < 4; ++i) { const int j = lane >> 3; const int e = 16 * (2 * (cc + 1) + (j >> 2)) + 4 * i + (j & 3); const int key = (e < n) ? (int)ql_list[e] : 0;
                    vreg[i] = *(const u32x4*)(P.VA + (brow + key) * 64 + 8 * (lane & 7)); }
            }
            asm volatile("s_waitcnt lgkmcnt(0)" ::: "memory");
            h16x8 pa;
#pragma unroll
            for (int i = 0; i < 4; ++i) { pa[i] = (h16)L[2 * cc][i]; pa[4 + i] = (h16)L[2 * cc + 1][i]; }
#pragma unroll
            for (int db = 0; db < 4; ++db) {
                const LAS unsigned char* pb = vb + (8 * g + ((lane & 15) >> 2)) * VROW + (16 * db + 4 * (lane & 3)) * 2;
                const s16x4 lo4 = __builtin_amdgcn_ds_read_tr16_b64_v4i16((LAS s16x4*)pb);
                const s16x4 hi4 = __builtin_amdgcn_ds_read_tr16_b64_v4i16((LAS s16x4*)(pb + 4 * VROW));
                const s16x8 bf = {lo4[0], lo4[1], lo4[2], lo4[3], hi4[0], hi4[1], hi4[2], hi4[3]};
                O[db] = __builtin_amdgcn_mfma_f32_16x16x32_f16(pa, __builtin_bit_cast(h16x8, bf), O[db], 0, 0, 0);
            }
            __builtin_amdgcn_sched_barrier(0);
        }
#pragma unroll
        for (int i = 0; i < 4; ++i) { const float lh = __shfl(lsum, (4 * g + i) & 7); const float rl = 1.0f / lh;
            if (g < 2) {
#pragma unroll
                for (int db = 0; db < 4; ++db) P.Y[(brow + qpos) * DM + (4 * g + i) * 64 + 16 * db + q16] = (h16)(O[db][i] * rl); } }
    }
    }
#endif
    __syncthreads();
}

constexpr int MB_LDS_KM = 0  , MB_LDS_KV = 4096  , MB_TILE = 64 * VROW;
__device__ __forceinline__ int crow(int r, int hi) { return (r & 3) + 8 * (r >> 2) + 4 * hi; }

__device__ __forceinline__ void moba_unit(LAS unsigned char* lds, const AttnPtrs& P, int b, int h, int j) {
    const int tid = threadIdx.x, lane = tid & 63, wid = __builtin_amdgcn_readfirstlane(tid >> 6), r32 = lane & 31, hi = lane >> 5;
    const size_t brow = (size_t)b * SEQ; const int q0 = 256 * j; const int qrel = 32 * wid + r32; const size_t qrow = brow + q0 + qrel;
    LAS float* km = (LAS float*)(lds + MB_LDS_KM);
    for (int i = tid; i < 16 * 64; i += 512) { const int n = i >> 6, d = i & 63; const size_t pm = (size_t)b * 16 + n;
        km[i] = (P.kmp[((pm * 2 + 0) * 8 + h) * 64 + d] + P.kmp[((pm * 2 + 1) * 8 + h) * 64 + d]) * (1.0f / 256.0f); }
    __syncthreads();
    h16x8 qf[4];
#pragma unroll
    for (int d0 = 0; d0 < 4; ++d0) qf[d0] = *(const h16x8*)(P.QB + qrow * 512 + h * 64 + d0 * 16 + hi * 8);
    unsigned selmask = 0u;
    {
        float gate[8];
#pragma unroll
        for (int nb = 0; nb < 8; ++nb) gate[nb] = 0.f;
#pragma unroll
        for (int c8 = 0; c8 < 8; ++c8) {
            const h16x8 qv = *(const h16x8*)(P.QB + qrow * 512 + h * 64 + c8 * 8);
#pragma unroll
            for (int nb = 0; nb < 8; ++nb) { const LAS float* kr = km + (8 * hi + nb) * 64 + c8 * 8;
#pragma unroll
                for (int e = 0; e < 8; ++e) gate[nb] += (float)qv[e] * kr[e]; }
        }
        float gall[16];
#pragma unroll
        for (int nb = 0; nb < 8; ++nb) { const float o = __shfl_xor(gate[nb], 32); gall[nb] = hi ? o : gate[nb]; gall[8 + nb] = hi ? gate[nb] : o; }
#pragma unroll
        for (int n = 0; n < 16; ++n) if (n >= j) gall[n] = NEG_INF;
#pragma unroll
        for (int pick = 0; pick < 3; ++pick) { float best = NEG_INF; int bi = -1;
#pragma unroll
            for (int n = 0; n < 16; ++n) if (gall[n] > best) { best = gall[n]; bi = n; }
            if (bi >= 0) { selmask |= 1u << bi;
#pragma unroll
                for (int n = 0; n < 16; ++n) if (n == bi) gall[n] = NEG_INF; } }
    }
    const int NT = 4 * (j + 1);
    const h16* Kg = P.KB + brow * 512 + h * 64; const h16* Vg = P.VB + brow * 512 + h * 64;
    const int lrow = tid >> 3, lch = tid & 7;
    auto tile_key0 = [&](int t) { return (t < 4) ? (q0 + 64 * t) : (64 * (t - 4)); };
    u32x4 kreg, vreg;
    { const int k0 = tile_key0(0); kreg = *(const u32x4*)(Kg + (size_t)(k0 + lrow) * 512 + lch * 8); vreg = *(const u32x4*)(Vg + (size_t)(k0 + lrow) * 512 + lch * 8); }
    { LAS unsigned char* kb = lds + MB_LDS_KV; *(LAS u32x4*)(kb + lrow * VROW + lch * 16) = kreg; *(LAS u32x4*)(kb + MB_TILE + lrow * VROW + lch * 16) = vreg; }
    __syncthreads();
    float mrun = NEG_INF, lrun = 0.f; f32x16 o[2]; o[0] = f32x16{}; o[1] = f32x16{};
#pragma unroll 1
    for (int t = 0; t < NT; ++t) {
        if (t + 1 < NT) { const int k0 = tile_key0(t + 1); kreg = *(const u32x4*)(Kg + (size_t)(k0 + lrow) * 512 + lch * 8); vreg = *(const u32x4*)(Vg + (size_t)(k0 + lrow) * 512 + lch * 8); }
        const LAS unsigned char* kb = lds + MB_LDS_KV + (t & 1) * (2 * MB_TILE); const LAS unsigned char* vb = kb + MB_TILE;
        bool active;
        if (t < 4) active = (64 * t) <= (32 * wid + 31);
        else active = __any((selmask >> ((t - 4) >> 2)) & 1u);
        if (active) {
            f32x16 p0 = f32x16{}, p1 = f32x16{};
#pragma unroll
            for (int d0 = 0; d0 < 4; ++d0) {
                const h16x8 k0f = *(const LAS h16x8*)(kb + r32 * VROW + (16 * d0 + 8 * hi) * 2);
                const h16x8 k1f = *(const LAS h16x8*)(kb + (32 + r32) * VROW + (16 * d0 + 8 * hi) * 2);
                p0 = __builtin_amdgcn_mfma_f32_32x32x16_f16(k0f, qf[d0], p0, 0, 0, 0);
                p1 = __builtin_amdgcn_mfma_f32_32x32x16_f16(k1f, qf[d0], p1, 0, 0, 0);
            }
            if (t < 4) {
#pragma unroll
                for (int r = 0; r < 16; ++r) { const int kv = 64 * t + crow(r, hi); if (kv > qrel) p0[r] = NEG_INF; if (kv + 32 > qrel) p1[r] = NEG_INF; }
            } else if (!((selmask >> ((t - 4) >> 2)) & 1u)) {
#pragma unroll
                for (int r = 0; r < 16; ++r) { p0[r] = NEG_INF; p1[r] = NEG_INF; }
            }
            float mt = NEG_INF;
#pragma unroll
            for (int r = 0; r < 16; ++r) mt = __builtin_fmaxf(mt, __builtin_fmaxf(p0[r], p1[r]));
            mt = __builtin_fmaxf(mt, __shfl_xor(mt, 32));
            const float mnew = __builtin_fmaxf(mrun, mt);
            const float alpha = (mnew == NEG_INF) ? 1.0f : __builtin_amdgcn_exp2f(mrun - mnew);
            const float msub = (mnew == NEG_INF) ? 0.f : mnew;
            float ps = 0.f;
#pragma unroll
            for (int r = 0; r < 16; ++r) { p0[r] = __builtin_amdgcn_exp2f(p0[r] - msub); p1[r] = __builtin_amdgcn_exp2f(p1[r] - msub); ps += p0[r] + p1[r]; }
            lrun = lrun * alpha + ps; mrun = mnew;
            if (__any(alpha != 1.0f)) {
#pragma unroll
                for (int r = 0; r < 16; ++r) { o[0][r] *= alpha; o[1][r] *= alpha; }
            }
#pragma unroll
            for (int kt = 0; kt < 2; ++kt)
#pragma unroll
                for (int s = 0; s < 2; ++s) {
                    h16x8 pb;
#pragma unroll
                    for (int e = 0; e < 8; ++e) pb[e] = (h16)(kt ? p1[8 * s + e] : p0[8 * s + e]);
#pragma unroll
                    for (int db = 0; db < 2; ++db) {
                        const LAS unsigned char* pa = vb + (32 * kt + 16 * s + 4 * hi + ((lane & 15) >> 2)) * VROW + (32 * db + 16 * ((lane >> 4) & 1) + 4 * (lane & 3)) * 2;
                        const s16x4 lo4 = __builtin_amdgcn_ds_read_tr16_b64_v4i16((LAS s16x4*)pa);
                        const s16x4 hi4 = __builtin_amdgcn_ds_read_tr16_b64_v4i16((LAS s16x4*)(pa + 8 * VROW));
                        const s16x8 af = {lo4[0], lo4[1], lo4[2], lo4[3], hi4[0], hi4[1], hi4[2], hi4[3]};
                        o[db] = __builtin_amdgcn_mfma_f32_32x32x16_f16(__builtin_bit_cast(h16x8, af), pb, o[db], 0, 0, 0);
                    }
                }
        }
        if (t + 1 < NT) { LAS unsigned char* nb = lds + MB_LDS_KV + ((t + 1) & 1) * (2 * MB_TILE); *(LAS u32x4*)(nb + lrow * VROW + lch * 16) = kreg; *(LAS u32x4*)(nb + MB_TILE + lrow * VROW + lch * 16) = vreg; }
        __syncthreads();
    }
    lrun += __shfl_xor(lrun, 32);
    const float rl = 1.0f / lrun;
    h16* yrow = P.Y + qrow * DM + 512 + h * 64;
#pragma unroll
    for (int db = 0; db < 2; ++db)
#pragma unroll
        for (int rg = 0; rg < 4; ++rg) { u32x2 w; w.x = pkh(o[db][4 * rg] * rl, o[db][4 * rg + 1] * rl); w.y = pkh(o[db][4 * rg + 2] * rl, o[db][4 * rg + 3] * rl);
            *(u32x2*)(yrow + 32 * db + 8 * rg + 4 * hi) = w; }
}


#define XB_TMO      128
#define XB_XCNT(j)  (256  + 64 * (j))
#define XB_XSUB(j)  (1280 + 64 * (j))
#define XB_XGEN(j)  (2304 + 64 * (j))
#define XB_TOP      3328
#define XB_TOPGEN   3392
#define XCD_BAR_WORDS 3456
#define XB_SPIN_CAP (1u << 22)
__device__ __forceinline__ unsigned xb_ld(unsigned* p)              { return __hip_atomic_load(p, __ATOMIC_RELAXED, __HIP_MEMORY_SCOPE_AGENT); }
__device__ __forceinline__ unsigned xb_add(unsigned* p, unsigned v) { return __hip_atomic_fetch_add(p, v, __ATOMIC_RELAXED, __HIP_MEMORY_SCOPE_AGENT); }
__device__ __forceinline__ unsigned xb_xcc_id() { return (unsigned)__builtin_amdgcn_s_getreg((3 << 11) | 20) & 0xFu; }
#define XB_SPIN(cond, bar) do { unsigned _sp = 0; while (cond) { __builtin_amdgcn_s_sleep(1); \
    if ((++_sp & 255u) == 0u) { if (xb_ld(&(bar)[XB_TMO])) break; if (_sp > XB_SPIN_CAP) { atomicAdd(&(bar)[XB_TMO], 1u); break; } } } } while (0)
struct XcdBarrier { unsigned* bar; unsigned x; volatile LAS unsigned* st; };
__device__ __forceinline__ XcdBarrier xcd_barrier_post(unsigned* bar, volatile LAS unsigned* st) {
    XcdBarrier b; b.bar = bar; b.x = xb_xcc_id(); b.st = st;
    if (threadIdx.x == 0) (void)xb_add(&bar[XB_XCNT(b.x)], 1u);
    return b;
}
__device__ __forceinline__ void xcd_barrier_complete(unsigned* bar, unsigned x, unsigned& nloc, unsigned& nx) {
    const unsigned G = gridDim.x * gridDim.y * gridDim.z;
    unsigned sum, cnt, mine, sp = 0u;
    for (;;) {
        sum = 0u; cnt = 0u; mine = 0u;
#pragma unroll
        for (unsigned j = 0; j < 16; ++j) { const unsigned c = xb_ld(&bar[XB_XCNT(j)]); sum += c; cnt += (c > 0u) ? 1u : 0u; mine = (j == x) ? c : mine; }
        if (sum == G) break;
        __builtin_amdgcn_s_sleep(1);
        if ((++sp & 255u) == 0u) { if (xb_ld(&bar[XB_TMO])) break; if (sp > XB_SPIN_CAP) { atomicAdd(&bar[XB_TMO], 1u); break; } }
    }
    nloc = mine > 0u ? mine : 1u; nx = cnt > 0u ? cnt : 1u;
}
__device__ __forceinline__ void xcd_barrier(const XcdBarrier& b) {
    asm volatile("s_waitcnt vmcnt(0)" ::: "memory");
    __syncthreads();
    if (threadIdx.x == 0) {
        unsigned* bar = b.bar;
        __builtin_amdgcn_s_waitcnt(0);
        unsigned nloc = b.st[0], nx = b.st[1];
        if (nloc == 0u) { xcd_barrier_complete(bar, b.x, nloc, nx); b.st[0] = nloc; b.st[1] = nx; }
        const unsigned old = xb_add(&bar[XB_XSUB(b.x)], 1u);
        const unsigned gen = old / nloc;
        if (old + 1u == (gen + 1u) * nloc) {
            __builtin_amdgcn_fence(__ATOMIC_RELEASE, "agent");
            asm volatile("s_waitcnt vmcnt(0)" ::: "memory");
            const unsigned og = xb_add(&bar[XB_TOP], 1u);
            const unsigned tg = og / nx;
            if (og + 1u == (tg + 1u) * nx) xb_add(&bar[XB_TOPGEN], 1u);
            else XB_SPIN(xb_ld(&bar[XB_TOPGEN]) == tg, bar);
            __builtin_amdgcn_fence(__ATOMIC_ACQUIRE, "agent");
            xb_add(&bar[XB_XGEN(b.x)], 1u);
            asm volatile("s_waitcnt vmcnt(0)" ::: "memory");
        } else {
            XB_SPIN(xb_ld(&bar[XB_XGEN(b.x)]) == gen, bar);
            __builtin_amdgcn_fence(__ATOMIC_ACQUIRE, "agent");
            asm volatile("s_waitcnt vmcnt(0)" ::: "memory");
        }
    }
    __syncthreads();
}

constexpr int LDS_BYTES = 147456;
struct Args { const float* in[14]; float* out; unsigned char* ws; int ph_lo, ph_hi; };

__global__ void __launch_bounds__(512, 2) hymba_fwd(Args args) {
    extern __shared__ __attribute__((aligned(16))) unsigned char lds_raw[];
    LAS unsigned char* lds = (LAS unsigned char*)lds_raw;
    cg::grid_group grid = cg::this_grid();
    const int tid = threadIdx.x, lane = tid & 63, wave = __builtin_amdgcn_readfirstlane(tid >> 6);
    const int G = gridDim.x, bx = blockIdx.x;
    unsigned char* ws = args.ws;
    const float* x = args.in[0]; const float* p_in = args.in[1]; const float* g_attn = args.in[2]; const float* w_in = args.in[3]; const float* g_idx = args.in[4];
    const float* w_out = args.in[5]; const float* g_ffn = args.in[6]; const float* w_gate = args.in[7]; const float* w_up = args.in[8]; const float* w_down = args.in[9];
    const float* g_ple = args.in[10]; const float* w_pg = args.in[11]; const float* w_pp = args.in[12]; const float* g_final = args.in[13];
    h16* Wt_in = (h16*)(ws + WS_WIN); h16* Wt_out = (h16*)(ws + WS_WOUT); h16* Wt_gu = (h16*)(ws + WS_WGU); h16* Wt_dn = (h16*)(ws + WS_WDN); h16* Wt_pg = (h16*)(ws + WS_WPG); h16* Wt_pp = (h16*)(ws + WS_WPP);
    float* rope = (float*)(ws + WS_ROPE); float* rs0 = (float*)(ws + WS_RS0); float* ssp1 = (float*)(ws + WS_SSP1); float* ssp2 = (float*)(ws + WS_SSP2); float* ssp3 = (float*)(ws + WS_SSP3);
    float* kmp = (float*)(ws + WS_KMP); float* WI = (float*)(ws + WS_WI);
    h16* PH = (h16*)(ws + WS_PH); h16* PP = (h16*)(ws + WS_PP); h16* XH = (h16*)(ws + WS_XH); h16* H1 = XH; h16* Y = (h16*)(ws + WS_Y); h16* H2 = Y;
    h16* QA = (h16*)(ws + WS_QA); h16* KA = (h16*)(ws + WS_KA); h16* VA = (h16*)(ws + WS_VA); h16* QI = (h16*)(ws + WS_QI); h16* KI = (h16*)(ws + WS_KI);
    h16* QB = (h16*)(ws + WS_QB); h16* KB = (h16*)(ws + WS_KB); h16* VB = (h16*)(ws + WS_VB); h16* ACT = (h16*)(ws + WS_ACT);
    const int lo = args.ph_lo, hi_ph = args.ph_hi;
#ifndef PH_MASK
#define PH_MASK 0xff
#endif
#define IN(k) (((PH_MASK >> (k)) & 1) && lo <= (k) && (k) < hi_ph)
    volatile LAS unsigned* MISC = (volatile LAS unsigned*)(lds + LDS_BYTES - 256);
    unsigned* barw = (unsigned*)(ws + 0);
    XcdBarrier xbar; xbar.bar = barw; xbar.x = 0; xbar.st = MISC;
#define SEAM(k) do { if (IN(k) && IN((k) + 1)) { if ((k) == 0) { grid.sync(); if (tid == 0) { MISC[0] = 0u; MISC[1] = 0u; } __syncthreads(); xbar = xcd_barrier_post(barw, MISC); } else xcd_barrier(xbar); } } while (0)

    if (IN(0)) {
        if (bx == 0) for (int i = tid; i < XCD_BAR_WORDS; i += 512) barw[i] = 0u;
        LAS float* scr = (LAS float*)(lds + wave * 16384);
        const int gw = bx * 8 + wave, NGW = G * 8;
        transpose_items(DM, NIN_SRC, Wt_in, NIN, [=](int np) -> const float* { const int c = win_colmap(np); return c >= 0 ? w_in + c : nullptr; }, g_attn, scr, gw, NGW, lane);
        transpose_items(DM, DM, Wt_out, DM, [=](int np) -> const float* { return w_out + np; }, nullptr, scr, gw, NGW, lane);
        transpose_items(DM, DFF, Wt_gu, 2 * DFF, [=](int np) -> const float* { const int p = np & 255, t = np >> 8; return (p < 128) ? (w_gate + t * 128 + p) : (w_up + t * 128 + p - 128); }, g_ffn, scr, gw, NGW, lane);
        transpose_items(DFF, DM, Wt_dn, DM, [=](int np) -> const float* { return w_down + np; }, nullptr, scr, gw, NGW, lane);
        transpose_items(DM, DM, Wt_pg, DM, [=](int np) -> const float* { return w_pg + np; }, g_ple, scr, gw, NGW, lane);
        transpose_items(DPLE, DM, Wt_pp, DM, [=](int np) -> const float* { return w_pp + np; }, nullptr, scr, gw, NGW, lane);
        for (int m = gw; m < NTOK; m += NGW) {
            const f32x4* xr = (const f32x4*)(x + (size_t)m * DM) + lane; f32x4 v[4]; float s = 0.f;
#pragma unroll
            for (int jj = 0; jj < 4; ++jj) { v[jj] = xr[64 * jj]; s += (v[jj].x * v[jj].x + v[jj].y * v[jj].y) + (v[jj].z * v[jj].z + v[jj].w * v[jj].w); }
            s = wave_sum(s);
            if (lane == 0) rs0[m] = 1.0f / sqrtf(s * (1.0f / DM) + EPS);
            u32x2* o8 = (u32x2*)(XH + (size_t)m * DM) + lane;
#pragma unroll
            for (int jj = 0; jj < 4; ++jj) { u32x2 w; w.x = pkh(v[jj].x, v[jj].y); w.y = pkh(v[jj].z, v[jj].w); o8[64 * jj] = w; }
        }
        for (int m = gw; m < NTOK; m += NGW) { const f32x4 v = *((const f32x4*)(p_in + (size_t)m * DPLE) + lane); u32x2 w; w.x = pkh(v.x, v.y); w.y = pkh(v.z, v.w); *((u32x2*)(PH + (size_t)m * DPLE) + lane) = w; }
        for (int i = bx * 512 + tid; i < SEQ * 32; i += G * 512) {
            const int pos = i >> 5, jx = i & 31;
            const float inv = ROPE_INV[jx];
            const float ang = (float)pos * inv;
            const double a = (double)ang; const double kq = __builtin_rint(a * 0.15915494309189535);
            double r = __builtin_fma(-kq, 6.283185307179586, a); r = __builtin_fma(-kq, 2.4492935982947064e-16, r);
            const double r2 = r * r; double sn = 0.0, cs = 0.0;
            double ts = 1.0, tc = 1.0;
#pragma unroll
            for (int n = 13; n >= 1; --n) { ts = 1.0 - ts * r2 / (double)((2 * n) * (2 * n + 1)); tc = 1.0 - tc * r2 / (double)((2 * n - 1) * (2 * n)); }
            sn = r * ts; cs = tc;
            rope[(size_t)i * 2] = (float)cs; rope[(size_t)i * 2 + 1] = (float)sn;
        }
    }
    SEAM(0);
    if (IN(1)) {
        { pg8::Gemm g{XH, Wt_in, NTOK, NIN, DM}; pg8::StaticOrder S; S.init(NTOK, NIN, G, bx);
          pg8::EpiInProj E{rs0, rope, g_idx, QA, KA, VA, QI, KI, QB, KB, VB, WI, kmp};
          pg8::gemm_phase(lds, g, S, E); }
        { pg8::Gemm g{PH, Wt_pp, NTOK, DM, DPLE}; pg8::StaticOrder S; S.init(NTOK, DM, G, bx);
          pg8::EpiPlain E{PP, DM};
          pg8::gemm_phase(lds, g, S, E); }
    }
    SEAM(1);
    if (IN(2)) {
        AttnPtrs P{QA, KA, VA, QI, KI, QB, KB, VB, WI, kmp, Y};
        const int b = bx & 7, r = bx >> 3;
        const int nr = G >> 3;
#ifndef NO_DSA
        for (int rep = 0; rep < REP_DSA; ++rep)
        for (int s = r; s < 128; s += nr) { dsa_unit(lds, P, b, s); dsa_unit(lds, P, b, 255 - s); }
#endif
#ifndef NO_MOBA
        for (int rep = 0; rep < REP_MOBA; ++rep)
        for (int uu = r; uu < 64; uu += nr) { const int h = uu >> 3, s = uu & 7; moba_unit(lds, P, b, h, s); __syncthreads(); moba_unit(lds, P, b, h, 15 - s); __syncthreads(); }
#endif
    }
    SEAM(2);
    if (IN(3)) {
        pg8::Gemm g{Y, Wt_out, NTOK, DM, DM}; pg8::StaticOrder S; S.init(NTOK, DM, G, bx);
        pg8::EpiRes<true> E{x, H1, ssp1};
        pg8::gemm_phase(lds, g, S, E);
    }
    SEAM(3);
    if (IN(4)) {
        pg8::Gemm g{H1, Wt_gu, NTOK, 2 * DFF, DM}; pg8::StaticOrder S; S.init(NTOK, 2 * DFF, G, bx);
        pg8::EpiSwiGLU E{ssp1, ACT};
        pg8::gemm_phase(lds, g, S, E);
    }
    SEAM(4);
    if (IN(5)) {
        pg8::Gemm g{ACT, Wt_dn, NTOK, DM, DFF}; pg8::StaticOrder S; S.init(NTOK, DM, G, bx);
        pg8::EpiRes<false> E{H1, H2, ssp2};
        pg8::gemm_phase(lds, g, S, E);
    }
    SEAM(5);
    if (IN(6)) {
        pg8::Gemm g{H2, Wt_pg, NTOK, DM, DM}; pg8::StaticOrder S; S.init(NTOK, DM, G, bx);
        pg8::EpiPLE E{ssp2, H2, PP, args.out, ssp3};
        pg8::gemm_phase(lds, g, S, E);
    }
    SEAM(6);
    if (IN(7)) {
        const int gw = bx * 8 + wave, NGW = G * 8;
        f32x4 gf[4];
#pragma unroll
        for (int jj = 0; jj < 4; ++jj) gf[jj] = *((const f32x4*)g_final + lane + 64 * jj);
        for (int m = gw; m < NTOK; m += NGW) {
            const float s = pg8::row_rstd(ssp3, m);
            f32x4* o = (f32x4*)(args.out + (size_t)m * DM) + lane;
#pragma unroll
            for (int jj = 0; jj < 4; ++jj) { f32x4 v = o[64 * jj]; v = v * s * gf[jj]; o[64 * jj] = v; }
        }
    }
#undef IN
#undef SEAM
}

extern "C" void kernel_launch(void* const* d_in, const int* in_sizes, int n_in, void* d_out, int out_size, void* d_ws, size_t ws_size, hipStream_t stream) {
    static int grid = 0;
    if (grid == 0) {
        if (n_in != 14 || out_size != NTOK * DM || ws_size < WS_END) { fprintf(stderr, "kernel_launch: unexpected shapes (n_in %d out %d ws %zu)\n", n_in, out_size, ws_size); grid = -1; return; }
        int dev = 0, cus = 0, per_cu = 0;
        (void)hipGetDevice(&dev);
        (void)hipDeviceGetAttribute(&cus, hipDeviceAttributeMultiprocessorCount, dev);
        (void)hipFuncSetAttribute((const void*)hymba_fwd, hipFuncAttributeMaxDynamicSharedMemorySize, LDS_BYTES);
        (void)hipOccupancyMaxActiveBlocksPerMultiprocessor(&per_cu, (const void*)hymba_fwd, 512, LDS_BYTES);
        if (per_cu < 1) { fprintf(stderr, "kernel_launch: occupancy query says %d blocks/CU\n", per_cu); }
        grid = cus;
        if (grid % 8 != 0 || grid > 256) grid = (grid / 8) * 8 > 256 ? 256 : (grid / 8) * 8;
    }
    if (grid <= 0) return;
    Args a{};
    for (int i = 0; i < 14; ++i) a.in[i] = (const float*)d_in[i];
    a.out = (float*)d_out; a.ws = (unsigned char*)d_ws;
#if MK_COOP
    a.ph_lo = 0; a.ph_hi = 8;
    void* kargs[] = {&a};
    hipError_t e = hipLaunchCooperativeKernel((const void*)hymba_fwd, dim3(grid), dim3(512), kargs, LDS_BYTES, stream);
    if (e != hipSuccess) fprintf(stderr, "cooperative launch failed: %s (grid %d)\n", hipGetErrorString(e), grid);
#else
    for (int ph = 0; ph < 8; ++ph) { a.ph_lo = ph; a.ph_hi = ph + 1; hipLaunchKernelGGL(hymba_fwd, dim3(grid), dim3(512), LDS_BYTES, stream, a); }
#endif
}
```

```cpp
#include <hip/hip_runtime.h>
#include <hip/hip_cooperative_groups.h>
#include <cstdio>
#include <cstdint>
namespace cg = cooperative_groups;

#ifndef REP_DSA
#define REP_DSA 1
#endif
#ifndef REP_MOBA
#define REP_MOBA 1
#endif
#ifndef REP_ATT
#define REP_ATT 1
#endif
#ifndef REP_SC
#define REP_SC 1
#endif
#ifndef REP_SEL
#define REP_SEL 1
#endif
#ifndef REP_EM
#define REP_EM 1
#endif
#ifndef MK_COOP
#define MK_COOP 1
#endif

#define LAS __attribute__((address_space(3)))
typedef _Float16 h16;
typedef _Float16 h16x8 __attribute__((ext_vector_type(8)));
typedef _Float16 h16x4 __attribute__((ext_vector_type(4)));
typedef _Float16 h16x2 __attribute__((ext_vector_type(2)));
typedef short s16x8 __attribute__((ext_vector_type(8)));
typedef short s16x4 __attribute__((ext_vector_type(4)));
typedef float f32x2 __attribute__((ext_vector_type(2)));
typedef float f32x4 __attribute__((ext_vector_type(4)));
typedef float f32x16 __attribute__((ext_vector_type(16)));
typedef unsigned u32x2 __attribute__((ext_vector_type(2)));
typedef unsigned u32x4 __attribute__((ext_vector_type(4)));

constexpr int BATCH = 8, SEQ = 4096, DM = 1024, NTOK = BATCH * SEQ, NIN = 2560, NIN_SRC = 2500, DFF = 2816, DPLE = 256;
constexpr float EPS = 1e-6f;
constexpr float C2 = 0.125f * 1.4426950408889634f;
constexpr float NEG_INF = -__builtin_huge_valf();

constexpr size_t MiB = 1u << 20;
constexpr size_t WS_WIN = 1 * MiB, WS_WOUT = 6 * MiB, WS_WGU = 8 * MiB, WS_WDN = 19 * MiB, WS_WPG = 25 * MiB, WS_WPP = 27 * MiB;
constexpr size_t WS_ROPE = 28 * MiB, WS_RS0 = 29 * MiB, WS_SSP1 = 30 * MiB, WS_SSP2 = 32 * MiB, WS_SSP3 = 34 * MiB, WS_KMP = 36 * MiB, WS_WI = 37 * MiB;
constexpr size_t WS_PH = 38 * MiB, WS_PP = 54 * MiB, WS_XH = 118 * MiB  , WS_Y = 182 * MiB  ;
constexpr size_t WS_QA = 246 * MiB, WS_KA = 278 * MiB, WS_VA = 282 * MiB, WS_QI = 286 * MiB, WS_KI = 302 * MiB, WS_QB = 306 * MiB, WS_KB = 338 * MiB, WS_VB = 370 * MiB;
constexpr size_t WS_ACT = 246 * MiB  , WS_END = 422 * MiB;

__constant__ float ROPE_INV[32] = {0x1.0000000000000p+0f, 0x1.7ff2220000000p-1f, 0x1.1feb340000000p-1f, 0x1.afd1360000000p-2f, 0x1.43d1360000000p-2f, 0x1.e5a8480000000p-3f, 0x1.6c310e0000000p-3f, 0x1.111aee0000000p-3f,
    0x1.99999a0000000p-4f, 0x1.33281c0000000p-4f, 0x1.ccab860000000p-5f, 0x1.59742a0000000p-5f, 0x1.030dc40000000p-5f, 0x1.8486a00000000p-6f, 0x1.235a720000000p-6f, 0x1.b4f7e20000000p-7f,
    0x1.47ae140000000p-7f, 0x1.eb73600000000p-8f, 0x1.7089380000000p-8f, 0x1.145cee0000000p-8f, 0x1.9e7c6e0000000p-9f, 0x1.36d21a0000000p-9f, 0x1.d22a500000000p-10f, 0x1.5d931c0000000p-10f,
    0x1.0624de0000000p-10f, 0x1.8929180000000p-11f, 0x1.26d42c0000000p-11f, 0x1.ba2e4c0000000p-12f, 0x1.4b96be0000000p-12f, 0x1.f150280000000p-13f, 0x1.74eea60000000p-13f, 0x1.17a8e40000000p-13f};
__device__ __forceinline__ unsigned pkh(float lo, float hi) { h16x2 v = {(h16)lo, (h16)hi}; return __builtin_bit_cast(unsigned, v); }
__device__ __forceinline__ float wave_sum(float v) {
#pragma unroll
    for (int o = 1; o < 64; o <<= 1) v += __shfl_xor(v, o);
    return v;
}
__device__ __forceinline__ float fast_sigmoid(float x) { return __builtin_amdgcn_rcpf(1.0f + __builtin_amdgcn_exp2f(-1.4426950408889634f * x)); }

namespace pg8 {
constexpr int BM = 256, BK = 64, HALF = 128, HTB = HALF * BK * 2, STAGE_BYTES = 8 * HTB, NXCD = 8, WGM = 8;
__host__ __device__ __forceinline__ int lds_byte(int r, int c) { const int st = (r >> 4) * 2 + (c >> 5), rr = r & 15, cc = c & 31, ob = rr * 64 + cc * 2; return st * 1024 + (ob ^ (((ob >> 9) & 1) << 5)); }
__host__ __device__ __forceinline__ void stage_rc(int b, int& R, int& C) { const int st = b / 1024, sb = b % 1024, swz = sb ^ (((sb >> 9) & 1) << 5); R = (st >> 1) * 16 + swz / 64; C = (st & 1) * 32 + (swz % 64) / 2; }
__host__ __device__ __forceinline__ int perm32(int rho) { const int n = rho >> 4, i = rho & 15; return 8 * (i >> 2) + 4 * n + (i & 3); }
struct Unit { int pm, pn; };
struct Gemm { const h16* A; const h16* Bt; int M, N, K; };
struct StaticOrder {
    int nM, nN, nwg, G, c;
    __host__ __device__ void init(int M, int N, int G_, int c_) { nM = M / BM; nN = N / BM; nwg = nM * nN; G = G_; c = c_; }
    __host__ __device__ bool next(int i, Unit& u) const {
        const long L = (long)i * G + c; if (L >= nwg) return false;
        int wgid = (int)L; { const int q = nwg / NXCD, r = nwg % NXCD, xcd = wgid % NXCD, off = wgid / NXCD; wgid = (xcd < r ? xcd * (q + 1) : r * (q + 1) + (xcd - r) * q) + off; }
        const int nig = WGM * nN, gid = wgid / nig, fm = gid * WGM, gsz = (nM - fm) < WGM ? (nM - fm) : WGM;
        u.pm = fm + ((wgid % nig) % gsz); u.pn = (wgid % nig) / gsz; return true;
    }
};
template <class Epi>
__device__ __forceinline__ void gemm_phase(LAS unsigned char* lds, const Gemm g, const StaticOrder& S, const Epi& E) {
    const int tid = threadIdx.x, wid = __builtin_amdgcn_readfirstlane(tid >> 6), lane = tid & 63, wr = wid >> 2, wc = wid & 3, fr = lane & 15, fq = lane >> 4;
    const int K = g.K, nt = K / BK;
    unsigned voffA[2], voffB[2];
#pragma unroll
    for (int i = 0; i < 2; ++i) { int R, C; stage_rc(tid * 16 + i * 8192, R, C); const int Rb = (R & ~31) + perm32(R & 31);
        voffA[i] = (unsigned)(R * K + C) * 2u; voffB[i] = (unsigned)(Rb * K + C) * 2u; }
    const size_t kstep = (size_t)(BK * 2);
    const size_t hstep = (size_t)HALF * K * 2;
    const size_t tstep = 2 * hstep;
    const unsigned ldsw = (unsigned)wid * 1024u;
    const int aoff = lds_byte(wr * 64 + fr, fq * 8), boff = lds_byte(wc * 32 + fr, fq * 8);
#define PG8_SA(b, h) (((b) * 2 + (h)) * HTB)
#define PG8_SB(b, h) ((4 + (b) * 2 + (h)) * HTB)
#define PG8_STAGE(bufoff, gbase, voff) do { _Pragma("unroll") for (int _i = 0; _i < 2; ++_i) \
        __builtin_amdgcn_global_load_lds((const unsigned*)((const char*)(gbase) + (voff)[_i]), (LAS unsigned*)(lds + (bufoff) + ldsw + _i * 8192), 16, 0, 0); } while (0)
#define PG8_LDA(dst, b, h) do { _Pragma("unroll") for (int m = 0; m < 4; ++m) _Pragma("unroll") for (int k = 0; k < 2; ++k) dst[m][k] = *(const LAS s16x8*)(lds + PG8_SA(b, h) + aoff + m * 2048 + k * 1024); } while (0)
#define PG8_LDB(dst, b, h) do { _Pragma("unroll") for (int n = 0; n < 2; ++n) _Pragma("unroll") for (int k = 0; k < 2; ++k) dst[n][k] = *(const LAS s16x8*)(lds + PG8_SB(b, h) + boff + n * 2048 + k * 1024); } while (0)
#define PG8_MMA(ai, bj, At, Bt) do { __builtin_amdgcn_s_setprio(1); _Pragma("unroll") for (int m = 0; m < 4; ++m) _Pragma("unroll") for (int n = 0; n < 2; ++n) _Pragma("unroll") for (int k = 0; k < 2; ++k) \
        acc[ai][bj][m][n] = __builtin_amdgcn_mfma_f32_16x16x32_f16(__builtin_bit_cast(h16x8, Bt[n][k]), __builtin_bit_cast(h16x8, At[m][k]), acc[ai][bj][m][n], 0, 0, 0); __builtin_amdgcn_s_setprio(0); } while (0)
#define PG8_WAIT_V(n) asm volatile("s_waitcnt vmcnt(" #n ")" ::: "memory")
#define PG8_WAIT_L(n) asm volatile("s_waitcnt lgkmcnt(" #n ")" ::: "memory")
#define PG8_BAR __builtin_amdgcn_s_barrier()
#define PG8_SCHED __builtin_amdgcn_sched_barrier(0)
    Unit cur, nxt; int ui = 0;
    if (!S.next(0, cur)) return;
    f32x4 acc[2][2][4][2];
#pragma unroll
    for (int a = 0; a < 2; ++a)
#pragma unroll
        for (int b = 0; b < 2; ++b)
#pragma unroll
            for (int m = 0; m < 4; ++m)
#pragma unroll
                for (int n = 0; n < 2; ++n) acc[a][b][m][n] = (f32x4){0.f, 0.f, 0.f, 0.f};
    s16x8 At[4][2], B0[2][2], B1[2][2];
    const char* cA = (const char*)g.A + (size_t)cur.pm * tstep; const char* cB = (const char*)g.Bt + (size_t)cur.pn * tstep;
    PG8_STAGE(PG8_SB(0, 0), cB, voffB); PG8_STAGE(PG8_SB(0, 1), cB + hstep, voffB); PG8_STAGE(PG8_SA(0, 0), cA, voffA); PG8_STAGE(PG8_SA(0, 1), cA + hstep, voffA);
    if (wr == 1) PG8_BAR;
    PG8_WAIT_V(2); PG8_BAR;
    PG8_STAGE(PG8_SB(1, 0), cB + kstep, voffB); PG8_STAGE(PG8_SA(1, 0), cA + kstep, voffA); PG8_STAGE(PG8_SB(1, 1), cB + hstep + kstep, voffB);
    PG8_WAIT_V(6); PG8_BAR;
    for (;;) {
        const bool has_next = S.next(ui + 1, nxt);
        const char* nA = has_next ? (const char*)g.A + (size_t)nxt.pm * tstep : cA; const char* nB = has_next ? (const char*)g.Bt + (size_t)nxt.pn * tstep : cB;
#pragma unroll 1
        for (int t = 0; t < nt; t += 2) {
            const bool last = (t == nt - 2);
            const char* a1 = cA + (size_t)(t + 1) * kstep;
            const char* a2 = last ? nA : cA + (size_t)(t + 2) * kstep; const char* b2 = last ? nB : cB + (size_t)(t + 2) * kstep;
            const char* a3 = a2 + kstep; const char* b3 = b2 + kstep;
            PG8_LDB(B0, 0, 0); PG8_LDB(B1, 0, 1); PG8_SCHED; PG8_LDA(At, 0, 0); PG8_STAGE(PG8_SA(1, 1), a1 + hstep, voffA);
            PG8_WAIT_V(8); PG8_WAIT_L(0); PG8_BAR; PG8_MMA(0, 0, At, B0); PG8_MMA(0, 1, At, B1); PG8_BAR; PG8_SCHED;
            PG8_LDA(At, 0, 1); PG8_STAGE(PG8_SB(0, 0), b2, voffB); PG8_STAGE(PG8_SB(0, 1), b2 + hstep, voffB); PG8_STAGE(PG8_SA(0, 0), a2, voffA);
            PG8_WAIT_V(8); PG8_WAIT_L(0); PG8_BAR; PG8_MMA(1, 0, At, B0); PG8_MMA(1, 1, At, B1); PG8_BAR; PG8_SCHED;
            PG8_LDB(B0, 1, 0); PG8_LDB(B1, 1, 1); PG8_SCHED; PG8_LDA(At, 1, 0); PG8_STAGE(PG8_SA(0, 1), a2 + hstep, voffA);
            PG8_WAIT_V(8); PG8_WAIT_L(0); PG8_BAR; PG8_MMA(0, 0, At, B0); PG8_MMA(0, 1, At, B1); PG8_BAR; PG8_SCHED;
            PG8_LDA(At, 1, 1); PG8_STAGE(PG8_SB(1, 0), b3, voffB); PG8_STAGE(PG8_SB(1, 1), b3 + hstep, voffB); PG8_STAGE(PG8_SA(1, 0), a3, voffA);
            PG8_WAIT_V(8); PG8_WAIT_L(0); PG8_BAR; PG8_MMA(1, 0, At, B0); PG8_MMA(1, 1, At, B1); PG8_BAR; PG8_SCHED;
        }
        if (wr == 0) PG8_BAR;
        E(acc, cur, wr, wc, fr, fq);
        if (!has_next) break;
#pragma unroll
        for (int a = 0; a < 2; ++a)
#pragma unroll
            for (int b = 0; b < 2; ++b)
#pragma unroll
                for (int m = 0; m < 4; ++m)
#pragma unroll
                    for (int n = 0; n < 2; ++n) acc[a][b][m][n] = (f32x4){0.f, 0.f, 0.f, 0.f};
        cur = nxt; cA = nA; cB = nB; ++ui;
        if (wr == 1) PG8_BAR;
    }
    PG8_WAIT_V(0);
    PG8_BAR;
#undef PG8_SA
#undef PG8_SB
#undef PG8_STAGE
#undef PG8_LDA
#undef PG8_LDB
#undef PG8_MMA
#undef PG8_WAIT_V
#undef PG8_WAIT_L
#undef PG8_BAR
#undef PG8_SCHED
}

typedef const f32x4 (&AccRef)[2][2][4][2];

struct EpiPlain {
    h16* O; int ldc;
    __device__ __forceinline__ void operator()(AccRef acc, const Unit& u, int wr, int wc, int fr, int fq) const {
        const int row0 = u.pm * BM + wr * 64 + fr, col0 = u.pn * BM + wc * 32 + 8 * fq;
#pragma unroll
        for (int ai = 0; ai < 2; ++ai)
#pragma unroll
            for (int m = 0; m < 4; ++m) { h16* rowp = O + (size_t)(row0 + ai * HALF + m * 16) * ldc + col0;
#pragma unroll
                for (int bj = 0; bj < 2; ++bj) { const f32x4 v0 = acc[ai][bj][m][0], v1 = acc[ai][bj][m][1];
                    u32x4 w; w.x = pkh(v0[0], v0[1]); w.y = pkh(v0[2], v0[3]); w.z = pkh(v1[0], v1[1]); w.w = pkh(v1[2], v1[3]);
                    *(u32x4*)(rowp + bj * HALF) = w; } }
    }
};

struct EpiInProj {
    const float* rs0; const float* rope; const float* gidx;
    h16 *QA, *KA, *VA, *QI, *KI, *QB, *KB, *VB; float* WI; float* kmp;
    __device__ __forceinline__ void operator()(AccRef acc, const Unit& u, int wr, int wc, int fr_in, int fq_in) const {
        int fr = fr_in, fq = fq_in; asm volatile("" : "+v"(fr), "+v"(fq));
        const int pn = u.pn;
        int type = 0; h16* dst = VA; int pitch = 64, cb = 0; float scl = 1.f; bool iskb = false;
        if (pn < 2) { type = 1; dst = QA; pitch = 512; cb = 256 * pn + 64 * wc; scl = C2; }
        else if (pn == 2) { if (wc == 0) { type = 1; dst = KA; } else if (wc == 1) { type = 0; dst = VA; } else if (wc == 2) { type = 2; dst = KI; } else { type = 3; } }
        else if (pn == 3) { type = 1; dst = QI; pitch = 256; cb = 64 * wc; }
        else if (pn < 6) { type = 1; dst = QB; pitch = 512; cb = 256 * (pn - 4) + 64 * wc; scl = C2; }
        else if (pn < 8) { type = 1; dst = KB; pitch = 512; cb = 256 * (pn - 6) + 64 * wc; iskb = true; }
        else { type = 0; dst = VB; pitch = 512; cb = 256 * (pn - 8) + 64 * wc; }
        float ks[2][2][4];
#pragma unroll
        for (int bj = 0; bj < 2; ++bj)
#pragma unroll
            for (int n = 0; n < 2; ++n)
#pragma unroll
                for (int e = 0; e < 4; ++e) ks[bj][n][e] = 0.f;
        float gl[2][2][4];
        if (type == 2) {
#pragma unroll
            for (int bj = 0; bj < 2; ++bj)
#pragma unroll
                for (int n = 0; n < 2; ++n)
#pragma unroll
                    for (int e = 0; e < 4; ++e) gl[bj][n][e] = gidx[32 * bj + 8 * fq + 4 * n + e];
        }
#pragma unroll
        for (int ai = 0; ai < 2; ++ai)
#pragma unroll
            for (int m = 0; m < 4; ++m) {
                const int row = u.pm * BM + ai * HALF + wr * 64 + m * 16 + fr;
                const float s = rs0[row];
                float v[2][2][4];
#pragma unroll
                for (int bj = 0; bj < 2; ++bj)
#pragma unroll
                    for (int n = 0; n < 2; ++n)
#pragma unroll
                        for (int e = 0; e < 4; ++e) v[bj][n][e] = acc[ai][bj][m][n][e] * s;
                if (type == 3) {
                    if (fq == 0) *(f32x4*)(WI + (size_t)row * 4) = (f32x4){v[0][0][0] * 0.0625f, v[0][0][1] * 0.0625f, v[0][0][2] * 0.0625f, v[0][0][3] * 0.0625f};
                    continue;
                }
                if (type == 2) {
                    float sum = 0.f;
#pragma unroll
                    for (int bj = 0; bj < 2; ++bj)
#pragma unroll
                        for (int n = 0; n < 2; ++n)
#pragma unroll
                            for (int e = 0; e < 4; ++e) sum += v[bj][n][e];
                    sum += __shfl_xor(sum, 16); sum += __shfl_xor(sum, 32);
                    const float mean = sum * (1.f / 64.f); float q = 0.f;
#pragma unroll
                    for (int bj = 0; bj < 2; ++bj)
#pragma unroll
                        for (int n = 0; n < 2; ++n)
#pragma unroll
                            for (int e = 0; e < 4; ++e) { v[bj][n][e] -= mean; q += v[bj][n][e] * v[bj][n][e]; }
                    q += __shfl_xor(q, 16); q += __shfl_xor(q, 32);
                    const float rstd = 1.0f / sqrtf(q * (1.f / 64.f) + EPS);
#pragma unroll
                    for (int bj = 0; bj < 2; ++bj)
#pragma unroll
                        for (int n = 0; n < 2; ++n)
#pragma unroll
                            for (int e = 0; e < 4; ++e) v[bj][n][e] = v[bj][n][e] * rstd * gl[bj][n][e];
                }
                if (type >= 1) {
                    const int pos = row & (SEQ - 1);
                    const f32x4* cs = (const f32x4*)(rope + ((size_t)pos * 32 + 8 * fq) * 2);
#pragma unroll
                    for (int n = 0; n < 2; ++n) { const f32x4 c01 = cs[2 * n], c23 = cs[2 * n + 1];
                        const float cc[4] = {c01[0], c01[2], c23[0], c23[2]}, sn[4] = {c01[1], c01[3], c23[1], c23[3]};
#pragma unroll
                        for (int e = 0; e < 4; ++e) { const float lo = v[0][n][e], hi = v[1][n][e]; v[0][n][e] = lo * cc[e] - hi * sn[e]; v[1][n][e] = hi * cc[e] + lo * sn[e]; } }
                }
#pragma unroll
                for (int bj = 0; bj < 2; ++bj) {
#pragma unroll
                    for (int n = 0; n < 2; ++n)
#pragma unroll
                        for (int e = 0; e < 4; ++e) { v[bj][n][e] *= scl; ks[bj][n][e] += v[bj][n][e]; }
                    u32x4 w; w.x = pkh(v[bj][0][0], v[bj][0][1]); w.y = pkh(v[bj][0][2], v[bj][0][3]); w.z = pkh(v[bj][1][0], v[bj][1][1]); w.w = pkh(v[bj][1][2], v[bj][1][3]);
                    *(u32x4*)(dst + (size_t)row * pitch + cb + 32 * bj + 8 * fq) = w;
                }
                __builtin_amdgcn_sched_barrier(0);
            }
        if (iskb) {
#pragma unroll
            for (int bj = 0; bj < 2; ++bj)
#pragma unroll
                for (int n = 0; n < 2; ++n)
#pragma unroll
                    for (int e = 0; e < 4; ++e) { float t = ks[bj][n][e]; t += __shfl_xor(t, 1); t += __shfl_xor(t, 2); t += __shfl_xor(t, 4); t += __shfl_xor(t, 8); ks[bj][n][e] = t; }
            if (fr == 0) { const int head = 4 * (pn - 6) + wc; float* o = kmp + (((size_t)u.pm * 2 + wr) * 8 + head) * 64;
#pragma unroll
                for (int bj = 0; bj < 2; ++bj)
#pragma unroll
                    for (int n = 0; n < 2; ++n) *(f32x4*)(o + 32 * bj + 8 * fq + 4 * n) = (f32x4){ks[bj][n][0], ks[bj][n][1], ks[bj][n][2], ks[bj][n][3]}; }
        }
    }
};

template <bool BASE_F32> struct EpiRes {
    const void* base; h16* out; float* ssp;
    __device__ __forceinline__ void operator()(AccRef acc, const Unit& u, int wr, int wc, int fr, int fq) const {
        const int col0 = u.pn * BM + wc * 32 + 8 * fq;
#pragma unroll
        for (int ai = 0; ai < 2; ++ai)
#pragma unroll
            for (int m = 0; m < 4; ++m) { const int row = u.pm * BM + ai * HALF + wr * 64 + m * 16 + fr; float ss = 0.f;
#pragma unroll
                for (int bj = 0; bj < 2; ++bj) { const size_t off = (size_t)row * DM + col0 + bj * HALF; float b[8];
                    if (BASE_F32) { const f32x4 b0 = *(const f32x4*)((const float*)base + off), b1 = *(const f32x4*)((const float*)base + off + 4);
                        b[0] = b0[0]; b[1] = b0[1]; b[2] = b0[2]; b[3] = b0[3]; b[4] = b1[0]; b[5] = b1[1]; b[6] = b1[2]; b[7] = b1[3]; }
                    else { const h16x8 hb = *(const h16x8*)((const h16*)base + off);
#pragma unroll
                        for (int e = 0; e < 8; ++e) b[e] = (float)hb[e]; }
                    float v[8];
#pragma unroll
                    for (int e = 0; e < 8; ++e) { v[e] = b[e] + acc[ai][bj][m][e >> 2][e & 3]; ss += v[e] * v[e]; }
                    u32x4 w; w.x = pkh(v[0], v[1]); w.y = pkh(v[2], v[3]); w.z = pkh(v[4], v[5]); w.w = pkh(v[6], v[7]);
                    *(u32x4*)(out + off) = w; }
                ss += __shfl_xor(ss, 16); ss += __shfl_xor(ss, 32);
                if (fq == 0) ssp[(size_t)row * 16 + u.pn * 4 + wc] = ss; }
    }
};
__device__ __forceinline__ float row_rstd(const float* ssp, int row) {
    const f32x4* p = (const f32x4*)(ssp + (size_t)row * 16); const f32x4 a = p[0], b = p[1], c = p[2], d = p[3];
    const float s = ((a[0] + a[1]) + (a[2] + a[3])) + ((b[0] + b[1]) + (b[2] + b[3])) + ((c[0] + c[1]) + (c[2] + c[3])) + ((d[0] + d[1]) + (d[2] + d[3]));
    return 1.0f / sqrtf(s * (1.0f / DM) + EPS);
}
struct EpiSwiGLU {
    const float* ssp; h16* act;
    __device__ __forceinline__ void operator()(AccRef acc, const Unit& u, int wr, int wc, int fr, int fq) const {
        const int col0 = u.pn * HALF + wc * 32 + 8 * fq;
#pragma unroll
        for (int ai = 0; ai < 2; ++ai)
#pragma unroll
            for (int m = 0; m < 4; ++m) { const int row = u.pm * BM + ai * HALF + wr * 64 + m * 16 + fr; const float s = row_rstd(ssp, row); float v[8];
#pragma unroll
                for (int e = 0; e < 8; ++e) { const float gt = acc[ai][0][m][e >> 2][e & 3] * s, up = acc[ai][1][m][e >> 2][e & 3] * s; v[e] = gt * fast_sigmoid(gt) * up; }
                u32x4 w; w.x = pkh(v[0], v[1]); w.y = pkh(v[2], v[3]); w.z = pkh(v[4], v[5]); w.w = pkh(v[6], v[7]);
                *(u32x4*)(act + (size_t)row * DFF + col0) = w; }
    }
};
struct EpiPLE {
    const float* ssp2; const h16* h2; const h16* pp; float* out; float* ssp3;
    __device__ __forceinline__ void operator()(AccRef acc, const Unit& u, int wr, int wc, int fr, int fq) const {
        const int col0 = u.pn * BM + wc * 32 + 8 * fq;
#pragma unroll
        for (int ai = 0; ai < 2; ++ai)
#pragma unroll
            for (int m = 0; m < 4; ++m) { const int row = u.pm * BM + ai * HALF + wr * 64 + m * 16 + fr; const float s = row_rstd(ssp2, row); float ss = 0.f;
#pragma unroll
                for (int bj = 0; bj < 2; ++bj) { const size_t off = (size_t)row * DM + col0 + bj * HALF;
                    const h16x8 hb = *(const h16x8*)(h2 + off), pb = *(const h16x8*)(pp + off); float v[8];
#pragma unroll
                    for (int e = 0; e < 8; ++e) { v[e] = (float)hb[e] + fast_sigmoid(acc[ai][bj][m][e >> 2][e & 3] * s) * (float)pb[e]; ss += v[e] * v[e]; }
                    *(f32x4*)(out + off) = (f32x4){v[0], v[1], v[2], v[3]}; *(f32x4*)(out + off + 4) = (f32x4){v[4], v[5], v[6], v[7]}; }
                ss += __shfl_xor(ss, 16); ss += __shfl_xor(ss, 32);
                if (fq == 0) ssp3[(size_t)row * 16 + u.pn * 4 + wc] = ss; }
    }
};
}

template <class ColMap>
__device__ __forceinline__ void transpose_items(int K, int Nsrc, h16* WT, int Nrows, ColMap cm, const float* __restrict__ kscale, LAS float* scr, int gw, int NGW, int lane) {
    const int nblk = Nrows / 32, items = (K / 64) * nblk;
    for (int it = gw; it < items; it += NGW) {
        const int kb = it / nblk, nb = it % nblk, k0 = 64 * kb, n0 = 32 * nb;
        const float* src = cm(n0 + (lane & 31));
#pragma unroll 8
        for (int i = 0; i < 32; ++i) { const int kk = 2 * i + (lane >> 5); float v = 0.f;
            if (src) { v = src[(size_t)(k0 + kk) * Nsrc]; if (kscale) v *= kscale[k0 + kk]; }
            scr[kk * 33 + (lane & 31)] = v; }
        asm volatile("s_waitcnt lgkmcnt(0)" ::: "memory");
        const int c = lane & 7;
#pragma unroll
        for (int j = 0; j < 4; ++j) { const int n = (lane >> 3) + 8 * j; const LAS float* s = scr + (8 * c) * 33 + n;
            u32x4 o; o.x = pkh(s[0 * 33], s[1 * 33]); o.y = pkh(s[2 * 33], s[3 * 33]); o.z = pkh(s[4 * 33], s[5 * 33]); o.w = pkh(s[6 * 33], s[7 * 33]);
            *(u32x4*)(WT + (size_t)(n0 + n) * K + k0 + 8 * c) = o; }
        asm volatile("s_waitcnt lgkmcnt(0)" ::: "memory");
    }
}
__device__ __forceinline__ int win_colmap(int np) {
    const int pn = np >> 8, p = np & 255, bj = p >> 7, wc = (p >> 5) & 3, r = p & 31;
    const int LC = 256 * pn + 64 * wc + 32 * bj + r;
    if (LC < 512) return LC;
    if (LC < 576) return LC;
    if (LC < 640) return LC;
    if (LC < 704) return 896 + (LC - 640);
    if (LC < 708) return 960 + (LC - 704);
    if (LC < 768) return -1;
    if (LC < 1024) return 640 + (LC - 768);
    if (LC < 1536) return 964 + (LC - 1024);
    if (LC < 2048) return 1476 + (LC - 1536);
    return 1988 + (LC - 2048);
}

constexpr int DSA_LDS_RED = 0  , DSA_LDS_FRED = 1024  , DSA_LDS_META = 2048  , DSA_LDS_LIST = 2304  , DSA_LDS_VBUF = 10496  ,
              DSA_LDS_QF = 84224  , DSA_LDS_BUF = 92416  , DSA_LDS_CANDB = 133376  , DSA_LDS_TRASH = 137472  ;
constexpr int DSA_CAP = 64, DSA_BUFN = 320;
constexpr float ZEPS = 0x1p-120f;
constexpr int VROW = 144;

struct AttnPtrs { const h16 *QA, *KA, *VA, *QI, *KI, *QB, *KB, *VB; const float* WI; const float* kmp; h16* Y; };

__device__ __forceinline__ void cnt_ge(int& c, float s, float tau) { asm volatile("v_cmp_ge_f32 vcc, %1, %2\n\tv_addc_co_u32 %0, vcc, 0, %0, vcc" : "+v"(c) : "v"(s), "v"(tau) : "vcc"); }
__device__ __forceinline__ void cnt_gt(int& c, float s, float tau) { asm volatile("v_cmp_gt_f32 vcc, %1, %2\n\tv_addc_co_u32 %0, vcc, 0, %0, vcc" : "+v"(c) : "v"(s), "v"(tau) : "vcc"); }
__device__ __forceinline__ void cnt_tie(int& c, float s, float t3, int key, int im) { unsigned long long tmp;
    asm volatile("v_cmp_eq_f32 vcc, %2, %3\n\tv_cmp_le_i32 %1, %4, %5\n\ts_and_b64 vcc, vcc, %1\n\tv_addc_co_u32 %0, vcc, 0, %0, vcc" : "+v"(c), "=&s"(tmp) : "v"(s), "v"(t3), "v"(key), "v"(im) : "vcc"); }
__device__ __forceinline__ int dsa_count_ge(const f32x4 (&S)[8][4], int nch, float tau) {
    int c = 0;
#pragma unroll
    for (int ch = 0; ch < 8; ++ch) if (ch < nch) {
#pragma unroll
        for (int tt = 0; tt < 4; ++tt)
#pragma unroll
            for (int i = 0; i < 4; ++i) cnt_ge(c, S[ch][tt][i], tau);
    }
    return c;
}
__device__ __forceinline__ int dsa_total(int c, LAS unsigned* red, int par, int wid, int q16, int g) {
    c += __shfl_xor(c, 16); c += __shfl_xor(c, 32);
    if (g == 0) red[(par * 8 + wid) * 16 + q16] = (unsigned)c;
    __syncthreads();
    int t = 0;
#pragma unroll
    for (int w = 0; w < 8; ++w) t += (int)red[(par * 8 + w) * 16 + q16];
    return t;
}

__device__ __forceinline__ void dsa_unit(LAS unsigned char* lds, const AttnPtrs& P, int b, int qt) {
    const int tid = threadIdx.x, lane = tid & 63, wid = __builtin_amdgcn_readfirstlane(tid >> 6), q16 = lane & 15, g = lane >> 4;
    LAS unsigned* red = (LAS unsigned*)(lds + DSA_LDS_RED); LAS float* fred = (LAS float*)(lds + DSA_LDS_FRED);
    LAS unsigned short* list = (LAS unsigned short*)(lds + DSA_LDS_LIST);
    const int t0 = qt * 16, myq = t0 + q16; const size_t brow = (size_t)b * SEQ;
    const int nch = (t0 + 15) / 512 + 1;
    f32x4 S[8][4];
#pragma unroll
    for (int ch = 0; ch < 8; ++ch)
#pragma unroll
        for (int tt = 0; tt < 4; ++tt) S[ch][tt] = (f32x4){NEG_INF, NEG_INF, NEG_INF, NEG_INF};
    float smax = NEG_INF, smin = -NEG_INF; int nvl = 0;
    {
        LAS h16x8* qfl = (LAS h16x8*)(lds + DSA_LDS_QF);
        qfl[wid * 64 + lane] = *(const h16x8*)(P.QI + (brow + myq) * 256 + (wid >> 1) * 64 + (wid & 1) * 32 + g * 8);
        __syncthreads();
        const f32x4 wv = *(const f32x4*)(P.WI + (brow + myq) * 4);
#ifndef X_NOSCORE
        for (int rep_sc = 0; rep_sc < REP_SC; ++rep_sc) {
        h16x8 pa0 = *(const h16x8*)(P.KI + (brow + 64 * wid + q16) * 64 + g * 8), pa1 = *(const h16x8*)(P.KI + (brow + 64 * wid + q16) * 64 + 32 + g * 8);
#pragma unroll
        for (int ch = 0; ch < 8; ++ch) if (ch < nch) {
#pragma unroll
            for (int tt = 0; tt < 4; ++tt) {
                const int kt = 512 * ch + 64 * wid + 16 * tt;
                const h16x8 a0 = pa0, a1 = pa1;
                { const int nidx = ch * 4 + tt + 1; int kn = 512 * (nidx >> 2) + 64 * wid + 16 * (nidx & 3); kn = kn < SEQ - 16 ? kn : SEQ - 16;
                  pa0 = *(const h16x8*)(P.KI + (brow + kn + q16) * 64 + g * 8); pa1 = *(const h16x8*)(P.KI + (brow + kn + q16) * 64 + 32 + g * 8); }
                if (kt <= t0 + 15) {
                    f32x4 sc = {0.f, 0.f, 0.f, 0.f};
#pragma unroll
                    for (int h = 0; h < 4; ++h) { f32x4 acc = {0.f, 0.f, 0.f, 0.f};
                        const h16x8 b0 = qfl[(2 * h) * 64 + lane], b1 = qfl[(2 * h + 1) * 64 + lane];
                        acc = __builtin_amdgcn_mfma_f32_16x16x32_f16(a0, b0, acc, 0, 0, 0);
                        acc = __builtin_amdgcn_mfma_f32_16x16x32_f16(a1, b1, acc, 0, 0, 0);
#pragma unroll
                        for (int i = 0; i < 4; ++i) sc[i] += wv[h] * __builtin_fmaxf(acc[i], 0.f); }
                    const int key0 = kt + 4 * g;
                    const float zb = -(float)(key0 + 1) * ZEPS;
#pragma unroll
                    for (int i = 0; i < 4; ++i) { const bool ok = (key0 + i) <= myq; float v = sc[i]; v = (v == 0.f) ? (zb - (float)i * ZEPS) : v; v = ok ? v : NEG_INF; sc[i] = v;
                        smax = __builtin_fmaxf(smax, v); smin = __builtin_fminf(smin, ok ? v : -NEG_INF); nvl += ok ? 1 : 0; }
                    S[ch][tt] = sc;
                }
                __builtin_amdgcn_sched_barrier(0);
            }
        }
        }
#endif
    }
    smax = __builtin_fmaxf(smax, __shfl_xor(smax, 16)); smax = __builtin_fmaxf(smax, __shfl_xor(smax, 32));
    smin = __builtin_fminf(smin, __shfl_xor(smin, 16)); smin = __builtin_fminf(smin, __shfl_xor(smin, 32));
    if (g == 0) { fred[(wid * 16 + q16) * 2] = smax; fred[(wid * 16 + q16) * 2 + 1] = smin; }
    __syncthreads();
#pragma unroll
    for (int w = 0; w < 8; ++w) { smax = __builtin_fmaxf(smax, fred[(w * 16 + q16) * 2]); smin = __builtin_fminf(smin, fred[(w * 16 + q16) * 2 + 1]); }
    const int nv = myq + 1; int par = 0;
    float lo = smin, hi; int c_lo = nv, c_hi = 0, cl_lo = nvl, cl_hi = 0;
    { const unsigned mb = __float_as_uint(smax); hi = __uint_as_float(smax > 0.f ? mb + 1u : mb - 1u); }
    const float TZ = -4097.0f * ZEPS;
    bool done = false, ovf = false;
    if (nv <= 256) { hi = lo; c_hi = c_lo; cl_hi = cl_lo; done = true; }
    auto pick = [&](float l, float h) -> float { if (l < 0.f && h > 0.f) return 0.f; if (l < TZ && h > TZ) return TZ; return l + (h - l) * 0.5f; };
    while (__any(!done)) {
        const float tau = done ? -NEG_INF : pick(lo, hi);
        const int clp = dsa_count_ge(S, nch, tau);
        const int c = dsa_total(clp, red, par, wid, q16, g); par ^= 1;
        if (!done) {
            if (c >= 256) { lo = tau; c_lo = c; cl_lo = clp; } else { hi = tau; c_hi = c; cl_hi = clp; }
            if (c_lo == 256) { hi = lo; c_hi = c_lo; cl_hi = cl_lo; done = true; }
            else if (c_lo - c_hi <= DSA_CAP) done = true;
            else { const float nt = pick(lo, hi); if (!(nt > lo && nt < hi)) { done = true; ovf = true; } }
        }
    }
    const int kb0 = 64 * wid + 4 * g;
    int istar = 0x7fffffff;
    if (__any(ovf)) {
        const int R = 256 - c_hi; int ilo = -1, ihi = myq;
        while (__any(ovf && ihi - ilo > 1)) {
            const int im = ovf ? ((ilo + ihi) >> 1) : -1;
            int c = 0;
#pragma unroll
            for (int ch = 0; ch < 8; ++ch) if (ch < nch) {
#pragma unroll
                for (int tt = 0; tt < 4; ++tt)
#pragma unroll
                    for (int i = 0; i < 4; ++i) cnt_tie(c, S[ch][tt][i], lo, kb0, im - (512 * ch + 16 * tt + i));
            }
            c = dsa_total(c, red, par, wid, q16, g); par ^= 1;
            if (ovf && ihi - ilo > 1) { if (c >= R) ihi = im; else ilo = im; }
        }
        if (ovf) istar = ihi;
        int c = 0;
#pragma unroll
        for (int ch = 0; ch < 8; ++ch) if (ch < nch) {
#pragma unroll
            for (int tt = 0; tt < 4; ++tt)
#pragma unroll
                for (int i = 0; i < 4; ++i) { const float s = S[ch][tt][i]; const int key = kb0 + 512 * ch + 16 * tt + i; c += (s >= lo && (s >= hi || key <= istar)) ? 1 : 0; }
        }
        if (ovf) { cl_lo = c; c_lo = 256; c_hi = 256; hi = NEG_INF; }
    }
    unsigned nw;
    {
        const int p = cl_lo;
        const int u1 = __shfl_up(p, 16); const int s1 = p + (g >= 1 ? u1 : 0);
        const int u2 = __shfl_up(s1, 32); const int s2 = s1 + (g >= 2 ? u2 : 0);
        if (g == 3) red[(par * 8 + wid) * 16 + q16] = (unsigned)s2;
        __syncthreads();
        int bw = 0;
#pragma unroll
        for (int w = 0; w < 8; ++w) { const int t = (int)red[(par * 8 + w) * 16 + q16]; bw += (w < wid) ? t : 0; }
        par ^= 1;
        nw = (unsigned)(bw + s2 - p);
    }
    if (wid == 0 && g == 0) ((LAS u32x4*)(lds + DSA_LDS_META))[q16] = (u32x4){(unsigned)c_lo, (unsigned)c_hi, __float_as_uint(hi), 0u};
    {
        const unsigned bufq = (unsigned)(uintptr_t)(lds + DSA_LDS_BUF + q16 * (DSA_BUFN * 8)), trash = (unsigned)(uintptr_t)(lds + DSA_LDS_TRASH + tid * 8);
        if (!__any(ovf)) {
#pragma unroll
            for (int ch = 0; ch < 8; ++ch) if (ch < nch) {
#pragma unroll
                for (int tt = 0; tt < 4; ++tt)
#pragma unroll
                    for (int i = 0; i < 4; ++i) { const float s = S[ch][tt][i]; const int key = kb0 + 512 * ch + 16 * tt + i; unsigned a;
                        asm volatile("v_cmp_ge_f32 vcc, %2, %3\n\tv_lshl_add_u32 %0, %1, 3, %4\n\tv_cndmask_b32 %0, %5, %0, vcc\n\tv_addc_co_u32 %1, vcc, 0, %1, vcc\n\tds_write2_b32 %0, %2, %6 offset1:1"
                                     : "=&v"(a), "+v"(nw) : "v"(s), "v"(lo), "v"(bufq), "v"(trash), "v"(key) : "vcc", "memory"); }
            }
        } else {
#pragma unroll
            for (int ch = 0; ch < 8; ++ch) if (ch < nch) {
#pragma unroll
                for (int tt = 0; tt < 4; ++tt)
#pragma unroll
                    for (int i = 0; i < 4; ++i) { const float s = S[ch][tt][i]; const int key = kb0 + 512 * ch + 16 * tt + i;
                        const bool w = (s >= lo && (s >= hi || key <= istar));
                        const unsigned a = w ? (bufq + nw * 8u) : trash; nw += w ? 1u : 0u;
                        asm volatile("ds_write2_b32 %0, %1, %2 offset1:1" :: "v"(a), "v"(s), "v"(key) : "memory"); }
            }
        }
    }
    asm volatile("s_waitcnt lgkmcnt(0)" ::: "memory");
    __syncthreads();
#ifndef X_NOATT
    int lane_o = lane;
    {
    LAS unsigned char* vbuf = lds + DSA_LDS_VBUF + wid * (2 * 32 * VROW);
#pragma unroll 1
    for (int qq2 = 0; qq2 < 2 * REP_ATT; ++qq2) { const int qq = qq2 & 1;
        asm volatile("" : "+v"(lane_o));
        const int lane = lane_o, q16 = lane & 15, g = lane >> 4;
        const int ql = 2 * wid + qq; const int qpos = t0 + ql; const int n = (qpos + 1 < 256) ? qpos + 1 : 256;
        LAS unsigned short* ql_list = list + ql * 256;
        {
            const u32x4 mt = ((const LAS u32x4*)(lds + DSA_LDS_META))[ql];
            const int n_e = (int)mt.x, chi = (int)mt.y; const float hiv = __uint_as_float(mt.z); const int R = 256 - chi;
            const LAS u32x2* bq = (const LAS u32x2*)(lds + DSA_LDS_BUF) + ql * DSA_BUFN;
            LAS u32x2* cb = (LAS u32x2*)(lds + DSA_LDS_CANDB) + wid * 64;
            int base_s = 0, base_c = 0;
#pragma unroll
            for (int k = 0; k < 5; ++k) { const int e = lane + 64 * k; const bool valid = e < n_e; u32x2 ent = {0u, 0u}; if (valid) ent = bq[e];
                const float s = __uint_as_float(ent.x); const bool sure = valid && (s >= hiv), cand = valid && !(s >= hiv);
                const unsigned long long bs = __ballot(sure), bc = __ballot(cand);
                const int ps = base_s + (int)__builtin_amdgcn_mbcnt_hi((unsigned)(bs >> 32), __builtin_amdgcn_mbcnt_lo((unsigned)bs, 0u));
                const int pc = base_c + (int)__builtin_amdgcn_mbcnt_hi((unsigned)(bc >> 32), __builtin_amdgcn_mbcnt_lo((unsigned)bc, 0u));
                if (sure && ps < 256) ql_list[ps] = (unsigned short)ent.y;
                if (cand && pc < 64) cb[pc] = ent;
                base_s += __popcll(bs); base_c += __popcll(bc); }
            const int m = base_c < 64 ? base_c : 64;
            asm volatile("s_waitcnt lgkmcnt(0)" ::: "memory");
            u32x2 my = {0u, 0u}; if (lane < m) my = cb[lane];
            const float mys = __uint_as_float(my.x); int rank = 0;
#pragma unroll 4
            for (int jx = 0; jx < m; ++jx) { const u32x2 o = cb[jx]; const float os = __uint_as_float(o.x); rank += (os > mys || (os == mys && o.y < my.y)) ? 1 : 0; }
            if (lane < m && rank < R && chi + rank < 256) ql_list[chi + rank] = (unsigned short)my.y;
            asm volatile("s_waitcnt lgkmcnt(0)" ::: "memory");
        }
        const int head = q16 & 7;
        h16x8 qf[2];
#pragma unroll
        for (int ks = 0; ks < 2; ++ks) qf[ks] = *(const h16x8*)(P.QA + (brow + qpos) * 512 + head * 64 + ks * 32 + g * 8);
        f32x4 L[16];
        {
            h16x8 ka[2][2][2];
#pragma unroll
            for (int u = 0; u < 2; ++u) { const int e = 16 * u + q16; const int key = (e < n) ? (int)ql_list[e] : 0;
                ka[0][u][0] = *(const h16x8*)(P.KA + (brow + key) * 64 + g * 8); ka[0][u][1] = *(const h16x8*)(P.KA + (brow + key) * 64 + 32 + g * 8); }
#pragma unroll
            for (int gi = 0; gi < 8; ++gi) {
                if (gi < 7) {
#pragma unroll
                    for (int u = 0; u < 2; ++u) { const int e = 16 * (2 * (gi + 1) + u) + q16; const int key = (e < n) ? (int)ql_list[e] : 0;
                        ka[(gi + 1) & 1][u][0] = *(const h16x8*)(P.KA + (brow + key) * 64 + g * 8); ka[(gi + 1) & 1][u][1] = *(const h16x8*)(P.KA + (brow + key) * 64 + 32 + g * 8); }
                }
#pragma unroll
                for (int u = 0; u < 2; ++u) { const int T = 2 * gi + u;
                    f32x4 acc = {0.f, 0.f, 0.f, 0.f};
                    acc = __builtin_amdgcn_mfma_f32_16x16x32_f16(ka[gi & 1][u][0], qf[0], acc, 0, 0, 0);
                    acc = __builtin_amdgcn_mfma_f32_16x16x32_f16(ka[gi & 1][u][1], qf[1], acc, 0, 0, 0);
#pragma unroll
                    for (int i = 0; i < 4; ++i) if (16 * T + 4 * g + i >= n) acc[i] = NEG_INF;
                    L[T] = acc; }
                __builtin_amdgcn_sched_barrier(0);
            }
        }
        float mx = NEG_INF;
#pragma unroll
        for (int T = 0; T < 16; ++T)
#pragma unroll
            for (int i = 0; i < 4; ++i) mx = __builtin_fmaxf(mx, L[T][i]);
        mx = __builtin_fmaxf(mx, __shfl_xor(mx, 16)); mx = __builtin_fmaxf(mx, __shfl_xor(mx, 32));
        float lsum = 0.f;
#pragma unroll
        for (int T = 0; T < 16; ++T)
#pragma unroll
            for (int i = 0; i < 4; ++i) { const float p = __builtin_amdgcn_exp2f(L[T][i] - mx); L[T][i] = p; lsum += p; }
        lsum += __shfl_xor(lsum, 16); lsum += __shfl_xor(lsum, 32);
        __builtin_amdgcn_sched_barrier(0);
        f32x4 O[4];
#pragma unroll
        for (int db = 0; db < 4; ++db) O[db] = (f32x4){0.f, 0.f, 0.f, 0.f};
        u32x4 vreg[4];
#pragma unroll
        for (int i = 0; i < 4; ++i) { const int j = lane >> 3; const int e = 16 * (j >> 2) + 4 * i + (j & 3); const int key = (e < n) ? (int)ql_list[e] : 0;
            vreg[i] = *(const u32x4*)(P.VA + (brow + key) * 64 + 8 * (lane & 7)); }
#pragma unroll
        for (int cc = 0; cc < 8; ++cc) {
            LAS unsigned char* vb = vbuf + (cc & 1) * (32 * VROW);
#pragma unroll
            for (int i = 0; i < 4; ++i) *(LAS u32x4*)(vb + (8 * i + (lane >> 3)) * VROW + 16 * (lane & 7)) = vreg[i];
            if (cc < 7) {
#pragma unroll
                for (int i = 0; i < 4; ++i) { const int j = lane >> 3; const int e = 16 * (2 * (cc + 1) + (j >> 2)) + 4 * i + (j & 3); const int key = (e < n) ? (int)ql_list[e] : 0;
                    vreg[i] = *(const u32x4*)(P.VA + (brow + key) * 64 + 8 * (lane & 7)); }
            }
            asm volatile("s_waitcnt lgkmcnt(0)" ::: "memory");
            h16x8 pa;
#pragma unroll
            for (int i = 0; i < 4; ++i) { pa[i] = (h16)L[2 * cc][i]; pa[4 + i] = (h16)L[2 * cc + 1][i]; }
#pragma unroll
            for (int db = 0; db < 4; ++db) {
                const LAS unsigned char* pb = vb + (8 * g + ((lane & 15) >> 2)) * VROW + (16 * db + 4 * (lane & 3)) * 2;
                const s16x4 lo4 = __builtin_amdgcn_ds_read_tr16_b64_v4i16((LAS s16x4*)pb);
                const s16x4 hi4 = __builtin_amdgcn_ds_read_tr16_b64_v4i16((LAS s16x4*)(pb + 4 * VROW));
                const s16x8 bf = {lo4[0], lo4[1], lo4[2], lo4[3], hi4[0], hi4[1], hi4[2], hi4[3]};
                O[db] = __builtin_amdgcn_mfma_f32_16x16x32_f16(pa, __builtin_bit_cast(h16x8, bf), O[db], 0, 0, 0);
            }
            __builtin_amdgcn_sched_barrier(0);
        }
#pragma unroll
        for (int i = 0; i < 4; ++i) { const float lh = __shfl(lsum, (4 * g + i) & 7); const float rl = 1.0f / lh;
            if (g < 2) {
#pragma unroll
                for (int db = 0; db < 4; ++db) P.Y[(brow + qpos) * DM + (4 * g + i) * 64 + 16 * db + q16] = (h16)(O[db][i] * rl); } }
    }
    }
#endif
    __syncthreads();
}

constexpr int MB_LDS_KM = 0  , MB_LDS_KV = 4096  , MB_TILE = 64 * VROW;
__device__ __forceinline__ int crow(int r, int hi) { return (r & 3) + 8 * (r >> 2) + 4 * hi; }

__device__ __forceinline__ void moba_unit(LAS unsigned char* lds, const AttnPtrs& P, int b, int h, int j) {
    const int tid = threadIdx.x, lane = tid & 63, wid = __builtin_amdgcn_readfirstlane(tid >> 6), r32 = lane & 31, hi = lane >> 5;
    const size_t brow = (size_t)b * SEQ; const int q0 = 256 * j; const int qrel = 32 * wid + r32; const size_t qrow = brow + q0 + qrel;
    LAS float* km = (LAS float*)(lds + MB_LDS_KM);
    for (int i = tid; i < 16 * 64; i += 512) { const int n = i >> 6, d = i & 63; const size_t pm = (size_t)b * 16 + n;
        km[i] = (P.kmp[((pm * 2 + 0) * 8 + h) * 64 + d] + P.kmp[((pm * 2 + 1) * 8 + h) * 64 + d]) * (1.0f / 256.0f); }
    __syncthreads();
    h16x8 qf[4];
#pragma unroll
    for (int d0 = 0; d0 < 4; ++d0) qf[d0] = *(const h16x8*)(P.QB + qrow * 512 + h * 64 + d0 * 16 + hi * 8);
    unsigned selmask = 0u;
    {
        float gate[8];
#pragma unroll
        for (int nb = 0; nb < 8; ++nb) gate[nb] = 0.f;
#pragma unroll
        for (int c8 = 0; c8 < 8; ++c8) {
            const h16x8 qv = *(const h16x8*)(P.QB + qrow * 512 + h * 64 + c8 * 8);
#pragma unroll
            for (int nb = 0; nb < 8; ++nb) { const LAS float* kr = km + (8 * hi + nb) * 64 + c8 * 8;
#pragma unroll
                for (int e = 0; e < 8; ++e) gate[nb] += (float)qv[e] * kr[e]; }
        }
        float gall[16];
#pragma unroll
        for (int nb = 0; nb < 8; ++nb) { const float o = __shfl_xor(gate[nb], 32); gall[nb] = hi ? o : gate[nb]; gall[8 + nb] = hi ? gate[nb] : o; }
#pragma unroll
        for (int n = 0; n < 16; ++n) if (n >= j) gall[n] = NEG_INF;
#pragma unroll
        for (int pick = 0; pick < 3; ++pick) { float best = NEG_INF; int bi = -1;
#pragma unroll
            for (int n = 0; n < 16; ++n) if (gall[n] > best) { best = gall[n]; bi = n; }
            if (bi >= 0) { selmask |= 1u << bi;
#pragma unroll
                for (int n = 0; n < 16; ++n) if (n == bi) gall[n] = NEG_INF; } }
    }
    const int NT = 4 * (j + 1);
    const h16* Kg = P.KB + brow * 512 + h * 64; const h16* Vg = P.VB + brow * 512 + h * 64;
    const int lrow = tid >> 3, lch = tid & 7;
    auto tile_key0 = [&](int t) { return (t < 4) ? (q0 + 64 * t) : (64 * (t - 4)); };
    u32x4 kreg, vreg;
    { const int k0 = tile_key0(0); kreg = *(const u32x4*)(Kg + (size_t)(k0 + lrow) * 512 + lch * 8); vreg = *(const u32x4*)(Vg + (size_t)(k0 + lrow) * 512 + lch * 8); }
    { LAS unsigned char* kb = lds + MB_LDS_KV; *(LAS u32x4*)(kb + lrow * VROW + lch * 16) = kreg; *(LAS u32x4*)(kb + MB_TILE + lrow * VROW + lch * 16) = vreg; }
    __syncthreads();
    float mrun = NEG_INF, lrun = 0.f; f32x16 o[2]; o[0] = f32x16{}; o[1] = f32x16{};
#pragma unroll 1
    for (int t = 0; t < NT; ++t) {
        if (t + 1 < NT) { const int k0 = tile_key0(t + 1); kreg = *(const u32x4*)(Kg + (size_t)(k0 + lrow) * 512 + lch * 8); vreg = *(const u32x4*)(Vg + (size_t)(k0 + lrow) * 512 + lch * 8); }
        const LAS unsigned char* kb = lds + MB_LDS_KV + (t & 1) * (2 * MB_TILE); const LAS unsigned char* vb = kb + MB_TILE;
        bool active;
        if (t < 4) active = (64 * t) <= (32 * wid + 31);
        else active = __any((selmask >> ((t - 4) >> 2)) & 1u);
        if (active) {
            f32x16 p0 = f32x16{}, p1 = f32x16{};
#pragma unroll
            for (int d0 = 0; d0 < 4; ++d0) {
                const h16x8 k0f = *(const LAS h16x8*)(kb + r32 * VROW + (16 * d0 + 8 * hi) * 2);
                const h16x8 k1f = *(const LAS h16x8*)(kb + (32 + r32) * VROW + (16 * d0 + 8 * hi) * 2);
                p0 = __builtin_amdgcn_mfma_f32_32x32x16_f16(k0f, qf[d0], p0, 0, 0, 0);
                p1 = __builtin_amdgcn_mfma_f32_32x32x16_f16(k1f, qf[d0], p1, 0, 0, 0);
            }
            if (t < 4) {
#pragma unroll
                for (int r = 0; r < 16; ++r) { const int kv = 64 * t + crow(r, hi); if (kv > qrel) p0[r] = NEG_INF; if (kv + 32 > qrel) p1[r] = NEG_INF; }
            } else if (!((selmask >> ((t - 4) >> 2)) & 1u)) {
#pragma unroll
                for (int r = 0; r < 16; ++r) { p0[r] = NEG_INF; p1[r] = NEG_INF; }
            }
            float mt = NEG_INF;
#pragma unroll
            for (int r = 0; r < 16; ++r) mt = __builtin_fmaxf(mt, __builtin_fmaxf(p0[r], p1[r]));
            mt = __builtin_fmaxf(mt, __shfl_xor(mt, 32));
            const float mnew = __builtin_fmaxf(mrun, mt);
            const float alpha = (mnew == NEG_INF) ? 1.0f : __builtin_amdgcn_exp2f(mrun - mnew);
            const float msub = (mnew == NEG_INF) ? 0.f : mnew;
            float ps = 0.f;
#pragma unroll
            for (int r = 0; r < 16; ++r) { p0[r] = __builtin_amdgcn_exp2f(p0[r] - msub); p1[r] = __builtin_amdgcn_exp2f(p1[r] - msub); ps += p0[r] + p1[r]; }
            lrun = lrun * alpha + ps; mrun = mnew;
            if (__any(alpha != 1.0f)) {
#pragma unroll
                for (int r = 0; r < 16; ++r) { o[0][r] *= alpha; o[1][r] *= alpha; }
            }
#pragma unroll
            for (int kt = 0; kt < 2; ++kt)
#pragma unroll
                for (int s = 0; s < 2; ++s) {
                    h16x8 pb;
#pragma unroll
                    for (int e = 0; e < 8; ++e) pb[e] = (h16)(kt ? p1[8 * s + e] : p0[8 * s + e]);
#pragma unroll
                    for (int db = 0; db < 2; ++db) {
                        const LAS unsigned char* pa = vb + (32 * kt + 16 * s + 4 * hi + ((lane & 15) >> 2)) * VROW + (32 * db + 16 * ((lane >> 4) & 1) + 4 * (lane & 3)) * 2;
                        const s16x4 lo4 = __builtin_amdgcn_ds_read_tr16_b64_v4i16((LAS s16x4*)pa);
                        const s16x4 hi4 = __builtin_amdgcn_ds_read_tr16_b64_v4i16((LAS s16x4*)(pa + 8 * VROW));
                        const s16x8 af = {lo4[0], lo4[1], lo4[2], lo4[3], hi4[0], hi4[1], hi4[2], hi4[3]};
                        o[db] = __builtin_amdgcn_mfma_f32_32x32x16_f16(__builtin_bit_cast(h16x8, af), pb, o[db], 0, 0, 0);
                    }
                }
        }
        if (t + 1 < NT) { LAS unsigned char* nb = lds + MB_LDS_KV + ((t + 1) & 1) * (2 * MB_TILE); *(LAS u32x4*)(nb + lrow * VROW + lch * 16) = kreg; *(LAS u32x4*)(nb + MB_TILE + lrow * VROW + lch * 16) = vreg; }
        __syncthreads();
    }
    lrun += __shfl_xor(lrun, 32);
    const float rl = 1.0f / lrun;
    h16* yrow = P.Y + qrow * DM + 512 + h * 64;
#pragma unroll
    for (int db = 0; db < 2; ++db)
#pragma unroll
        for (int rg = 0; rg < 4; ++rg) { u32x2 w; w.x = pkh(o[db][4 * rg] * rl, o[db][4 * rg + 1] * rl); w.y = pkh(o[db][4 * rg + 2] * rl, o[db][4 * rg + 3] * rl);
            *(u32x2*)(yrow + 32 * db + 8 * rg + 4 * hi) = w; }
}


#define XB_TMO      128
#define XB_XCNT(j)  (256  + 64 * (j))
#define XB_XSUB(j)  (1280 + 64 * (j))
#define XB_XGEN(j)  (2304 + 64 * (j))
#define XB_TOP      3328
#define XB_TOPGEN   3392
#define XCD_BAR_WORDS 3456
#define XB_SPIN_CAP (1u << 22)
__device__ __forceinline__ unsigned xb_ld(unsigned* p)              { return __hip_atomic_load(p, __ATOMIC_RELAXED, __HIP_MEMORY_SCOPE_AGENT); }
__device__ __forceinline__ unsigned xb_add(unsigned* p, unsigned v) { return __hip_atomic_fetch_add(p, v, __ATOMIC_RELAXED, __HIP_MEMORY_SCOPE_AGENT); }
__device__ __forceinline__ unsigned xb_xcc_id() { return (unsigned)__builtin_amdgcn_s_getreg((3 << 11) | 20) & 0xFu; }
#define XB_SPIN(cond, bar) do { unsigned _sp = 0; while (cond) { __builtin_amdgcn_s_sleep(1); \
    if ((++_sp & 255u) == 0u) { if (xb_ld(&(bar)[XB_TMO])) break; if (_sp > XB_SPIN_CAP) { atomicAdd(&(bar)[XB_TMO], 1u); break; } } } } while (0)
struct XcdBarrier { unsigned* bar; unsigned x; volatile LAS unsigned* st; };
__device__ __forceinline__ XcdBarrier xcd_barrier_post(unsigned* bar, volatile LAS unsigned* st) {
    XcdBarrier b; b.bar = bar; b.x = xb_xcc_id(); b.st = st;
    if (threadIdx.x == 0) (void)xb_add(&bar[XB_XCNT(b.x)], 1u);
    return b;
}
__device__ __forceinline__ void xcd_barrier_complete(unsigned* bar, unsigned x, unsigned& nloc, unsigned& nx) {
    const unsigned G = gridDim.x * gridDim.y * gridDim.z;
    unsigned sum, cnt, mine, sp = 0u;
    for (;;) {
        sum = 0u; cnt = 0u; mine = 0u;
#pragma unroll
        for (unsigned j = 0; j < 16; ++j) { const unsigned c = xb_ld(&bar[XB_XCNT(j)]); sum += c; cnt += (c > 0u) ? 1u : 0u; mine = (j == x) ? c : mine; }
        if (sum == G) break;
        __builtin_amdgcn_s_sleep(1);
        if ((++sp & 255u) == 0u) { if (xb_ld(&bar[XB_TMO])) break; if (sp > XB_SPIN_CAP) { atomicAdd(&bar[XB_TMO], 1u); break; } }
    }
    nloc = mine > 0u ? mine : 1u; nx = cnt > 0u ? cnt : 1u;
}
__device__ __forceinline__ void xcd_barrier(const XcdBarrier& b) {
    asm volatile("s_waitcnt vmcnt(0)" ::: "memory");
    __syncthreads();
    if (threadIdx.x == 0) {
        unsigned* bar = b.bar;
        __builtin_amdgcn_s_waitcnt(0);
        unsigned nloc = b.st[0], nx = b.st[1];
        if (nloc == 0u) { xcd_barrier_complete(bar, b.x, nloc, nx); b.st[0] = nloc; b.st[1] = nx; }
        const unsigned old = xb_add(&bar[XB_XSUB(b.x)], 1u);
        const unsigned gen = old / nloc;
        if (old + 1u == (gen + 1u) * nloc) {
            __builtin_amdgcn_fence(__ATOMIC_RELEASE, "agent");
            asm volatile("s_waitcnt vmcnt(0)" ::: "memory");
            const unsigned og = xb_add(&bar[XB_TOP], 1u);
            const unsigned tg = og / nx;
            if (og + 1u == (tg + 1u) * nx) xb_add(&bar[XB_TOPGEN], 1u);
            else XB_SPIN(xb_ld(&bar[XB_TOPGEN]) == tg, bar);
            __builtin_amdgcn_fence(__ATOMIC_ACQUIRE, "agent");
            xb_add(&bar[XB_XGEN(b.x)], 1u);
            asm volatile("s_waitcnt vmcnt(0)" ::: "memory");
        } else {
            XB_SPIN(xb_ld(&bar[XB_XGEN(b.x)]) == gen, bar);
            __builtin_amdgcn_fence(__ATOMIC_ACQUIRE, "agent");
            asm volatile("s_waitcnt vmcnt(0)" ::: "memory");
        }
    }
    __syncthreads();
}

constexpr int LDS_BYTES = 147456;
struct Args { const float* in[14]; float* out; unsigned char* ws; int ph_lo, ph_hi; };

__global__ void __launch_bounds__(512, 2) hymba_fwd(Args args) {
    extern __shared__ __attribute__((aligned(16))) unsigned char lds_raw[];
    LAS unsigned char* lds = (LAS unsigned char*)lds_raw;
    cg::grid_group grid = cg::this_grid();
    const int tid = threadIdx.x, lane = tid & 63, wave = __builtin_amdgcn_readfirstlane(tid >> 6);
    const int G = gridDim.x, bx = blockIdx.x;
    unsigned char* ws = args.ws;
    const float* x = args.in[0]; const float* p_in = args.in[1]; const float* g_attn = args.in[2]; const float* w_in = args.in[3]; const float* g_idx = args.in[4];
    const float* w_out = args.in[5]; const float* g_ffn = args.in[6]; const float* w_gate = args.in[7]; const float* w_up = args.in[8]; const float* w_down = args.in[9];
    const float* g_ple = args.in[10]; const float* w_pg = args.in[11]; const float* w_pp = args.in[12]; const float* g_final = args.in[13];
    h16* Wt_in = (h16*)(ws + WS_WIN); h16* Wt_out = (h16*)(ws + WS_WOUT); h16* Wt_gu = (h16*)(ws + WS_WGU); h16* Wt_dn = (h16*)(ws + WS_WDN); h16* Wt_pg = (h16*)(ws + WS_WPG); h16* Wt_pp = (h16*)(ws + WS_WPP);
    float* rope = (float*)(ws + WS_ROPE); float* rs0 = (float*)(ws + WS_RS0); float* ssp1 = (float*)(ws + WS_SSP1); float* ssp2 = (float*)(ws + WS_SSP2); float* ssp3 = (float*)(ws + WS_SSP3);
    float* kmp = (float*)(ws + WS_KMP); float* WI = (float*)(ws + WS_WI);
    h16* PH = (h16*)(ws + WS_PH); h16* PP = (h16*)(ws + WS_PP); h16* XH = (h16*)(ws + WS_XH); h16* H1 = XH; h16* Y = (h16*)(ws + WS_Y); h16* H2 = Y;
    h16* QA = (h16*)(ws + WS_QA); h16* KA = (h16*)(ws + WS_KA); h16* VA = (h16*)(ws + WS_VA); h16* QI = (h16*)(ws + WS_QI); h16* KI = (h16*)(ws + WS_KI);
    h16* QB = (h16*)(ws + WS_QB); h16* KB = (h16*)(ws + WS_KB); h16* VB = (h16*)(ws + WS_VB); h16* ACT = (h16*)(ws + WS_ACT);
    const int lo = args.ph_lo, hi_ph = args.ph_hi;
#ifndef PH_MASK
#define PH_MASK 0xff
#endif
#define IN(k) (((PH_MASK >> (k)) & 1) && lo <= (k) && (k) < hi_ph)
    volatile LAS unsigned* MISC = (volatile LAS unsigned*)(lds + LDS_BYTES - 256);
    unsigned* barw = (unsigned*)(ws + 0);
    XcdBarrier xbar; xbar.bar = barw; xbar.x = 0; xbar.st = MISC;
#define SEAM(k) do { if (IN(k) && IN((k) + 1)) { if ((k) == 0) { grid.sync(); if (tid == 0) { MISC[0] = 0u; MISC[1] = 0u; } __syncthreads(); xbar = xcd_barrier_post(barw, MISC); } else xcd_barrier(xbar); } } while (0)

    if (IN(0)) {
        if (bx == 0) for (int i = tid; i < XCD_BAR_WORDS; i += 512) barw[i] = 0u;
        LAS float* scr = (LAS float*)(lds + wave * 16384);
        const int gw = bx * 8 + wave, NGW = G * 8;
        transpose_items(DM, NIN_SRC, Wt_in, NIN, [=](int np) -> const float* { const int c = win_colmap(np); return c >= 0 ? w_in + c : nullptr; }, g_attn, scr, gw, NGW, lane);
        transpose_items(DM, DM, Wt_out, DM, [=](int np) -> const float* { return w_out + np; }, nullptr, scr, gw, NGW, lane);
        transpose_items(DM, DFF, Wt_gu, 2 * DFF, [=](int np) -> const float* { const int p = np & 255, t = np >> 8; return (p < 128) ? (w_gate + t * 128 + p) : (w_up + t * 128 + p - 128); }, g_ffn, scr, gw, NGW, lane);
        transpose_items(DFF, DM, Wt_dn, DM, [=](int np) -> const float* { return w_down + np; }, nullptr, scr, gw, NGW, lane);
        transpose_items(DM, DM, Wt_pg, DM, [=](int np) -> const float* { return w_pg + np; }, g_ple, scr, gw, NGW, lane);
        transpose_items(DPLE, DM, Wt_pp, DM, [=](int np) -> const float* { return w_pp + np; }, nullptr, scr, gw, NGW, lane);
        for (int m = gw; m < NTOK; m += NGW) {
            const f32x4* xr = (const f32x4*)(x + (size_t)m * DM) + lane; f32x4 v[4]; float s = 0.f;
#pragma unroll
            for (int jj = 0; jj < 4; ++jj) { v[jj] = xr[64 * jj]; s += (v[jj].x * v[jj].x + v[jj].y * v[jj].y) + (v[jj].z * v[jj].z + v[jj].w * v[jj].w); }
            s = wave_sum(s);
            if (lane == 0) rs0[m] = 1.0f / sqrtf(s * (1.0f / DM) + EPS);
            u32x2* o8 = (u32x2*)(XH + (size_t)m * DM) + lane;
#pragma unroll
            for (int jj = 0; jj < 4; ++jj) { u32x2 w; w.x = pkh(v[jj].x, v[jj].y); w.y = pkh(v[jj].z, v[jj].w); o8[64 * jj] = w; }
        }
        for (int m = gw; m < NTOK; m += NGW) { const f32x4 v = *((const f32x4*)(p_in + (size_t)m * DPLE) + lane); u32x2 w; w.x = pkh(v.x, v.y); w.y = pkh(v.z, v.w); *((u32x2*)(PH + (size_t)m * DPLE) + lane) = w; }
        for (int i = bx * 512 + tid; i < SEQ * 32; i += G * 512) {
            const int pos = i >> 5, jx = i & 31;
            const float inv = ROPE_INV[jx];
            const float ang = (float)pos * inv;
            const double a = (double)ang; const double kq = __builtin_rint(a * 0.15915494309189535);
            double r = __builtin_fma(-kq, 6.283185307179586, a); r = __builtin_fma(-kq, 2.4492935982947064e-16, r);
            const double r2 = r * r; double sn = 0.0, cs = 0.0;
            double ts = 1.0, tc = 1.0;
#pragma unroll
            for (int n = 13; n >= 1; --n) { ts = 1.0 - ts * r2 / (double)((2 * n) * (2 * n + 1)); tc = 1.0 - tc * r2 / (double)((2 * n - 1) * (2 * n)); }
            sn = r * ts; cs = tc;
            rope[(size_t)i * 2] = (float)cs; rope[(size_t)i * 2 + 1] = (float)sn;
        }
    }
    SEAM(0);
    if (IN(1)) {
        { pg8::Gemm g{XH, Wt_in, NTOK, NIN, DM}; pg8::StaticOrder S; S.init(NTOK, NIN, G, bx);
          pg8::EpiInProj E{rs0, rope, g_idx, QA, KA, VA, QI, KI, QB, KB, VB, WI, kmp};
          pg8::gemm_phase(lds, g, S, E); }
        { pg8::Gemm g{PH, Wt_pp, NTOK, DM, DPLE}; pg8::StaticOrder S; S.init(NTOK, DM, G, bx);
          pg8::EpiPlain E{PP, DM};
          pg8::gemm_phase(lds, g, S, E); }
    }
    SEAM(1);
    if (IN(2)) {
        AttnPtrs P{QA, KA, VA, QI, KI, QB, KB, VB, WI, kmp, Y};
        const int b = bx & 7, r = bx >> 3;
        const int nr = G >> 3;
#ifndef NO_DSA
        for (int rep = 0; rep < REP_DSA; ++rep)
        for (int s = r; s < 128; s += nr) { dsa_unit(lds, P, b, s); dsa_unit(lds, P, b, 255 - s); }
#endif
#ifndef NO_MOBA
        for (int rep = 0; rep < REP_MOBA; ++rep)
        for (int uu = r; uu < 64; uu += nr) { const int h = uu >> 3, s = uu & 7; moba_unit(lds, P, b, h, s); __syncthreads(); moba_unit(lds, P, b, h, 15 - s); __syncthreads(); }
#endif
    }
    SEAM(2);
    if (IN(3)) {
        pg8::Gemm g{Y, Wt_out, NTOK, DM, DM}; pg8::StaticOrder S; S.init(NTOK, DM, G, bx);
        pg8::EpiRes<true> E{x, H1, ssp1};
        pg8::gemm_phase(lds, g, S, E);
    }
    SEAM(3);
    if (IN(4)) {
        pg8::Gemm g{H1, Wt_gu, NTOK, 2 * DFF, DM}; pg8::StaticOrder S; S.init(NTOK, 2 * DFF, G, bx);
        pg8::EpiSwiGLU E{ssp1, ACT};
        pg8::gemm_phase(lds, g, S, E);
    }
    SEAM(4);
    if (IN(5)) {
        pg8::Gemm g{ACT, Wt_dn, NTOK, DM, DFF}; pg8::StaticOrder S; S.init(NTOK, DM, G, bx);
        pg8::EpiRes<false> E{H1, H2, ssp2};
        pg8::gemm_phase(lds, g, S, E);
    }
    SEAM(5);
    if (IN(6)) {
        pg8::Gemm g{H2, Wt_pg, NTOK, DM, DM}; pg8::StaticOrder S; S.init(NTOK, DM, G, bx);
        pg8::EpiPLE E{ssp2, H2, PP, args.out, ssp3};
        pg8::gemm_phase(lds, g, S, E);
    }
    SEAM(6);
    if (IN(7)) {
        const int gw = bx * 8 + wave, NGW = G * 8;
        f32x4 gf[4];
#pragma unroll
        for (int jj = 0; jj < 4; ++jj) gf[jj] = *((const f32x4*)g_final + lane + 64 * jj);
        for (int m = gw; m < NTOK; m += NGW) {
            const float s = pg8::row_rstd(ssp3, m);
            f32x4* o = (f32x4*)(args.out + (size_t)m * DM) + lane;
#pragma unroll
            for (int jj = 0; jj < 4; ++jj) { f32x4 v = o[64 * jj]; v = v * s * gf[jj]; o[64 * jj] = v; }
        }
    }
#undef IN
#undef SEAM
}

extern "C" void kernel_launch(void* const* d_in, const int* in_sizes, int n_in, void* d_out, int out_size, void* d_ws, size_t ws_size, hipStream_t stream) {
    static int grid = 0;
    if (grid == 0) {
        if (n_in != 14 || out_size != NTOK * DM || ws_size < WS_END) { fprintf(stderr, "kernel_launch: unexpected shapes (n_in %d out %d ws %zu)\n", n_in, out_size, ws_size); grid = -1; return; }
        int dev = 0, cus = 0, per_cu = 0;
        (void)hipGetDevice(&dev);
        (void)hipDeviceGetAttribute(&cus, hipDeviceAttributeMultiprocessorCount, dev);
        (void)hipFuncSetAttribute((const void*)hymba_fwd, hipFuncAttributeMaxDynamicSharedMemorySize, LDS_BYTES);
        (void)hipOccupancyMaxActiveBlocksPerMultiprocessor(&per_cu, (const void*)hymba_fwd, 512, LDS_BYTES);
        if (per_cu < 1) { fprintf(stderr, "kernel_launch: occupancy query says %d blocks/CU\n", per_cu); }
        grid = cus;
        if (grid % 8 != 0 || grid > 256) grid = (grid / 8) * 8 > 256 ? 256 : (grid / 8) * 8;
    }
    if (grid <= 0) return;
    Args a{};
    for (int i = 0; i < 14; ++i) a.in[i] = (const float*)d_in[i];
    a.out = (float*)d_out; a.ws = (unsigned char*)d_ws;
#if MK_COOP
    a.ph_lo = 0; a.ph_hi = 8;
    void* kargs[] = {&a};
    hipError_t e = hipLaunchCooperativeKernel((const void*)hymba_fwd, dim3(grid), dim3(512), kargs, LDS_BYTES, stream);
    if (e != hipSuccess) fprintf(stderr, "cooperative launch failed: %s (grid %d)\n", hipGetErrorString(e), grid);
#else
    for (int ph = 0; ph < 8; ++ph) { a.ph_lo = ph; a.ph_hi = ph + 1; hipLaunchKernelGGL(hymba_fwd, dim3(grid), dim3(512), LDS_BYTES, stream, a); }
#endif
}
```

```cpp
#include <hip/hip_runtime.h>
#include <hip/hip_cooperative_groups.h>
#include <cstdio>
#include <cstdint>
namespace cg = cooperative_groups;

#ifndef REP_DSA
#define REP_DSA 1
#endif
#ifndef REP_MOBA
#define REP_MOBA 1
#endif
#ifndef REP_ATT
#define REP_ATT 1
#endif
#ifndef REP_SC
#define REP_SC 1
#endif
#ifndef REP_SEL
#define REP_SEL 1
#endif
#ifndef REP_EM
#define REP_EM 1
#endif
#ifndef REPMASK
#define REPMASK 0
#endif
#ifndef MK_COOP
#define MK_COOP 1
#endif

#define LAS __attribute__((address_space(3)))
typedef _Float16 h16;
typedef _Float16 h16x8 __attribute__((ext_vector_type(8)));
typedef _Float16 h16x4 __attribute__((ext_vector_type(4)));
typedef _Float16 h16x2 __attribute__((ext_vector_type(2)));
typedef short s16x8 __attribute__((ext_vector_type(8)));
typedef short s16x4 __attribute__((ext_vector_type(4)));
typedef float f32x2 __attribute__((ext_vector_type(2)));
typedef float f32x4 __attribute__((ext_vector_type(4)));
typedef float f32x16 __attribute__((ext_vector_type(16)));
typedef unsigned u32x2 __attribute__((ext_vector_type(2)));
typedef unsigned u32x4 __attribute__((ext_vector_type(4)));

constexpr int BATCH = 8, SEQ = 4096, DM = 1024, NTOK = BATCH * SEQ, NIN = 2560, NIN_SRC = 2500, DFF = 2816, DPLE = 256;
constexpr float EPS = 1e-6f;
constexpr float C2 = 0.125f * 1.4426950408889634f;
constexpr float NEG_INF = -__builtin_huge_valf();

constexpr size_t MiB = 1u << 20;
constexpr size_t WS_WIN = 1 * MiB, WS_WOUT = 6 * MiB, WS_WGU = 8 * MiB, WS_WDN = 19 * MiB, WS_WPG = 25 * MiB, WS_WPP = 27 * MiB;
constexpr size_t WS_ROPE = 28 * MiB, WS_RS0 = 29 * MiB, WS_SSP1 = 30 * MiB, WS_SSP2 = 32 * MiB, WS_SSP3 = 34 * MiB, WS_KMP = 36 * MiB, WS_WI = 37 * MiB;
constexpr size_t WS_PH = 38 * MiB, WS_PP = 54 * MiB, WS_XH = 118 * MiB  , WS_Y = 182 * MiB  ;
constexpr size_t WS_QA = 246 * MiB, WS_KA = 278 * MiB, WS_VA = 282 * MiB, WS_QI = 286 * MiB, WS_KI = 302 * MiB, WS_QB = 306 * MiB, WS_KB = 338 * MiB, WS_VB = 370 * MiB;
constexpr size_t WS_ACT = 246 * MiB  , WS_END = 422 * MiB;

__constant__ float ROPE_INV[32] = {0x1.0000000000000p+0f, 0x1.7ff2220000000p-1f, 0x1.1feb340000000p-1f, 0x1.afd1360000000p-2f, 0x1.43d1360000000p-2f, 0x1.e5a8480000000p-3f, 0x1.6c310e0000000p-3f, 0x1.111aee0000000p-3f,
    0x1.99999a0000000p-4f, 0x1.33281c0000000p-4f, 0x1.ccab860000000p-5f, 0x1.59742a0000000p-5f, 0x1.030dc40000000p-5f, 0x1.8486a00000000p-6f, 0x1.235a720000000p-6f, 0x1.b4f7e20000000p-7f,
    0x1.47ae140000000p-7f, 0x1.eb73600000000p-8f, 0x1.7089380000000p-8f, 0x1.145cee0000000p-8f, 0x1.9e7c6e0000000p-9f, 0x1.36d21a0000000p-9f, 0x1.d22a500000000p-10f, 0x1.5d931c0000000p-10f,
    0x1.0624de0000000p-10f, 0x1.8929180000000p-11f, 0x1.26d42c0000000p-11f, 0x1.ba2e4c0000000p-12f, 0x1.4b96be0000000p-12f, 0x1.f150280000000p-13f, 0x1.74eea60000000p-13f, 0x1.17a8e40000000p-13f};
__device__ __forceinline__ unsigned pkh(float lo, float hi) { h16x2 v = {(h16)lo, (h16)hi}; return __builtin_bit_cast(unsigned, v); }
__device__ __forceinline__ float wave_sum(float v) {
#pragma unroll
    for (int o = 1; o < 64; o <<= 1) v += __shfl_xor(v, o);
    return v;
}
__device__ __forceinline__ float fast_sigmoid(float x) { return __builtin_amdgcn_rcpf(1.0f + __builtin_amdgcn_exp2f(-1.4426950408889634f * x)); }

namespace pg8 {
constexpr int BM = 256, BK = 64, HALF = 128, HTB = HALF * BK * 2, STAGE_BYTES = 8 * HTB, NXCD = 8, WGM = 8;
__host__ __device__ __forceinline__ int lds_byte(int r, int c) { const int st = (r >> 4) * 2 + (c >> 5), rr = r & 15, cc = c & 31, ob = rr * 64 + cc * 2; return st * 1024 + (ob ^ (((ob >> 9) & 1) << 5)); }
__host__ __device__ __forceinline__ void stage_rc(int b, int& R, int& C) { const int st = b / 1024, sb = b % 1024, swz = sb ^ (((sb >> 9) & 1) << 5); R = (st >> 1) * 16 + swz / 64; C = (st & 1) * 32 + (swz % 64) / 2; }
__host__ __device__ __forceinline__ int perm32(int rho) { const int n = rho >> 4, i = rho & 15; return 8 * (i >> 2) + 4 * n + (i & 3); }
struct Unit { int pm, pn; };
struct Gemm { const h16* A; const h16* Bt; int M, N, K; };
struct StaticOrder {
    int nM, nN, nwg, G, c;
    __host__ __device__ void init(int M, int N, int G_, int c_) { nM = M / BM; nN = N / BM; nwg = nM * nN; G = G_; c = c_; }
    __host__ __device__ bool next(int i, Unit& u) const {
        const long L = (long)i * G + c; if (L >= nwg) return false;
        int wgid = (int)L; { const int q = nwg / NXCD, r = nwg % NXCD, xcd = wgid % NXCD, off = wgid / NXCD; wgid = (xcd < r ? xcd * (q + 1) : r * (q + 1) + (xcd - r) * q) + off; }
        const int nig = WGM * nN, gid = wgid / nig, fm = gid * WGM, gsz = (nM - fm) < WGM ? (nM - fm) : WGM;
        u.pm = fm + ((wgid % nig) % gsz); u.pn = (wgid % nig) / gsz; return true;
    }
};
template <class Epi>
__device__ __forceinline__ void gemm_phase(LAS unsigned char* lds, const Gemm g, const StaticOrder& S, const Epi& E) {
    const int tid = threadIdx.x, wid = __builtin_amdgcn_readfirstlane(tid >> 6), lane = tid & 63, wr = wid >> 2, wc = wid & 3, fr = lane & 15, fq = lane >> 4;
    const int K = g.K, nt = K / BK;
    unsigned voffA[2], voffB[2];
#pragma unroll
    for (int i = 0; i < 2; ++i) { int R, C; stage_rc(tid * 16 + i * 8192, R, C); const int Rb = (R & ~31) + perm32(R & 31);
        voffA[i] = (unsigned)(R * K + C) * 2u; voffB[i] = (unsigned)(Rb * K + C) * 2u; }
    const size_t kstep = (size_t)(BK * 2);
    const size_t hstep = (size_t)HALF * K * 2;
    const size_t tstep = 2 * hstep;
    const unsigned ldsw = (unsigned)wid * 1024u;
    const int aoff = lds_byte(wr * 64 + fr, fq * 8), boff = lds_byte(wc * 32 + fr, fq * 8);
#define PG8_SA(b, h) (((b) * 2 + (h)) * HTB)
#define PG8_SB(b, h) ((4 + (b) * 2 + (h)) * HTB)
#define PG8_STAGE(bufoff, gbase, voff) do { _Pragma("unroll") for (int _i = 0; _i < 2; ++_i) \
        __builtin_amdgcn_global_load_lds((const unsigned*)((const char*)(gbase) + (voff)[_i]), (LAS unsigned*)(lds + (bufoff) + ldsw + _i * 8192), 16, 0, 0); } while (0)
#define PG8_LDA(dst, b, h) do { _Pragma("unroll") for (int m = 0; m < 4; ++m) _Pragma("unroll") for (int k = 0; k < 2; ++k) dst[m][k] = *(const LAS s16x8*)(lds + PG8_SA(b, h) + aoff + m * 2048 + k * 1024); } while (0)
#define PG8_LDB(dst, b, h) do { _Pragma("unroll") for (int n = 0; n < 2; ++n) _Pragma("unroll") for (int k = 0; k < 2; ++k) dst[n][k] = *(const LAS s16x8*)(lds + PG8_SB(b, h) + boff + n * 2048 + k * 1024); } while (0)
#define PG8_MMA(ai, bj, At, Bt) do { __builtin_amdgcn_s_setprio(1); _Pragma("unroll") for (int m = 0; m < 4; ++m) _Pragma("unroll") for (int n = 0; n < 2; ++n) _Pragma("unroll") for (int k = 0; k < 2; ++k) \
        acc[ai][bj][m][n] = __builtin_amdgcn_mfma_f32_16x16x32_f16(__builtin_bit_cast(h16x8, Bt[n][k]), __builtin_bit_cast(h16x8, At[m][k]), acc[ai][bj][m][n], 0, 0, 0); __builtin_amdgcn_s_setprio(0); } while (0)
#define PG8_WAIT_V(n) asm volatile("s_waitcnt vmcnt(" #n ")" ::: "memory")
#define PG8_WAIT_L(n) asm volatile("s_waitcnt lgkmcnt(" #n ")" ::: "memory")
#define PG8_BAR __builtin_amdgcn_s_barrier()
#define PG8_SCHED __builtin_amdgcn_sched_barrier(0)
    Unit cur, nxt; int ui = 0;
    if (!S.next(0, cur)) return;
    f32x4 acc[2][2][4][2];
#pragma unroll
    for (int a = 0; a < 2; ++a)
#pragma unroll
        for (int b = 0; b < 2; ++b)
#pragma unroll
            for (int m = 0; m < 4; ++m)
#pragma unroll
                for (int n = 0; n < 2; ++n) acc[a][b][m][n] = (f32x4){0.f, 0.f, 0.f, 0.f};
    s16x8 At[4][2], B0[2][2], B1[2][2];
    const char* cA = (const char*)g.A + (size_t)cur.pm * tstep; const char* cB = (const char*)g.Bt + (size_t)cur.pn * tstep;
    PG8_STAGE(PG8_SB(0, 0), cB, voffB); PG8_STAGE(PG8_SB(0, 1), cB + hstep, voffB); PG8_STAGE(PG8_SA(0, 0), cA, voffA); PG8_STAGE(PG8_SA(0, 1), cA + hstep, voffA);
    if (wr == 1) PG8_BAR;
    PG8_WAIT_V(2); PG8_BAR;
    PG8_STAGE(PG8_SB(1, 0), cB + kstep, voffB); PG8_STAGE(PG8_SA(1, 0), cA + kstep, voffA); PG8_STAGE(PG8_SB(1, 1), cB + hstep + kstep, voffB);
    PG8_WAIT_V(6); PG8_BAR;
    for (;;) {
        const bool has_next = S.next(ui + 1, nxt);
        const char* nA = has_next ? (const char*)g.A + (size_t)nxt.pm * tstep : cA; const char* nB = has_next ? (const char*)g.Bt + (size_t)nxt.pn * tstep : cB;
#pragma unroll 1
        for (int t = 0; t < nt; t += 2) {
            const bool last = (t == nt - 2);
            const char* a1 = cA + (size_t)(t + 1) * kstep;
            const char* a2 = last ? nA : cA + (size_t)(t + 2) * kstep; const char* b2 = last ? nB : cB + (size_t)(t + 2) * kstep;
            const char* a3 = a2 + kstep; const char* b3 = b2 + kstep;
            PG8_LDB(B0, 0, 0); PG8_LDB(B1, 0, 1); PG8_SCHED; PG8_LDA(At, 0, 0); PG8_STAGE(PG8_SA(1, 1), a1 + hstep, voffA);
            PG8_WAIT_V(8); PG8_WAIT_L(0); PG8_BAR; PG8_MMA(0, 0, At, B0); PG8_MMA(0, 1, At, B1); PG8_BAR; PG8_SCHED;
            PG8_LDA(At, 0, 1); PG8_STAGE(PG8_SB(0, 0), b2, voffB); PG8_STAGE(PG8_SB(0, 1), b2 + hstep, voffB); PG8_STAGE(PG8_SA(0, 0), a2, voffA);
            PG8_WAIT_V(8); PG8_WAIT_L(0); PG8_BAR; PG8_MMA(1, 0, At, B0); PG8_MMA(1, 1, At, B1); PG8_BAR; PG8_SCHED;
            PG8_LDB(B0, 1, 0); PG8_LDB(B1, 1, 1); PG8_SCHED; PG8_LDA(At, 1, 0); PG8_STAGE(PG8_SA(0, 1), a2 + hstep, voffA);
            PG8_WAIT_V(8); PG8_WAIT_L(0); PG8_BAR; PG8_MMA(0, 0, At, B0); PG8_MMA(0, 1, At, B1); PG8_BAR; PG8_SCHED;
            PG8_LDA(At, 1, 1); PG8_STAGE(PG8_SB(1, 0), b3, voffB); PG8_STAGE(PG8_SB(1, 1), b3 + hstep, voffB); PG8_STAGE(PG8_SA(1, 0), a3, voffA);
            PG8_WAIT_V(8); PG8_WAIT_L(0); PG8_BAR; PG8_MMA(1, 0, At, B0); PG8_MMA(1, 1, At, B1); PG8_BAR; PG8_SCHED;
        }
        if (wr == 0) PG8_BAR;
        E(acc, cur, wr, wc, fr, fq);
        if (!has_next) break;
#pragma unroll
        for (int a = 0; a < 2; ++a)
#pragma unroll
            for (int b = 0; b < 2; ++b)
#pragma unroll
                for (int m = 0; m < 4; ++m)
#pragma unroll
                    for (int n = 0; n < 2; ++n) acc[a][b][m][n] = (f32x4){0.f, 0.f, 0.f, 0.f};
        cur = nxt; cA = nA; cB = nB; ++ui;
        if (wr == 1) PG8_BAR;
    }
    PG8_WAIT_V(0);
    PG8_BAR;
#undef PG8_SA
#undef PG8_SB
#undef PG8_STAGE
#undef PG8_LDA
#undef PG8_LDB
#undef PG8_MMA
#undef PG8_WAIT_V
#undef PG8_WAIT_L
#undef PG8_BAR
#undef PG8_SCHED
}

typedef const f32x4 (&AccRef)[2][2][4][2];

struct EpiPlain {
    h16* O; int ldc;
    __device__ __forceinline__ void operator()(AccRef acc, const Unit& u, int wr, int wc, int fr, int fq) const {
        const int row0 = u.pm * BM + wr * 64 + fr, col0 = u.pn * BM + wc * 32 + 8 * fq;
#pragma unroll
        for (int ai = 0; ai < 2; ++ai)
#pragma unroll
            for (int m = 0; m < 4; ++m) { h16* rowp = O + (size_t)(row0 + ai * HALF + m * 16) * ldc + col0;
#pragma unroll
                for (int bj = 0; bj < 2; ++bj) { const f32x4 v0 = acc[ai][bj][m][0], v1 = acc[ai][bj][m][1];
                    u32x4 w; w.x = pkh(v0[0], v0[1]); w.y = pkh(v0[2], v0[3]); w.z = pkh(v1[0], v1[1]); w.w = pkh(v1[2], v1[3]);
                    *(u32x4*)(rowp + bj * HALF) = w; } }
    }
};

struct EpiInProj {
    const float* rs0; const float* rope; const float* gidx;
    h16 *QA, *KA, *VA, *QI, *KI, *QB, *KB, *VB; float* WI; float* kmp;
    __device__ __forceinline__ void operator()(AccRef acc, const Unit& u, int wr, int wc, int fr_in, int fq_in) const {
        int fr = fr_in, fq = fq_in; asm volatile("" : "+v"(fr), "+v"(fq));
        const int pn = u.pn;
        int type = 0; h16* dst = VA; int pitch = 64, cb = 0; float scl = 1.f; bool iskb = false;
        if (pn < 2) { type = 1; dst = QA; pitch = 512; cb = 256 * pn + 64 * wc; scl = C2; }
        else if (pn == 2) { if (wc == 0) { type = 1; dst = KA; } else if (wc == 1) { type = 0; dst = VA; } else if (wc == 2) { type = 2; dst = KI; } else { type = 3; } }
        else if (pn == 3) { type = 1; dst = QI; pitch = 256; cb = 64 * wc; }
        else if (pn < 6) { type = 1; dst = QB; pitch = 512; cb = 256 * (pn - 4) + 64 * wc; scl = C2; }
        else if (pn < 8) { type = 1; dst = KB; pitch = 512; cb = 256 * (pn - 6) + 64 * wc; iskb = true; }
        else { type = 0; dst = VB; pitch = 512; cb = 256 * (pn - 8) + 64 * wc; }
        float ks[2][2][4];
#pragma unroll
        for (int bj = 0; bj < 2; ++bj)
#pragma unroll
            for (int n = 0; n < 2; ++n)
#pragma unroll
                for (int e = 0; e < 4; ++e) ks[bj][n][e] = 0.f;
        float gl[2][2][4];
        if (type == 2) {
#pragma unroll
            for (int bj = 0; bj < 2; ++bj)
#pragma unroll
                for (int n = 0; n < 2; ++n)
#pragma unroll
                    for (int e = 0; e < 4; ++e) gl[bj][n][e] = gidx[32 * bj + 8 * fq + 4 * n + e];
        }
#pragma unroll
        for (int ai = 0; ai < 2; ++ai)
#pragma unroll
            for (int m = 0; m < 4; ++m) {
                const int row = u.pm * BM + ai * HALF + wr * 64 + m * 16 + fr;
                const float s = rs0[row];
                float v[2][2][4];
#pragma unroll
                for (int bj = 0; bj < 2; ++bj)
#pragma unroll
                    for (int n = 0; n < 2; ++n)
#pragma unroll
                        for (int e = 0; e < 4; ++e) v[bj][n][e] = acc[ai][bj][m][n][e] * s;
                if (type == 3) {
                    if (fq == 0) *(f32x4*)(WI + (size_t)row * 4) = (f32x4){v[0][0][0] * 0.0625f, v[0][0][1] * 0.0625f, v[0][0][2] * 0.0625f, v[0][0][3] * 0.0625f};
                    continue;
                }
                if (type == 2) {
                    float sum = 0.f;
#pragma unroll
                    for (int bj = 0; bj < 2; ++bj)
#pragma unroll
                        for (int n = 0; n < 2; ++n)
#pragma unroll
                            for (int e = 0; e < 4; ++e) sum += v[bj][n][e];
                    sum += __shfl_xor(sum, 16); sum += __shfl_xor(sum, 32);
                    const float mean = sum * (1.f / 64.f); float q = 0.f;
#pragma unroll
                    for (int bj = 0; bj < 2; ++bj)
#pragma unroll
                        for (int n = 0; n < 2; ++n)
#pragma unroll
                            for (int e = 0; e < 4; ++e) { v[bj][n][e] -= mean; q += v[bj][n][e] * v[bj][n][e]; }
                    q += __shfl_xor(q, 16); q += __shfl_xor(q, 32);
                    const float rstd = 1.0f / sqrtf(q * (1.f / 64.f) + EPS);
#pragma unroll
                    for (int bj = 0; bj < 2; ++bj)
#pragma unroll
                        for (int n = 0; n < 2; ++n)
#pragma unroll
                            for (int e = 0; e < 4; ++e) v[bj][n][e] = v[bj][n][e] * rstd * gl[bj][n][e];
                }
                if (type >= 1) {
                    const int pos = row & (SEQ - 1);
                    const f32x4* cs = (const f32x4*)(rope + ((size_t)pos * 32 + 8 * fq) * 2);
#pragma unroll
                    for (int n = 0; n < 2; ++n) { const f32x4 c01 = cs[2 * n], c23 = cs[2 * n + 1];
                        const float cc[4] = {c01[0], c01[2], c23[0], c23[2]}, sn[4] = {c01[1], c01[3], c23[1], c23[3]};
#pragma unroll
                        for (int e = 0; e < 4; ++e) { const float lo = v[0][n][e], hi = v[1][n][e]; v[0][n][e] = lo * cc[e] - hi * sn[e]; v[1][n][e] = hi * cc[e] + lo * sn[e]; } }
                }
#pragma unroll
                for (int bj = 0; bj < 2; ++bj) {
#pragma unroll
                    for (int n = 0; n < 2; ++n)
#pragma unroll
                        for (int e = 0; e < 4; ++e) { v[bj][n][e] *= scl; ks[bj][n][e] += v[bj][n][e]; }
                    u32x4 w; w.x = pkh(v[bj][0][0], v[bj][0][1]); w.y = pkh(v[bj][0][2], v[bj][0][3]); w.z = pkh(v[bj][1][0], v[bj][1][1]); w.w = pkh(v[bj][1][2], v[bj][1][3]);
                    *(u32x4*)(dst + (size_t)row * pitch + cb + 32 * bj + 8 * fq) = w;
                }
                __builtin_amdgcn_sched_barrier(0);
            }
        if (iskb) {
#pragma unroll
            for (int bj = 0; bj < 2; ++bj)
#pragma unroll
                for (int n = 0; n < 2; ++n)
#pragma unroll
                    for (int e = 0; e < 4; ++e) { float t = ks[bj][n][e]; t += __shfl_xor(t, 1); t += __shfl_xor(t, 2); t += __shfl_xor(t, 4); t += __shfl_xor(t, 8); ks[bj][n][e] = t; }
            if (fr == 0) { const int head = 4 * (pn - 6) + wc; float* o = kmp + (((size_t)u.pm * 2 + wr) * 8 + head) * 64;
#pragma unroll
                for (int bj = 0; bj < 2; ++bj)
#pragma unroll
                    for (int n = 0; n < 2; ++n) *(f32x4*)(o + 32 * bj + 8 * fq + 4 * n) = (f32x4){ks[bj][n][0], ks[bj][n][1], ks[bj][n][2], ks[bj][n][3]}; }
        }
    }
};

template <bool BASE_F32> struct EpiRes {
    const void* base; h16* out; float* ssp;
    __device__ __forceinline__ void operator()(AccRef acc, const Unit& u, int wr, int wc, int fr, int fq) const {
        const int col0 = u.pn * BM + wc * 32 + 8 * fq;
#pragma unroll
        for (int ai = 0; ai < 2; ++ai)
#pragma unroll
            for (int m = 0; m < 4; ++m) { const int row = u.pm * BM + ai * HALF + wr * 64 + m * 16 + fr; float ss = 0.f;
#pragma unroll
                for (int bj = 0; bj < 2; ++bj) { const size_t off = (size_t)row * DM + col0 + bj * HALF; float b[8];
                    if (BASE_F32) { const f32x4 b0 = *(const f32x4*)((const float*)base + off), b1 = *(const f32x4*)((const float*)base + off + 4);
                        b[0] = b0[0]; b[1] = b0[1]; b[2] = b0[2]; b[3] = b0[3]; b[4] = b1[0]; b[5] = b1[1]; b[6] = b1[2]; b[7] = b1[3]; }
                    else { const h16x8 hb = *(const h16x8*)((const h16*)base + off);
#pragma unroll
                        for (int e = 0; e < 8; ++e) b[e] = (float)hb[e]; }
                    float v[8];
#pragma unroll
                    for (int e = 0; e < 8; ++e) { v[e] = b[e] + acc[ai][bj][m][e >> 2][e & 3]; ss += v[e] * v[e]; }
                    u32x4 w; w.x = pkh(v[0], v[1]); w.y = pkh(v[2], v[3]); w.z = pkh(v[4], v[5]); w.w = pkh(v[6], v[7]);
                    *(u32x4*)(out + off) = w; }
                ss += __shfl_xor(ss, 16); ss += __shfl_xor(ss, 32);
                if (fq == 0) ssp[(size_t)row * 16 + u.pn * 4 + wc] = ss; }
    }
};
__device__ __forceinline__ float row_rstd(const float* ssp, int row) {
    const f32x4* p = (const f32x4*)(ssp + (size_t)row * 16); const f32x4 a = p[0], b = p[1], c = p[2], d = p[3];
    const float s = ((a[0] + a[1]) + (a[2] + a[3])) + ((b[0] + b[1]) + (b[2] + b[3])) + ((c[0] + c[1]) + (c[2] + c[3])) + ((d[0] + d[1]) + (d[2] + d[3]));
    return 1.0f / sqrtf(s * (1.0f / DM) + EPS);
}
struct EpiSwiGLU {
    const float* ssp; h16* act;
    __device__ __forceinline__ void operator()(AccRef acc, const Unit& u, int wr, int wc, int fr, int fq) const {
        const int col0 = u.pn * HALF + wc * 32 + 8 * fq;
#pragma unroll
        for (int ai = 0; ai < 2; ++ai)
#pragma unroll
            for (int m = 0; m < 4; ++m) { const int row = u.pm * BM + ai * HALF + wr * 64 + m * 16 + fr; const float s = row_rstd(ssp, row); float v[8];
#pragma unroll
                for (int e = 0; e < 8; ++e) { const float gt = acc[ai][0][m][e >> 2][e & 3] * s, up = acc[ai][1][m][e >> 2][e & 3] * s; v[e] = gt * fast_sigmoid(gt) * up; }
                u32x4 w; w.x = pkh(v[0], v[1]); w.y = pkh(v[2], v[3]); w.z = pkh(v[4], v[5]); w.w = pkh(v[6], v[7]);
                *(u32x4*)(act + (size_t)row * DFF + col0) = w; }
    }
};
struct EpiPLE {
    const float* ssp2; const h16* h2; const h16* pp; h16* out; float* ssp3;
    __device__ __forceinline__ void operator()(AccRef acc, const Unit& u, int wr, int wc, int fr, int fq) const {
        const int col0 = u.pn * BM + wc * 32 + 8 * fq;
#pragma unroll
        for (int ai = 0; ai < 2; ++ai)
#pragma unroll
            for (int m = 0; m < 4; ++m) { const int row = u.pm * BM + ai * HALF + wr * 64 + m * 16 + fr; const float s = row_rstd(ssp2, row); float ss = 0.f;
#pragma unroll
                for (int bj = 0; bj < 2; ++bj) { const size_t off = (size_t)row * DM + col0 + bj * HALF;
                    const h16x8 hb = *(const h16x8*)(h2 + off), pb = *(const h16x8*)(pp + off); float v[8];
#pragma unroll
                    for (int e = 0; e < 8; ++e) { v[e] = (float)hb[e] + fast_sigmoid(acc[ai][bj][m][e >> 2][e & 3] * s) * (float)pb[e]; ss += v[e] * v[e]; }
                    u32x4 w; w.x = pkh(v[0], v[1]); w.y = pkh(v[2], v[3]); w.z = pkh(v[4], v[5]); w.w = pkh(v[6], v[7]); *(u32x4*)(out + off) = w; }
                ss += __shfl_xor(ss, 16); ss += __shfl_xor(ss, 32);
                if (fq == 0) ssp3[(size_t)row * 16 + u.pn * 4 + wc] = ss; }
    }
};
}

template <class ColMap>
__device__ __forceinline__ void transpose_items(int K, int Nsrc, h16* WT, int Nrows, ColMap cm, const float* __restrict__ kscale, LAS float* scr, int gw, int NGW, int lane) {
    const int nblk = Nrows / 32, items = (K / 64) * nblk;
    for (int it = gw; it < items; it += NGW) {
        const int kb = it / nblk, nb = it % nblk, k0 = 64 * kb, n0 = 32 * nb;
        const float* src = cm(n0 + (lane & 31));
#pragma unroll 8
        for (int i = 0; i < 32; ++i) { const int kk = 2 * i + (lane >> 5); float v = 0.f;
            if (src) { v = src[(size_t)(k0 + kk) * Nsrc]; if (kscale) v *= kscale[k0 + kk]; }
            scr[kk * 33 + (lane & 31)] = v; }
        asm volatile("s_waitcnt lgkmcnt(0)" ::: "memory");
        const int c = lane & 7;
#pragma unroll
        for (int j = 0; j < 4; ++j) { const int n = (lane >> 3) + 8 * j; const LAS float* s = scr + (8 * c) * 33 + n;
            u32x4 o; o.x = pkh(s[0 * 33], s[1 * 33]); o.y = pkh(s[2 * 33], s[3 * 33]); o.z = pkh(s[4 * 33], s[5 * 33]); o.w = pkh(s[6 * 33], s[7 * 33]);
            *(u32x4*)(WT + (size_t)(n0 + n) * K + k0 + 8 * c) = o; }
        asm volatile("s_waitcnt lgkmcnt(0)" ::: "memory");
    }
}
__device__ __forceinline__ int win_colmap(int np) {
    const int pn = np >> 8, p = np & 255, bj = p >> 7, wc = (p >> 5) & 3, r = p & 31;
    const int LC = 256 * pn + 64 * wc + 32 * bj + r;
    if (LC < 512) return LC;
    if (LC < 576) return LC;
    if (LC < 640) return LC;
    if (LC < 704) return 896 + (LC - 640);
    if (LC < 708) return 960 + (LC - 704);
    if (LC < 768) return -1;
    if (LC < 1024) return 640 + (LC - 768);
    if (LC < 1536) return 964 + (LC - 1024);
    if (LC < 2048) return 1476 + (LC - 1536);
    return 1988 + (LC - 2048);
}

constexpr int DSA_LDS_RED = 0  , DSA_LDS_FRED = 1024  , DSA_LDS_META = 2048  , DSA_LDS_LIST = 2304  , DSA_LDS_VBUF = 10496  ,
              DSA_LDS_QF = 84224  , DSA_LDS_BUF = 92416  , DSA_LDS_CANDB = 133376  , DSA_LDS_TRASH = 137472  ;
constexpr int DSA_CAP = 64, DSA_BUFN = 320;
constexpr float ZEPS = 0x1p-120f;
constexpr int VROW = 144;

struct AttnPtrs { const h16 *QA, *KA, *VA, *QI, *KI, *QB, *KB, *VB; const float* WI; const float* kmp; h16* Y; };

__device__ __forceinline__ void cnt_ge(int& c, float s, float tau) { asm volatile("v_cmp_ge_f32 vcc, %1, %2\n\tv_addc_co_u32 %0, vcc, 0, %0, vcc" : "+v"(c) : "v"(s), "v"(tau) : "vcc"); }
__device__ __forceinline__ void cnt_gt(int& c, float s, float tau) { asm volatile("v_cmp_gt_f32 vcc, %1, %2\n\tv_addc_co_u32 %0, vcc, 0, %0, vcc" : "+v"(c) : "v"(s), "v"(tau) : "vcc"); }
__device__ __forceinline__ void cnt_tie(int& c, float s, float t3, int key, int im) { unsigned long long tmp;
    asm volatile("v_cmp_eq_f32 vcc, %2, %3\n\tv_cmp_le_i32 %1, %4, %5\n\ts_and_b64 vcc, vcc, %1\n\tv_addc_co_u32 %0, vcc, 0, %0, vcc" : "+v"(c), "=&s"(tmp) : "v"(s), "v"(t3), "v"(key), "v"(im) : "vcc"); }
__device__ __forceinline__ int dsa_count_ge(const f32x4 (&S)[8][4], int nch, float tau) {
    int c = 0;
#pragma unroll
    for (int ch = 0; ch < 8; ++ch) if (ch < nch) {
#pragma unroll
        for (int tt = 0; tt < 4; ++tt)
#pragma unroll
            for (int i = 0; i < 4; ++i) cnt_ge(c, S[ch][tt][i], tau);
    }
    return c;
}
__device__ __forceinline__ int dsa_total(int c, LAS unsigned* red, int par, int wid, int q16, int g) {
    c += __shfl_xor(c, 16); c += __shfl_xor(c, 32);
    if (g == 0) red[(par * 8 + wid) * 16 + q16] = (unsigned)c;
    __syncthreads();
    int t = 0;
#pragma unroll
    for (int w = 0; w < 8; ++w) t += (int)red[(par * 8 + w) * 16 + q16];
    return t;
}

__device__ __forceinline__ void dsa_unit(LAS unsigned char* lds, const AttnPtrs& P, int b, int qt) {
    const int tid = threadIdx.x, lane = tid & 63, wid = __builtin_amdgcn_readfirstlane(tid >> 6), q16 = lane & 15, g = lane >> 4;
    LAS unsigned* red = (LAS unsigned*)(lds + DSA_LDS_RED); LAS float* fred = (LAS float*)(lds + DSA_LDS_FRED);
    LAS unsigned short* list = (LAS unsigned short*)(lds + DSA_LDS_LIST);
    const int t0 = qt * 16, myq = t0 + q16; const size_t brow = (size_t)b * SEQ;
    const int nch = (t0 + 15) / 512 + 1;
    f32x4 S[8][4];
#pragma unroll
    for (int ch = 0; ch < 8; ++ch)
#pragma unroll
        for (int tt = 0; tt < 4; ++tt) S[ch][tt] = (f32x4){NEG_INF, NEG_INF, NEG_INF, NEG_INF};
    float smax = NEG_INF, smin = -NEG_INF; int nvl = 0;
    {
        h16x8 qf[4][2];
#pragma unroll
        for (int h = 0; h < 4; ++h)
#pragma unroll
            for (int ks = 0; ks < 2; ++ks) qf[h][ks] = *(const h16x8*)(P.QI + (brow + myq) * 256 + h * 64 + ks * 32 + g * 8);
        const f32x4 wv = *(const f32x4*)(P.WI + (brow + myq) * 4);
        h16x8 pa[2][2];
#pragma unroll
        for (int u = 0; u < 2; ++u) { pa[u][0] = *(const h16x8*)(P.KI + (brow + 64 * wid + 16 * u + q16) * 64 + g * 8); pa[u][1] = *(const h16x8*)(P.KI + (brow + 64 * wid + 16 * u + q16) * 64 + 32 + g * 8); }
#pragma unroll
        for (int ch = 0; ch < 8; ++ch) if (ch < nch) {
#pragma unroll
            for (int tp = 0; tp < 2; ++tp) {
                h16x8 a[2][2];
#pragma unroll
                for (int u = 0; u < 2; ++u) { a[u][0] = pa[u][0]; a[u][1] = pa[u][1]; }
                { const int nidx = ch * 2 + tp + 1; int kn = 512 * (nidx >> 1) + 64 * wid + 32 * (nidx & 1); kn = kn < SEQ - 32 ? kn : SEQ - 32;
#pragma unroll
                  for (int u = 0; u < 2; ++u) { pa[u][0] = *(const h16x8*)(P.KI + (brow + kn + 16 * u + q16) * 64 + g * 8); pa[u][1] = *(const h16x8*)(P.KI + (brow + kn + 16 * u + q16) * 64 + 32 + g * 8); } }
#pragma unroll
                for (int u = 0; u < 2; ++u) {
                    const int tt = 2 * tp + u; const int kt = 512 * ch + 64 * wid + 16 * tt;
                    if (kt <= t0 + 15) {
                        f32x4 sc = {0.f, 0.f, 0.f, 0.f};
#pragma unroll
                        for (int h = 0; h < 4; ++h) { f32x4 acc = {0.f, 0.f, 0.f, 0.f};
                            acc = __builtin_amdgcn_mfma_f32_16x16x32_f16(a[u][0], qf[h][0], acc, 0, 0, 0);
                            acc = __builtin_amdgcn_mfma_f32_16x16x32_f16(a[u][1], qf[h][1], acc, 0, 0, 0);
#pragma unroll
                            for (int i = 0; i < 4; ++i) sc[i] += wv[h] * __builtin_fmaxf(acc[i], 0.f); }
                        const int key0 = kt + 4 * g;
                        const float zb = -(float)(key0 + 1) * ZEPS;
#pragma unroll
                        for (int i = 0; i < 4; ++i) { const bool ok = (key0 + i) <= myq; float v = sc[i]; v = (v == 0.f) ? (zb - (float)i * ZEPS) : v; v = ok ? v : NEG_INF; sc[i] = v;
                            smax = __builtin_fmaxf(smax, v); smin = __builtin_fminf(smin, ok ? v : -NEG_INF); nvl += ok ? 1 : 0; }
                        S[ch][tt] = sc;
                    }
                }
                __builtin_amdgcn_sched_barrier(0);
            }
        }
    }
    smax = __builtin_fmaxf(smax, __shfl_xor(smax, 16)); smax = __builtin_fmaxf(smax, __shfl_xor(smax, 32));
    smin = __builtin_fminf(smin, __shfl_xor(smin, 16)); smin = __builtin_fminf(smin, __shfl_xor(smin, 32));
    if (g == 0) { fred[(wid * 16 + q16) * 2] = smax; fred[(wid * 16 + q16) * 2 + 1] = smin; }
    __syncthreads();
#pragma unroll
    for (int w = 0; w < 8; ++w) { smax = __builtin_fmaxf(smax, fred[(w * 16 + q16) * 2]); smin = __builtin_fminf(smin, fred[(w * 16 + q16) * 2 + 1]); }
    const int nv = myq + 1; int par = 0;
    float lo = smin, hi; int c_lo = nv, c_hi = 0, cl_lo = nvl, cl_hi = 0;
    { const unsigned mb = __float_as_uint(smax); hi = __uint_as_float(smax > 0.f ? mb + 1u : mb - 1u); }
    const float TZ = -4097.0f * ZEPS;
    bool done = false, ovf = false;
    if (nv <= 256) { hi = lo; c_hi = c_lo; cl_hi = cl_lo; done = true; }
    auto pick = [&](float l, float h) -> float { if (l < 0.f && h > 0.f) return 0.f; if (l < TZ && h > TZ) return TZ; return l + (h - l) * 0.5f; };
    while (__any(!done)) {
        const float tau = done ? -NEG_INF : pick(lo, hi);
        const int clp = dsa_count_ge(S, nch, tau);
        const int c = dsa_total(clp, red, par, wid, q16, g); par ^= 1;
        if (!done) {
            if (c >= 256) { lo = tau; c_lo = c; cl_lo = clp; } else { hi = tau; c_hi = c; cl_hi = clp; }
            if (c_lo == 256) { hi = lo; c_hi = c_lo; cl_hi = cl_lo; done = true; }
            else if (c_lo - c_hi <= DSA_CAP) done = true;
            else { const float nt = pick(lo, hi); if (!(nt > lo && nt < hi)) { done = true; ovf = true; } }
        }
    }
    const int kb0 = 64 * wid + 4 * g;
    int istar = 0x7fffffff;
    if (__any(ovf)) {
        const int R = 256 - c_hi; int ilo = -1, ihi = myq;
        while (__any(ovf && ihi - ilo > 1)) {
            const int im = ovf ? ((ilo + ihi) >> 1) : -1;
            int c = 0;
#pragma unroll
            for (int ch = 0; ch < 8; ++ch) if (ch < nch) {
#pragma unroll
                for (int tt = 0; tt < 4; ++tt)
#pragma unroll
                    for (int i = 0; i < 4; ++i) cnt_tie(c, S[ch][tt][i], lo, kb0, im - (512 * ch + 16 * tt + i));
            }
            c = dsa_total(c, red, par, wid, q16, g); par ^= 1;
            if (ovf && ihi - ilo > 1) { if (c >= R) ihi = im; else ilo = im; }
        }
        if (ovf) istar = ihi;
        int c = 0;
#pragma unroll
        for (int ch = 0; ch < 8; ++ch) if (ch < nch) {
#pragma unroll
            for (int tt = 0; tt < 4; ++tt)
#pragma unroll
                for (int i = 0; i < 4; ++i) { const float s = S[ch][tt][i]; const int key = kb0 + 512 * ch + 16 * tt + i; c += (s >= lo && (s >= hi || key <= istar)) ? 1 : 0; }
        }
        if (ovf) { cl_lo = c; c_lo = 256; c_hi = 256; hi = NEG_INF; }
    }
    unsigned nw;
    {
        const int p = cl_lo;
        const int u1 = __shfl_up(p, 16); const int s1 = p + (g >= 1 ? u1 : 0);
        const int u2 = __shfl_up(s1, 32); const int s2 = s1 + (g >= 2 ? u2 : 0);
        if (g == 3) red[(par * 8 + wid) * 16 + q16] = (unsigned)s2;
        __syncthreads();
        int bw = 0;
#pragma unroll
        for (int w = 0; w < 8; ++w) { const int t = (int)red[(par * 8 + w) * 16 + q16]; bw += (w < wid) ? t : 0; }
        par ^= 1;
        nw = (unsigned)(bw + s2 - p);
    }
    if (wid == 0 && g == 0) ((LAS u32x4*)(lds + DSA_LDS_META))[q16] = (u32x4){(unsigned)c_lo, (unsigned)c_hi, __float_as_uint(hi), 0u};
    {
        const unsigned bufq = (unsigned)(uintptr_t)(lds + DSA_LDS_BUF + q16 * (DSA_BUFN * 8)), trash = (unsigned)(uintptr_t)(lds + DSA_LDS_TRASH + tid * 8);
        if (!__any(ovf)) {
#pragma unroll
            for (int ch = 0; ch < 8; ++ch) if (ch < nch) {
#pragma unroll
                for (int tt = 0; tt < 4; ++tt)
#pragma unroll
                    for (int i = 0; i < 4; ++i) { const float s = S[ch][tt][i]; const int key = kb0 + 512 * ch + 16 * tt + i; unsigned a;
                        asm volatile("v_cmp_ge_f32 vcc, %2, %3\n\tv_lshl_add_u32 %0, %1, 3, %4\n\tv_cndmask_b32 %0, %5, %0, vcc\n\tv_addc_co_u32 %1, vcc, 0, %1, vcc\n\tds_write2_b32 %0, %2, %6 offset1:1"
                                     : "=&v"(a), "+v"(nw) : "v"(s), "v"(lo), "v"(bufq), "v"(trash), "v"(key) : "vcc", "memory"); }
            }
        } else {
#pragma unroll
            for (int ch = 0; ch < 8; ++ch) if (ch < nch) {
#pragma unroll
                for (int tt = 0; tt < 4; ++tt)
#pragma unroll
                    for (int i = 0; i < 4; ++i) { const float s = S[ch][tt][i]; const int key = kb0 + 512 * ch + 16 * tt + i;
                        const bool w = (s >= lo && (s >= hi || key <= istar));
                        const unsigned a = w ? (bufq + nw * 8u) : trash; nw += w ? 1u : 0u;
                        asm volatile("ds_write2_b32 %0, %1, %2 offset1:1" :: "v"(a), "v"(s), "v"(key) : "memory"); }
            }
        }
    }
    asm volatile("s_waitcnt lgkmcnt(0)" ::: "memory");
    __syncthreads();
#ifndef X_NOATT
    int lane_o = lane;
    {
    LAS unsigned char* vbuf = lds + DSA_LDS_VBUF + wid * (2 * 32 * VROW);
#pragma unroll 1
    for (int qq2 = 0; qq2 < 2 * REP_ATT; ++qq2) { const int qq = qq2 & 1;
        asm volatile("" : "+v"(lane_o));
        const int lane = lane_o, q16 = lane & 15, g = lane >> 4;
        const int ql = 2 * wid + qq; const int qpos = t0 + ql; const int n = (qpos + 1 < 256) ? qpos + 1 : 256;
        LAS unsigned short* ql_list = list + ql * 256;
        {
            const u32x4 mt = ((const LAS u32x4*)(lds + DSA_LDS_META))[ql];
            const int n_e = (int)mt.x, chi = (int)mt.y; const float hiv = __uint_as_float(mt.z); const int R = 256 - chi;
            const LAS u32x2* bq = (const LAS u32x2*)(lds + DSA_LDS_BUF) + ql * DSA_BUFN;
            LAS u32x2* cb = (LAS u32x2*)(lds + DSA_LDS_CANDB) + wid * 64;
            int base_s = 0, base_c = 0;
#pragma unroll
            for (int k = 0; k < 5; ++k) { const int e = lane + 64 * k; const bool valid = e < n_e; const u32x2 ent = bq[e];
                const float s = __uint_as_float(ent.x); const bool sure = valid && (s >= hiv), cand = valid && !(s >= hiv);
                const unsigned long long bs = __ballot(sure), bc = __ballot(cand);
                const int ps = base_s + (int)__builtin_amdgcn_mbcnt_hi((unsigned)(bs >> 32), __builtin_amdgcn_mbcnt_lo((unsigned)bs, 0u));
                const int pc = base_c + (int)__builtin_amdgcn_mbcnt_hi((unsigned)(bc >> 32), __builtin_amdgcn_mbcnt_lo((unsigned)bc, 0u));
                if (sure && ps < 256) ql_list[ps] = (unsigned short)ent.y;
                if (cand && pc < 64) cb[pc] = ent;
                base_s += __popcll(bs); base_c += __popcll(bc); }
            const int m = base_c < 64 ? base_c : 64;
            asm volatile("s_waitcnt lgkmcnt(0)" ::: "memory");
            u32x2 my = {0u, 0u}; if (lane < m) my = cb[lane];
            const float mys = __uint_as_float(my.x); int rank = 0;
#pragma unroll 4
            for (int jx = 0; jx < m; ++jx) { const u32x2 o = cb[jx]; const float os = __uint_as_float(o.x); rank += (os > mys || (os == mys && o.y < my.y)) ? 1 : 0; }
            if (lane < m && rank < R && chi + rank < 256) ql_list[chi + rank] = (unsigned short)my.y;
            asm volatile("s_waitcnt lgkmcnt(0)" ::: "memory");
        }
        const int head = q16 & 7;
        h16x8 qf[2];
#pragma unroll
        for (int ks = 0; ks < 2; ++ks) qf[ks] = *(const h16x8*)(P.QA + (brow + qpos) * 512 + head * 64 + ks * 32 + g * 8);
        f32x4 L[16];
        {
            h16x8 ka[2][4][2];
#pragma unroll
            for (int u = 0; u < 4; ++u) { const int e = 16 * u + q16; const int kraw = (int)ql_list[e]; const int key = (e < n) ? kraw : 0;
                ka[0][u][0] = *(const h16x8*)(P.KA + (brow + key) * 64 + g * 8); ka[0][u][1] = *(const h16x8*)(P.KA + (brow + key) * 64 + 32 + g * 8); }
#pragma unroll
            for (int gi = 0; gi < 4; ++gi) {
                if (gi < 3) {
#pragma unroll
                    for (int u = 0; u < 4; ++u) { const int e = 16 * (4 * (gi + 1) + u) + q16; const int kraw = (int)ql_list[e]; const int key = (e < n) ? kraw : 0;
                        ka[(gi + 1) & 1][u][0] = *(const h16x8*)(P.KA + (brow + key) * 64 + g * 8); ka[(gi + 1) & 1][u][1] = *(const h16x8*)(P.KA + (brow + key) * 64 + 32 + g * 8); }
                }
#pragma unroll
                for (int u = 0; u < 4; ++u) { const int T = 4 * gi + u;
                    f32x4 acc = {0.f, 0.f, 0.f, 0.f};
                    acc = __builtin_amdgcn_mfma_f32_16x16x32_f16(ka[gi & 1][u][0], qf[0], acc, 0, 0, 0);
                    acc = __builtin_amdgcn_mfma_f32_16x16x32_f16(ka[gi & 1][u][1], qf[1], acc, 0, 0, 0);
#pragma unroll
                    for (int i = 0; i < 4; ++i) if (16 * T + 4 * g + i >= n) acc[i] = NEG_INF;
                    L[T] = acc; }
                __builtin_amdgcn_sched_barrier(0);
            }
        }
        u32x4 vreg[2][4];
#pragma unroll
        for (int c2 = 0; c2 < 2; ++c2)
#pragma unroll
            for (int i = 0; i < 4; ++i) { const int j = lane >> 3; const int e = 16 * (2 * c2 + (j >> 2)) + 4 * i + (j & 3); const int kraw = (int)ql_list[e]; const int key = (e < n) ? kraw : 0;
                vreg[c2][i] = *(const u32x4*)(P.VA + (brow + key) * 64 + 8 * (lane & 7)); }
        __builtin_amdgcn_sched_barrier(0);
        float mx = NEG_INF;
#pragma unroll
        for (int T = 0; T < 16; ++T)
#pragma unroll
            for (int i = 0; i < 4; ++i) mx = __builtin_fmaxf(mx, L[T][i]);
        mx = __builtin_fmaxf(mx, __shfl_xor(mx, 16)); mx = __builtin_fmaxf(mx, __shfl_xor(mx, 32));
        float lsum = 0.f;
#pragma unroll
        for (int T = 0; T < 16; ++T)
#pragma unroll
            for (int i = 0; i < 4; ++i) { const float p = __builtin_amdgcn_exp2f(L[T][i] - mx); L[T][i] = p; lsum += p; }
        lsum += __shfl_xor(lsum, 16); lsum += __shfl_xor(lsum, 32);
        __builtin_amdgcn_sched_barrier(0);
        f32x4 O[4];
#pragma unroll
        for (int db = 0; db < 4; ++db) O[db] = (f32x4){0.f, 0.f, 0.f, 0.f};
#pragma unroll
        for (int cc = 0; cc < 8; ++cc) {
            LAS unsigned char* vb = vbuf + (cc & 1) * (32 * VROW);
#pragma unroll
            for (int i = 0; i < 4; ++i) *(LAS u32x4*)(vb + (8 * i + (lane >> 3)) * VROW + 16 * (lane & 7)) = vreg[cc & 1][i];
            if (cc < 6) {
#pragma unroll
                for (int i = 0; i < 4; ++i) { const int j = lane >> 3; const int e = 16 * (2 * (cc + 2) + (j >> 2)) + 4 * i + (j & 3); const int kraw = (int)ql_list[e]; const int key = (e < n) ? kraw : 0;
                    vreg[cc & 1][i] = *(const u32x4*)(P.VA + (brow + key) * 64 + 8 * (lane & 7)); }
            }
            asm volatile("s_waitcnt lgkmcnt(0)" ::: "memory");
            h16x8 pa;
#pragma unroll
            for (int i = 0; i < 4; ++i) { pa[i] = (h16)L[2 * cc][i]; pa[4 + i] = (h16)L[2 * cc + 1][i]; }
#pragma unroll
            for (int db = 0; db < 4; ++db) {
                const LAS unsigned char* pb = vb + (8 * g + ((lane & 15) >> 2)) * VROW + (16 * db + 4 * (lane & 3)) * 2;
                const s16x4 lo4 = __builtin_amdgcn_ds_read_tr16_b64_v4i16((LAS s16x4*)pb);
                const s16x4 hi4 = __builtin_amdgcn_ds_read_tr16_b64_v4i16((LAS s16x4*)(pb + 4 * VROW));
                const s16x8 bf = {lo4[0], lo4[1], lo4[2], lo4[3], hi4[0], hi4[1], hi4[2], hi4[3]};
                O[db] = __builtin_amdgcn_mfma_f32_16x16x32_f16(pa, __builtin_bit_cast(h16x8, bf), O[db], 0, 0, 0);
            }
            __builtin_amdgcn_sched_barrier(0);
        }
#pragma unroll
        for (int i = 0; i < 4; ++i) { const float lh = __shfl(lsum, (4 * g + i) & 7); const float rl = 1.0f / lh;
            if (g < 2) {
#pragma unroll
                for (int db = 0; db < 4; ++db) P.Y[(brow + qpos) * DM + (4 * g + i) * 64 + 16 * db + q16] = (h16)(O[db][i] * rl); } }
    }
    }
#endif
    __syncthreads();
}

constexpr int MB_LDS_KM = 0  , MB_LDS_KV = 4096  , MB_TILE = 64 * VROW;
__device__ __forceinline__ int crow(int r, int hi) { return (r & 3) + 8 * (r >> 2) + 4 * hi; }

__device__ __forceinline__ void moba_unit(LAS unsigned char* lds, const AttnPtrs& P, int b, int h, int j) {
    const int tid = threadIdx.x, lane = tid & 63, wid = __builtin_amdgcn_readfirstlane(tid >> 6), r32 = lane & 31, hi = lane >> 5;
    const size_t brow = (size_t)b * SEQ; const int q0 = 256 * j; const int qrel = 32 * wid + r32; const size_t qrow = brow + q0 + qrel;
    LAS float* km = (LAS float*)(lds + MB_LDS_KM);
    for (int i = tid; i < 16 * 64; i += 512) { const int n = i >> 6, d = i & 63; const size_t pm = (size_t)b * 16 + n;
        km[i] = (P.kmp[((pm * 2 + 0) * 8 + h) * 64 + d] + P.kmp[((pm * 2 + 1) * 8 + h) * 64 + d]) * (1.0f / 256.0f); }
    __syncthreads();
    h16x8 qf[4];
#pragma unroll
    for (int d0 = 0; d0 < 4; ++d0) qf[d0] = *(const h16x8*)(P.QB + qrow * 512 + h * 64 + d0 * 16 + hi * 8);
    unsigned selmask = 0u;
    {
        float gate[8];
#pragma unroll
        for (int nb = 0; nb < 8; ++nb) gate[nb] = 0.f;
#pragma unroll
        for (int c8 = 0; c8 < 8; ++c8) {
            const h16x8 qv = *(const h16x8*)(P.QB + qrow * 512 + h * 64 + c8 * 8);
#pragma unroll
            for (int nb = 0; nb < 8; ++nb) { const LAS float* kr = km + (8 * hi + nb) * 64 + c8 * 8;
#pragma unroll
                for (int e = 0; e < 8; ++e) gate[nb] += (float)qv[e] * kr[e]; }
        }
        float gall[16];
#pragma unroll
        for (int nb = 0; nb < 8; ++nb) { const float o = __shfl_xor(gate[nb], 32); gall[nb] = hi ? o : gate[nb]; gall[8 + nb] = hi ? gate[nb] : o; }
#pragma unroll
        for (int n = 0; n < 16; ++n) if (n >= j) gall[n] = NEG_INF;
#pragma unroll
        for (int pick = 0; pick < 3; ++pick) { float best = NEG_INF; int bi = -1;
#pragma unroll
            for (int n = 0; n < 16; ++n) if (gall[n] > best) { best = gall[n]; bi = n; }
            if (bi >= 0) { selmask |= 1u << bi;
#pragma unroll
                for (int n = 0; n < 16; ++n) if (n == bi) gall[n] = NEG_INF; } }
    }
    const int NT = 4 * (j + 1);
    const h16* Kg = P.KB + brow * 512 + h * 64; const h16* Vg = P.VB + brow * 512 + h * 64;
    const int lrow = tid >> 3, lch = tid & 7;
    auto tile_key0 = [&](int t) { return (t < 4) ? (q0 + 64 * t) : (64 * (t - 4)); };
    u32x4 kreg, vreg;
    { const int k0 = tile_key0(0); kreg = *(const u32x4*)(Kg + (size_t)(k0 + lrow) * 512 + lch * 8); vreg = *(const u32x4*)(Vg + (size_t)(k0 + lrow) * 512 + lch * 8); }
    { LAS unsigned char* kb = lds + MB_LDS_KV; *(LAS u32x4*)(kb + lrow * VROW + lch * 16) = kreg; *(LAS u32x4*)(kb + MB_TILE + lrow * VROW + lch * 16) = vreg; }
    __syncthreads();
    float mrun = NEG_INF, lrun = 0.f; f32x16 o[2]; o[0] = f32x16{}; o[1] = f32x16{};
#pragma unroll 1
    for (int t = 0; t < NT; ++t) {
        if (t + 1 < NT) { const int k0 = tile_key0(t + 1); kreg = *(const u32x4*)(Kg + (size_t)(k0 + lrow) * 512 + lch * 8); vreg = *(const u32x4*)(Vg + (size_t)(k0 + lrow) * 512 + lch * 8); }
        const LAS unsigned char* kb = lds + MB_LDS_KV + (t & 1) * (2 * MB_TILE); const LAS unsigned char* vb = kb + MB_TILE;
        bool active;
        if (t < 4) active = (64 * t) <= (32 * wid + 31);
        else active = __any((selmask >> ((t - 4) >> 2)) & 1u);
        if (active) {
            f32x16 p0 = f32x16{}, p1 = f32x16{};
#pragma unroll
            for (int d0 = 0; d0 < 4; ++d0) {
                const h16x8 k0f = *(const LAS h16x8*)(kb + r32 * VROW + (16 * d0 + 8 * hi) * 2);
                const h16x8 k1f = *(const LAS h16x8*)(kb + (32 + r32) * VROW + (16 * d0 + 8 * hi) * 2);
                p0 = __builtin_amdgcn_mfma_f32_32x32x16_f16(k0f, qf[d0], p0, 0, 0, 0);
                p1 = __builtin_amdgcn_mfma_f32_32x32x16_f16(k1f, qf[d0], p1, 0, 0, 0);
            }
            if (t < 4) {
#pragma unroll
                for (int r = 0; r < 16; ++r) { const int kv = 64 * t + crow(r, hi); if (kv > qrel) p0[r] = NEG_INF; if (kv + 32 > qrel) p1[r] = NEG_INF; }
            } else if (!((selmask >> ((t - 4) >> 2)) & 1u)) {
#pragma unroll
                for (int r = 0; r < 16; ++r) { p0[r] = NEG_INF; p1[r] = NEG_INF; }
            }
            float mt = NEG_INF;
#pragma unroll
            for (int r = 0; r < 16; ++r) mt = __builtin_fmaxf(mt, __builtin_fmaxf(p0[r], p1[r]));
            mt = __builtin_fmaxf(mt, __shfl_xor(mt, 32));
            const float mnew = __builtin_fmaxf(mrun, mt);
            const float alpha = (mnew == NEG_INF) ? 1.0f : __builtin_amdgcn_exp2f(mrun - mnew);
            const float msub = (mnew == NEG_INF) ? 0.f : mnew;
            float ps = 0.f;
#pragma unroll
            for (int r = 0; r < 16; ++r) { p0[r] = __builtin_amdgcn_exp2f(p0[r] - msub); p1[r] = __builtin_amdgcn_exp2f(p1[r] - msub); ps += p0[r] + p1[r]; }
            lrun = lrun * alpha + ps; mrun = mnew;
            if (__any(alpha != 1.0f)) {
#pragma unroll
                for (int r = 0; r < 16; ++r) { o[0][r] *= alpha; o[1][r] *= alpha; }
            }
#pragma unroll
            for (int kt = 0; kt < 2; ++kt)
#pragma unroll
                for (int s = 0; s < 2; ++s) {
                    h16x8 pb;
#pragma unroll
                    for (int e = 0; e < 8; ++e) pb[e] = (h16)(kt ? p1[8 * s + e] : p0[8 * s + e]);
#pragma unroll
                    for (int db = 0; db < 2; ++db) {
                        const LAS unsigned char* pa = vb + (32 * kt + 16 * s + 4 * hi + ((lane & 15) >> 2)) * VROW + (32 * db + 16 * ((lane >> 4) & 1) + 4 * (lane & 3)) * 2;
                        const s16x4 lo4 = __builtin_amdgcn_ds_read_tr16_b64_v4i16((LAS s16x4*)pa);
                        const s16x4 hi4 = __builtin_amdgcn_ds_read_tr16_b64_v4i16((LAS s16x4*)(pa + 8 * VROW));
                        const s16x8 af = {lo4[0], lo4[1], lo4[2], lo4[3], hi4[0], hi4[1], hi4[2], hi4[3]};
                        o[db] = __builtin_amdgcn_mfma_f32_32x32x16_f16(__builtin_bit_cast(h16x8, af), pb, o[db], 0, 0, 0);
                    }
                }
        }
        if (t + 1 < NT) { LAS unsigned char* nb = lds + MB_LDS_KV + ((t + 1) & 1) * (2 * MB_TILE); *(LAS u32x4*)(nb + lrow * VROW + lch * 16) = kreg; *(LAS u32x4*)(nb + MB_TILE + lrow * VROW + lch * 16) = vreg; }
        __syncthreads();
    }
    lrun += __shfl_xor(lrun, 32);
    const float rl = 1.0f / lrun;
    h16* yrow = P.Y + qrow * DM + 512 + h * 64;
#pragma unroll
    for (int db = 0; db < 2; ++db)
#pragma unroll
        for (int rg = 0; rg < 4; ++rg) { u32x2 w; w.x = pkh(o[db][4 * rg] * rl, o[db][4 * rg + 1] * rl); w.y = pkh(o[db][4 * rg + 2] * rl, o[db][4 * rg + 3] * rl);
            *(u32x2*)(yrow + 32 * db + 8 * rg + 4 * hi) = w; }
}


#define XB_TMO      128
#define XB_XCNT(j)  (256  + 64 * (j))
#define XB_XSUB(j)  (1280 + 64 * (j))
#define XB_XGEN(j)  (2304 + 64 * (j))
#define XB_TOP      3328
#define XB_TOPGEN   3392
#define XCD_BAR_WORDS 3456
#define XB_SPIN_CAP (1u << 22)
__device__ __forceinline__ unsigned xb_ld(unsigned* p)              { return __hip_atomic_load(p, __ATOMIC_RELAXED, __HIP_MEMORY_SCOPE_AGENT); }
__device__ __forceinline__ unsigned xb_add(unsigned* p, unsigned v) { return __hip_atomic_fetch_add(p, v, __ATOMIC_RELAXED, __HIP_MEMORY_SCOPE_AGENT); }
__device__ __forceinline__ unsigned xb_xcc_id() { return (unsigned)__builtin_amdgcn_s_getreg((3 << 11) | 20) & 0xFu; }
#define XB_SPIN(cond, bar) do { unsigned _sp = 0; while (cond) { __builtin_amdgcn_s_sleep(1); \
    if ((++_sp & 255u) == 0u) { if (xb_ld(&(bar)[XB_TMO])) break; if (_sp > XB_SPIN_CAP) { atomicAdd(&(bar)[XB_TMO], 1u); break; } } } } while (0)
struct XcdBarrier { unsigned* bar; unsigned x; volatile LAS unsigned* st; };
__device__ __forceinline__ XcdBarrier xcd_barrier_post(unsigned* bar, volatile LAS unsigned* st) {
    XcdBarrier b; b.bar = bar; b.x = xb_xcc_id(); b.st = st;
    if (threadIdx.x == 0) (void)xb_add(&bar[XB_XCNT(b.x)], 1u);
    return b;
}
__device__ __forceinline__ void xcd_barrier_complete(unsigned* bar, unsigned x, unsigned& nloc, unsigned& nx) {
    const unsigned G = gridDim.x * gridDim.y * gridDim.z;
    unsigned sum, cnt, mine, sp = 0u;
    for (;;) {
        sum = 0u; cnt = 0u; mine = 0u;
#pragma unroll
        for (unsigned j = 0; j < 16; ++j) { const unsigned c = xb_ld(&bar[XB_XCNT(j)]); sum += c; cnt += (c > 0u) ? 1u : 0u; mine = (j == x) ? c : mine; }
        if (sum == G) break;
        __builtin_amdgcn_s_sleep(1);
        if ((++sp & 255u) == 0u) { if (xb_ld(&bar[XB_TMO])) break; if (sp > XB_SPIN_CAP) { atomicAdd(&bar[XB_TMO], 1u); break; } }
    }
    nloc = mine > 0u ? mine : 1u; nx = cnt > 0u ? cnt : 1u;
}
__device__ __forceinline__ void xcd_barrier(const XcdBarrier& b) {
    asm volatile("s_waitcnt vmcnt(0)" ::: "memory");
    __syncthreads();
    if (threadIdx.x == 0) {
        unsigned* bar = b.bar;
        __builtin_amdgcn_s_waitcnt(0);
        unsigned nloc = b.st[0], nx = b.st[1];
        if (nloc == 0u) { xcd_barrier_complete(bar, b.x, nloc, nx); b.st[0] = nloc; b.st[1] = nx; }
        const unsigned old = xb_add(&bar[XB_XSUB(b.x)], 1u);
        const unsigned gen = old / nloc;
        if (old + 1u == (gen + 1u) * nloc) {
            __builtin_amdgcn_fence(__ATOMIC_RELEASE, "agent");
            asm volatile("s_waitcnt vmcnt(0)" ::: "memory");
            const unsigned og = xb_add(&bar[XB_TOP], 1u);
            const unsigned tg = og / nx;
            if (og + 1u == (tg + 1u) * nx) xb_add(&bar[XB_TOPGEN], 1u);
            else XB_SPIN(xb_ld(&bar[XB_TOPGEN]) == tg, bar);
            __builtin_amdgcn_fence(__ATOMIC_ACQUIRE, "agent");
            xb_add(&bar[XB_XGEN(b.x)], 1u);
            asm volatile("s_waitcnt vmcnt(0)" ::: "memory");
        } else {
            XB_SPIN(xb_ld(&bar[XB_XGEN(b.x)]) == gen, bar);
            __builtin_amdgcn_fence(__ATOMIC_ACQUIRE, "agent");
            asm volatile("s_waitcnt vmcnt(0)" ::: "memory");
        }
    }
    __syncthreads();
}

constexpr int LDS_BYTES = 147456;
struct Args { const float* in[14]; float* out; unsigned char* ws; int ph_lo, ph_hi; };

__global__ void __launch_bounds__(512, 2) hymba_fwd(Args args) {
    extern __shared__ __attribute__((aligned(16))) unsigned char lds_raw[];
    LAS unsigned char* lds = (LAS unsigned char*)lds_raw;
    cg::grid_group grid = cg::this_grid();
    const int tid = threadIdx.x, lane = tid & 63, wave = __builtin_amdgcn_readfirstlane(tid >> 6);
    const int G = gridDim.x, bx = blockIdx.x;
    unsigned char* ws = args.ws;
    const float* x = args.in[0]; const float* p_in = args.in[1]; const float* g_attn = args.in[2]; const float* w_in = args.in[3]; const float* g_idx = args.in[4];
    const float* w_out = args.in[5]; const float* g_ffn = args.in[6]; const float* w_gate = args.in[7]; const float* w_up = args.in[8]; const float* w_down = args.in[9];
    const float* g_ple = args.in[10]; const float* w_pg = args.in[11]; const float* w_pp = args.in[12]; const float* g_final = args.in[13];
    h16* Wt_in = (h16*)(ws + WS_WIN); h16* Wt_out = (h16*)(ws + WS_WOUT); h16* Wt_gu = (h16*)(ws + WS_WGU); h16* Wt_dn = (h16*)(ws + WS_WDN); h16* Wt_pg = (h16*)(ws + WS_WPG); h16* Wt_pp = (h16*)(ws + WS_WPP);
    float* rope = (float*)(ws + WS_ROPE); float* rs0 = (float*)(ws + WS_RS0); float* ssp1 = (float*)(ws + WS_SSP1); float* ssp2 = (float*)(ws + WS_SSP2); float* ssp3 = (float*)(ws + WS_SSP3);
    float* kmp = (float*)(ws + WS_KMP); float* WI = (float*)(ws + WS_WI);
    h16* PH = (h16*)(ws + WS_PH); h16* PP = (h16*)(ws + WS_PP); h16* XH = (h16*)(ws + WS_XH); h16* H1 = XH; h16* H3 = XH; h16* Y = (h16*)(ws + WS_Y); h16* H2 = Y;
    h16* QA = (h16*)(ws + WS_QA); h16* KA = (h16*)(ws + WS_KA); h16* VA = (h16*)(ws + WS_VA); h16* QI = (h16*)(ws + WS_QI); h16* KI = (h16*)(ws + WS_KI);
    h16* QB = (h16*)(ws + WS_QB); h16* KB = (h16*)(ws + WS_KB); h16* VB = (h16*)(ws + WS_VB); h16* ACT = (h16*)(ws + WS_ACT);
    const int lo = args.ph_lo, hi_ph = args.ph_hi;
#ifndef PH_MASK
#define PH_MASK 0xff
#endif
#define IN(k) (((PH_MASK >> (k)) & 1) && lo <= (k) && (k) < hi_ph)
    volatile LAS unsigned* MISC = (volatile LAS unsigned*)(lds + LDS_BYTES - 256);
    unsigned* barw = (unsigned*)(ws + 0);
    XcdBarrier xbar; xbar.bar = barw; xbar.x = 0; xbar.st = MISC;
#define SEAM(k) do { if (IN(k) && IN((k) + 1)) { if ((k) == 0) { grid.sync(); if (tid == 0) { MISC[0] = 0u; MISC[1] = 0u; } __syncthreads(); xbar = xcd_barrier_post(barw, MISC); } else xcd_barrier(xbar); } } while (0)

    if (IN(0)) for (int rep_ph = 0; rep_ph < 1 + (REPMASK & 1); ++rep_ph) {
        if (bx == 0) for (int i = tid; i < XCD_BAR_WORDS; i += 512) barw[i] = 0u;
        LAS float* scr = (LAS float*)(lds + wave * 16384);
        const int gw = bx * 8 + wave, NGW = G * 8;
        transpose_items(DM, NIN_SRC, Wt_in, NIN, [=](int np) -> const float* { const int c = win_colmap(np); return c >= 0 ? w_in + c : nullptr; }, g_attn, scr, gw, NGW, lane);
        transpose_items(DM, DM, Wt_out, DM, [=](int np) -> const float* { return w_out + np; }, nullptr, scr, gw, NGW, lane);
        transpose_items(DM, DFF, Wt_gu, 2 * DFF, [=](int np) -> const float* { const int p = np & 255, t = np >> 8; return (p < 128) ? (w_gate + t * 128 + p) : (w_up + t * 128 + p - 128); }, g_ffn, scr, gw, NGW, lane);
        transpose_items(DFF, DM, Wt_dn, DM, [=](int np) -> const float* { return w_down + np; }, nullptr, scr, gw, NGW, lane);
        transpose_items(DM, DM, Wt_pg, DM, [=](int np) -> const float* { return w_pg + np; }, g_ple, scr, gw, NGW, lane);
        transpose_items(DPLE, DM, Wt_pp, DM, [=](int np) -> const float* { return w_pp + np; }, nullptr, scr, gw, NGW, lane);
        for (int m0 = 2 * gw; m0 < NTOK; m0 += 2 * NGW) {
            f32x4 v[2][4]; float s[2];
#pragma unroll
            for (int r2 = 0; r2 < 2; ++r2) { const f32x4* xr = (const f32x4*)(x + (size_t)(m0 + r2) * DM) + lane;
#pragma unroll
                for (int jj = 0; jj < 4; ++jj) v[r2][jj] = __builtin_nontemporal_load(xr + 64 * jj); }
#pragma unroll
            for (int r2 = 0; r2 < 2; ++r2) { float t = 0.f;
#pragma unroll
                for (int jj = 0; jj < 4; ++jj) t += (v[r2][jj].x * v[r2][jj].x + v[r2][jj].y * v[r2][jj].y) + (v[r2][jj].z * v[r2][jj].z + v[r2][jj].w * v[r2][jj].w);
                s[r2] = wave_sum(t); }
#pragma unroll
            for (int r2 = 0; r2 < 2; ++r2) {
                if (lane == 0) rs0[m0 + r2] = 1.0f / sqrtf(s[r2] * (1.0f / DM) + EPS);
                u32x2* o8 = (u32x2*)(XH + (size_t)(m0 + r2) * DM) + lane;
#pragma unroll
                for (int jj = 0; jj < 4; ++jj) { u32x2 w; w.x = pkh(v[r2][jj].x, v[r2][jj].y); w.y = pkh(v[r2][jj].z, v[r2][jj].w); o8[64 * jj] = w; } }
        }
        for (int m0 = 4 * gw; m0 < NTOK; m0 += 4 * NGW) {
            f32x4 v[4];
#pragma unroll
            for (int r4 = 0; r4 < 4; ++r4) v[r4] = __builtin_nontemporal_load((const f32x4*)(p_in + (size_t)(m0 + r4) * DPLE) + lane);
#pragma unroll
            for (int r4 = 0; r4 < 4; ++r4) { u32x2 w; w.x = pkh(v[r4].x, v[r4].y); w.y = pkh(v[r4].z, v[r4].w); *((u32x2*)(PH + (size_t)(m0 + r4) * DPLE) + lane) = w; }
        }
        for (int i = bx * 512 + tid; i < SEQ * 32; i += G * 512) {
            const int pos = i >> 5, jx = i & 31;
            const float inv = ROPE_INV[jx];
            const float ang = (float)pos * inv;
            const double a = (double)ang; const double kq = __builtin_rint(a * 0.15915494309189535);
            double r = __builtin_fma(-kq, 6.283185307179586, a); r = __builtin_fma(-kq, 2.4492935982947064e-16, r);
            const double r2 = r * r; double sn = 0.0, cs = 0.0;
            double ts = 1.0, tc = 1.0;
#pragma unroll
            for (int n = 13; n >= 1; --n) { ts = 1.0 - ts * r2 / (double)((2 * n) * (2 * n + 1)); tc = 1.0 - tc * r2 / (double)((2 * n - 1) * (2 * n)); }
            sn = r * ts; cs = tc;
            rope[(size_t)i * 2] = (float)cs; rope[(size_t)i * 2 + 1] = (float)sn;
        }
    }
    SEAM(0);
    if (IN(1)) for (int rep_ph = 0; rep_ph < 1 + ((REPMASK >> 1) & 1); ++rep_ph) {
        { pg8::Gemm g{XH, Wt_in, NTOK, NIN, DM}; pg8::StaticOrder S; S.init(NTOK, NIN, G, bx);
          pg8::EpiInProj E{rs0, rope, g_idx, QA, KA, VA, QI, KI, QB, KB, VB, WI, kmp};
          pg8::gemm_phase(lds, g, S, E); }
        { pg8::Gemm g{PH, Wt_pp, NTOK, DM, DPLE}; pg8::StaticOrder S; S.init(NTOK, DM, G, bx);
          pg8::EpiPlain E{PP, DM};
          pg8::gemm_phase(lds, g, S, E); }
    }
    SEAM(1);
    if (IN(2)) {
        AttnPtrs P{QA, KA, VA, QI, KI, QB, KB, VB, WI, kmp, Y};
        const int b = bx & 7, r = bx >> 3;
        const int nr = G >> 3;
#ifndef NO_DSA
        for (int rep = 0; rep < REP_DSA; ++rep)
        for (int s = r; s < 128; s += nr) { dsa_unit(lds, P, b, s); dsa_unit(lds, P, b, 255 - s); }
#endif
#ifndef NO_MOBA
        for (int rep = 0; rep < REP_MOBA; ++rep)
        for (int uu = r; uu < 64; uu += nr) { const int h = uu >> 3, s = uu & 7; moba_unit(lds, P, b, h, s); __syncthreads(); moba_unit(lds, P, b, h, 15 - s); __syncthreads(); }
#endif
    }
    SEAM(2);
    if (IN(3)) for (int rep_ph = 0; rep_ph < 1 + ((REPMASK >> 3) & 1); ++rep_ph) {
        pg8::Gemm g{Y, Wt_out, NTOK, DM, DM}; pg8::StaticOrder S; S.init(NTOK, DM, G, bx);
        pg8::EpiRes<false> E{XH, H1, ssp1};
        pg8::gemm_phase(lds, g, S, E);
    }
    SEAM(3);
    if (IN(4)) for (int rep_ph = 0; rep_ph < 1 + ((REPMASK >> 4) & 1); ++rep_ph) {
        pg8::Gemm g{H1, Wt_gu, NTOK, 2 * DFF, DM}; pg8::StaticOrder S; S.init(NTOK, 2 * DFF, G, bx);
        pg8::EpiSwiGLU E{ssp1, ACT};
        pg8::gemm_phase(lds, g, S, E);
    }
    SEAM(4);
    if (IN(5)) for (int rep_ph = 0; rep_ph < 1 + ((REPMASK >> 5) & 1); ++rep_ph) {
        pg8::Gemm g{ACT, Wt_dn, NTOK, DM, DFF}; pg8::StaticOrder S; S.init(NTOK, DM, G, bx);
        pg8::EpiRes<false> E{H1, H2, ssp2};
        pg8::gemm_phase(lds, g, S, E);
    }
    SEAM(5);
    if (IN(6)) for (int rep_ph = 0; rep_ph < 1 + ((REPMASK >> 6) & 1); ++rep_ph) {
        pg8::Gemm g{H2, Wt_pg, NTOK, DM, DM}; pg8::StaticOrder S; S.init(NTOK, DM, G, bx);
        pg8::EpiPLE E{ssp2, H2, PP, H3, ssp3};
        pg8::gemm_phase(lds, g, S, E);
    }
    SEAM(6);
    if (IN(7)) {
        const int gw = bx * 8 + wave, NGW = G * 8;
        f32x4 gf[2][2];
#pragma unroll
        for (int hh = 0; hh < 2; ++hh) { gf[hh][0] = *(const f32x4*)(g_final + 512 * hh + 8 * lane); gf[hh][1] = *(const f32x4*)(g_final + 512 * hh + 8 * lane + 4); }
        for (int m = gw; m < NTOK; m += NGW) {
            const float s = pg8::row_rstd(ssp3, m);
#pragma unroll
            for (int hh = 0; hh < 2; ++hh) {
                const h16x8 hv = *(const h16x8*)(H3 + (size_t)m * DM + 512 * hh + 8 * lane);
                float* o = args.out + (size_t)m * DM + 512 * hh + 8 * lane;
                f32x4 v0 = {(float)hv[0], (float)hv[1], (float)hv[2], (float)hv[3]}, v1 = {(float)hv[4], (float)hv[5], (float)hv[6], (float)hv[7]};
                v0 = v0 * s * gf[hh][0]; v1 = v1 * s * gf[hh][1];
                *(f32x4*)o = v0; *(f32x4*)(o + 4) = v1;
            }
        }
    }
#undef IN
#undef SEAM
}

extern "C" void kernel_launch(void* const* d_in, const int* in_sizes, int n_in, void* d_out, int out_size, void* d_ws, size_t ws_size, hipStream_t stream) {
    static int grid = 0;
    if (grid == 0) {
        if (n_in != 14 || out_size != NTOK * DM || ws_size < WS_END) { fprintf(stderr, "kernel_launch: unexpected shapes (n_in %d out %d ws %zu)\n", n_in, out_size, ws_size); grid = -1; return; }
        int dev = 0, cus = 0, per_cu = 0;
        (void)hipGetDevice(&dev);
        (void)hipDeviceGetAttribute(&cus, hipDeviceAttributeMultiprocessorCount, dev);
        (void)hipFuncSetAttribute((const void*)hymba_fwd, hipFuncAttributeMaxDynamicSharedMemorySize, LDS_BYTES);
        (void)hipOccupancyMaxActiveBlocksPerMultiprocessor(&per_cu, (const void*)hymba_fwd, 512, LDS_BYTES);
        if (per_cu < 1) { fprintf(stderr, "kernel_launch: occupancy query says %d blocks/CU\n", per_cu); }
        grid = cus;
        if (grid % 8 != 0 || grid > 256) grid = (grid / 8) * 8 > 256 ? 256 : (grid / 8) * 8;
    }
    if (grid <= 0) return;
    Args a{};
    for (int i = 0; i < 14; ++i) a.in[i] = (const float*)d_in[i];
    a.out = (float*)d_out; a.ws = (unsigned char*)d_ws;
#if MK_COOP
    a.ph_lo = 0; a.ph_hi = 8;
    void* kargs[] = {&a};
    hipError_t e = hipLaunchCooperativeKernel((const void*)hymba_fwd, dim3(grid), dim3(512), kargs, LDS_BYTES, stream);
    if (e != hipSuccess) fprintf(stderr, "cooperative launch failed: %s (grid %d)\n", hipGetErrorString(e), grid);
#else
    for (int ph = 0; ph < 8; ++ph) { a.ph_lo = ph; a.ph_hi = ph + 1; hipLaunchKernelGGL(hymba_fwd, dim3(grid), dim3(512), LDS_BYTES, stream, a); }
#endif
}
```

```cpp
#include <hip/hip_runtime.h>
#include <hip/hip_cooperative_groups.h>
#include <cstdio>
#include <cstdint>
#include <cmath>
namespace cg = cooperative_groups;

#ifndef REP_DSA
#define REP_DSA 1
#endif
#ifndef REP_MOBA
#define REP_MOBA 1
#endif
#ifndef REP_ATT
#define REP_ATT 1
#endif
#ifndef REP_SC
#define REP_SC 1
#endif
#ifndef REP_SEL
#define REP_SEL 1
#endif
#ifndef REP_EM
#define REP_EM 1
#endif
#ifndef REPMASK
#define REPMASK 0
#endif
#ifndef MK_COOP
#define MK_COOP 1
#endif

#define LAS __attribute__((address_space(3)))
typedef _Float16 h16;
typedef _Float16 h16x8 __attribute__((ext_vector_type(8)));
typedef _Float16 h16x4 __attribute__((ext_vector_type(4)));
typedef _Float16 h16x2 __attribute__((ext_vector_type(2)));
typedef short s16x8 __attribute__((ext_vector_type(8)));
typedef short s16x4 __attribute__((ext_vector_type(4)));
typedef float f32x2 __attribute__((ext_vector_type(2)));
typedef float f32x4 __attribute__((ext_vector_type(4)));
typedef float f32x16 __attribute__((ext_vector_type(16)));
typedef unsigned u32x2 __attribute__((ext_vector_type(2)));
typedef unsigned u32x4 __attribute__((ext_vector_type(4)));

constexpr int BATCH = 8, SEQ = 4096, DM = 1024, NTOK = BATCH * SEQ, NIN = 2560, NIN_SRC = 2500, DFF = 2816, DPLE = 256;
constexpr float EPS = 1e-6f;
constexpr float C2 = 0.125f * 1.4426950408889634f;
constexpr float NEG_INF = -__builtin_huge_valf();

constexpr size_t MiB = 1u << 20;
constexpr size_t WS_WIN = 1 * MiB, WS_WOUT = 6 * MiB, WS_WGU = 8 * MiB, WS_WDN = 19 * MiB, WS_WPG = 25 * MiB, WS_WPP = 27 * MiB;
constexpr size_t WS_ROPE = 28 * MiB, WS_RS0 = 29 * MiB, WS_SSP1 = 30 * MiB, WS_SSP2 = 32 * MiB, WS_SSP3 = 34 * MiB, WS_KMP = 36 * MiB, WS_WI = 37 * MiB;
constexpr size_t WS_PH = 38 * MiB, WS_PP = 54 * MiB, WS_XH = 118 * MiB  , WS_Y = 182 * MiB  ;
constexpr size_t WS_QA = 246 * MiB, WS_KA = 278 * MiB, WS_VA = 282 * MiB, WS_QI = 286 * MiB, WS_KI = 302 * MiB, WS_QB = 306 * MiB, WS_KB = 338 * MiB, WS_VB = 370 * MiB;
constexpr size_t WS_ACT = 246 * MiB  , WS_END = 422 * MiB;

__constant__ float ROPE_INV[32] = {0x1.0000000000000p+0f, 0x1.7ff2220000000p-1f, 0x1.1feb340000000p-1f, 0x1.afd1360000000p-2f, 0x1.43d1360000000p-2f, 0x1.e5a8480000000p-3f, 0x1.6c310e0000000p-3f, 0x1.111aee0000000p-3f,
    0x1.99999a0000000p-4f, 0x1.33281c0000000p-4f, 0x1.ccab860000000p-5f, 0x1.59742a0000000p-5f, 0x1.030dc40000000p-5f, 0x1.8486a00000000p-6f, 0x1.235a720000000p-6f, 0x1.b4f7e20000000p-7f,
    0x1.47ae140000000p-7f, 0x1.eb73600000000p-8f, 0x1.7089380000000p-8f, 0x1.145cee0000000p-8f, 0x1.9e7c6e0000000p-9f, 0x1.36d21a0000000p-9f, 0x1.d22a500000000p-10f, 0x1.5d931c0000000p-10f,
    0x1.0624de0000000p-10f, 0x1.8929180000000p-11f, 0x1.26d42c0000000p-11f, 0x1.ba2e4c0000000p-12f, 0x1.4b96be0000000p-12f, 0x1.f150280000000p-13f, 0x1.74eea60000000p-13f, 0x1.17a8e40000000p-13f};
__device__ __forceinline__ int lane_id_fresh() { int l; asm volatile("v_mbcnt_lo_u32_b32 %0, -1, 0\n\tv_mbcnt_hi_u32_b32 %0, -1, %0" : "=v"(l)); return l; }
__device__ __forceinline__ unsigned pkh(float lo, float hi) { h16x2 v = {(h16)lo, (h16)hi}; return __builtin_bit_cast(unsigned, v); }
__device__ __forceinline__ float wave_sum(float v) {
#pragma unroll
    for (int o = 1; o < 64; o <<= 1) v += __shfl_xor(v, o);
    return v;
}
__device__ __forceinline__ float fast_sigmoid(float x) { return __builtin_amdgcn_rcpf(1.0f + __builtin_amdgcn_exp2f(-1.4426950408889634f * x)); }

namespace pg8 {
constexpr int BM = 256, BK = 64, HALF = 128, HTB = HALF * BK * 2, STAGE_BYTES = 8 * HTB, NXCD = 8, WGM = 8;
__host__ __device__ __forceinline__ int lds_byte(int r, int c) { const int st = (r >> 4) * 2 + (c >> 5), rr = r & 15, cc = c & 31, ob = rr * 64 + cc * 2; return st * 1024 + (ob ^ (((ob >> 9) & 1) << 5)); }
__host__ __device__ __forceinline__ void stage_rc(int b, int& R, int& C) { const int st = b / 1024, sb = b % 1024, swz = sb ^ (((sb >> 9) & 1) << 5); R = (st >> 1) * 16 + swz / 64; C = (st & 1) * 32 + (swz % 64) / 2; }
__host__ __device__ __forceinline__ int perm32(int rho) { const int n = rho >> 4, i = rho & 15; return 8 * (i >> 2) + 4 * n + (i & 3); }
struct Unit { int pm, pn; };
struct Gemm { const h16* A; const h16* Bt; int M, N, K; };
struct StaticOrder {
    int nM, nN, nwg, G, c;
    __host__ __device__ void init(int M, int N, int G_, int c_) { nM = M / BM; nN = N / BM; nwg = nM * nN; G = G_; c = c_; }
    __host__ __device__ bool next(int i, Unit& u) const {
        const long L = (long)i * G + c; if (L >= nwg) return false;
        int wgid = (int)L; { const int q = nwg / NXCD, r = nwg % NXCD, xcd = wgid % NXCD, off = wgid / NXCD; wgid = (xcd < r ? xcd * (q + 1) : r * (q + 1) + (xcd - r) * q) + off; }
        const int nig = WGM * nN, gid = wgid / nig, fm = gid * WGM, gsz = (nM - fm) < WGM ? (nM - fm) : WGM;
        u.pm = fm + ((wgid % nig) % gsz); u.pn = (wgid % nig) / gsz; return true;
    }
};
template <class Epi>
__device__ __forceinline__ void gemm_phase(LAS unsigned char* lds, const Gemm g, const StaticOrder& S, const Epi& E) {
    const int tid = threadIdx.x, wid = __builtin_amdgcn_readfirstlane(tid >> 6), lane = tid & 63, wr = wid >> 2, wc = wid & 3, fr = lane & 15, fq = lane >> 4;
    const int K = g.K, nt = K / BK;
    unsigned voffA[2], voffB[2];
#pragma unroll
    for (int i = 0; i < 2; ++i) { int R, C; stage_rc(tid * 16 + i * 8192, R, C); const int Rb = (R & ~31) + perm32(R & 31);
        voffA[i] = (unsigned)(R * K + C) * 2u; voffB[i] = (unsigned)(Rb * K + C) * 2u; }
    const size_t kstep = (size_t)(BK * 2);
    const size_t hstep = (size_t)HALF * K * 2;
    const size_t tstep = 2 * hstep;
    const unsigned ldsw = (unsigned)wid * 1024u;
    const int aoff = lds_byte(wr * 64 + fr, fq * 8), boff = lds_byte(wc * 32 + fr, fq * 8);
#define PG8_SA(b, h) (((b) * 2 + (h)) * HTB)
#define PG8_SB(b, h) ((4 + (b) * 2 + (h)) * HTB)
#define PG8_STAGE(bufoff, gbase, voff) do { _Pragma("unroll") for (int _i = 0; _i < 2; ++_i) \
        __builtin_amdgcn_global_load_lds((const unsigned*)((const char*)(gbase) + (voff)[_i]), (LAS unsigned*)(lds + (bufoff) + ldsw + _i * 8192), 16, 0, 0); } while (0)
#define PG8_LDA(dst, b, h) do { _Pragma("unroll") for (int m = 0; m < 4; ++m) _Pragma("unroll") for (int k = 0; k < 2; ++k) dst[m][k] = *(const LAS s16x8*)(lds + PG8_SA(b, h) + aoff + m * 2048 + k * 1024); } while (0)
#define PG8_LDB(dst, b, h) do { _Pragma("unroll") for (int n = 0; n < 2; ++n) _Pragma("unroll") for (int k = 0; k < 2; ++k) dst[n][k] = *(const LAS s16x8*)(lds + PG8_SB(b, h) + boff + n * 2048 + k * 1024); } while (0)
#define PG8_MMA(ai, bj, At, Bt) do { __builtin_amdgcn_s_setprio(1); _Pragma("unroll") for (int m = 0; m < 4; ++m) _Pragma("unroll") for (int n = 0; n < 2; ++n) _Pragma("unroll") for (int k = 0; k < 2; ++k) \
        acc[ai][bj][m][n] = __builtin_amdgcn_mfma_f32_16x16x32_f16(__builtin_bit_cast(h16x8, Bt[n][k]), __builtin_bit_cast(h16x8, At[m][k]), acc[ai][bj][m][n], 0, 0, 0); __builtin_amdgcn_s_setprio(0); } while (0)
#define PG8_WAIT_V(n) asm volatile("s_waitcnt vmcnt(" #n ")" ::: "memory")
#define PG8_WAIT_L(n) asm volatile("s_waitcnt lgkmcnt(" #n ")" ::: "memory")
#define PG8_BAR __builtin_amdgcn_s_barrier()
#define PG8_SCHED __builtin_amdgcn_sched_barrier(0)
    Unit cur, nxt; int ui = 0;
    if (!S.next(0, cur)) return;
    f32x4 acc[2][2][4][2];
#pragma unroll
    for (int a = 0; a < 2; ++a)
#pragma unroll
        for (int b = 0; b < 2; ++b)
#pragma unroll
            for (int m = 0; m < 4; ++m)
#pragma unroll
                for (int n = 0; n < 2; ++n) acc[a][b][m][n] = (f32x4){0.f, 0.f, 0.f, 0.f};
    s16x8 At[4][2], B0[2][2], B1[2][2];
    const char* cA = (const char*)g.A + (size_t)cur.pm * tstep; const char* cB = (const char*)g.Bt + (size_t)cur.pn * tstep;
    PG8_STAGE(PG8_SB(0, 0), cB, voffB); PG8_STAGE(PG8_SB(0, 1), cB + hstep, voffB); PG8_STAGE(PG8_SA(0, 0), cA, voffA); PG8_STAGE(PG8_SA(0, 1), cA + hstep, voffA);
    if (wr == 1) PG8_BAR;
    PG8_WAIT_V(2); PG8_BAR;
    PG8_STAGE(PG8_SB(1, 0), cB + kstep, voffB); PG8_STAGE(PG8_SA(1, 0), cA + kstep, voffA); PG8_STAGE(PG8_SB(1, 1), cB + hstep + kstep, voffB);
    PG8_WAIT_V(6); PG8_BAR;
    for (;;) {
        const bool has_next = S.next(ui + 1, nxt);
        const char* nA = has_next ? (const char*)g.A + (size_t)nxt.pm * tstep : cA; const char* nB = has_next ? (const char*)g.Bt + (size_t)nxt.pn * tstep : cB;
#pragma unroll 1
        for (int t = 0; t < nt; t += 2) {
            const bool last = (t == nt - 2);
            const char* a1 = cA + (size_t)(t + 1) * kstep;
            const char* a2 = last ? nA : cA + (size_t)(t + 2) * kstep; const char* b2 = last ? nB : cB + (size_t)(t + 2) * kstep;
            const char* a3 = a2 + kstep; const char* b3 = b2 + kstep;
            PG8_LDB(B0, 0, 0); PG8_LDB(B1, 0, 1); PG8_SCHED; PG8_LDA(At, 0, 0); PG8_STAGE(PG8_SA(1, 1), a1 + hstep, voffA);
            PG8_WAIT_V(8); PG8_WAIT_L(0); PG8_BAR; PG8_MMA(0, 0, At, B0); PG8_MMA(0, 1, At, B1); PG8_BAR; PG8_SCHED;
            PG8_LDA(At, 0, 1); PG8_STAGE(PG8_SB(0, 0), b2, voffB); PG8_STAGE(PG8_SB(0, 1), b2 + hstep, voffB); PG8_STAGE(PG8_SA(0, 0), a2, voffA);
            PG8_WAIT_V(8); PG8_WAIT_L(0); PG8_BAR; PG8_MMA(1, 0, At, B0); PG8_MMA(1, 1, At, B1); PG8_BAR; PG8_SCHED;
            PG8_LDB(B0, 1, 0); PG8_LDB(B1, 1, 1); PG8_SCHED; PG8_LDA(At, 1, 0); PG8_STAGE(PG8_SA(0, 1), a2 + hstep, voffA);
            PG8_WAIT_V(8); PG8_WAIT_L(0); PG8_BAR; PG8_MMA(0, 0, At, B0); PG8_MMA(0, 1, At, B1); PG8_BAR; PG8_SCHED;
            PG8_LDA(At, 1, 1); PG8_STAGE(PG8_SB(1, 0), b3, voffB); PG8_STAGE(PG8_SB(1, 1), b3 + hstep, voffB); PG8_STAGE(PG8_SA(1, 0), a3, voffA);
            PG8_WAIT_V(8); PG8_WAIT_L(0); PG8_BAR; PG8_MMA(1, 0, At, B0); PG8_MMA(1, 1, At, B1); PG8_BAR; PG8_SCHED;
        }
        if (wr == 0) PG8_BAR;
        E(acc, cur, wr, wc, fr, fq);
        if (!has_next) break;
#pragma unroll
        for (int a = 0; a < 2; ++a)
#pragma unroll
            for (int b = 0; b < 2; ++b)
#pragma unroll
                for (int m = 0; m < 4; ++m)
#pragma unroll
                    for (int n = 0; n < 2; ++n) acc[a][b][m][n] = (f32x4){0.f, 0.f, 0.f, 0.f};
        cur = nxt; cA = nA; cB = nB; ++ui;
        if (wr == 1) PG8_BAR;
    }
    PG8_WAIT_V(0);
    PG8_BAR;
#undef PG8_SA
#undef PG8_SB
#undef PG8_STAGE
#undef PG8_LDA
#undef PG8_LDB
#undef PG8_MMA
#undef PG8_WAIT_V
#undef PG8_WAIT_L
#undef PG8_BAR
#undef PG8_SCHED
}

typedef const f32x4 (&AccRef)[2][2][4][2];

struct EpiPlain {
    h16* O; int ldc;
    __device__ __forceinline__ void operator()(AccRef acc, const Unit& u, int wr, int wc, int fr, int fq) const {
        const int row0 = u.pm * BM + wr * 64 + fr, col0 = u.pn * BM + wc * 32 + 8 * fq;
#pragma unroll
        for (int ai = 0; ai < 2; ++ai)
#pragma unroll
            for (int m = 0; m < 4; ++m) { h16* rowp = O + (size_t)(row0 + ai * HALF + m * 16) * ldc + col0;
#pragma unroll
                for (int bj = 0; bj < 2; ++bj) { const f32x4 v0 = acc[ai][bj][m][0], v1 = acc[ai][bj][m][1];
                    u32x4 w; w.x = pkh(v0[0], v0[1]); w.y = pkh(v0[2], v0[3]); w.z = pkh(v1[0], v1[1]); w.w = pkh(v1[2], v1[3]);
                    *(u32x4*)(rowp + bj * HALF) = w; } }
    }
};

struct EpiInProj {
    const float* rs0; const float* rope; const float* gidx;
    h16 *QA, *KA, *VA, *QI, *KI, *QB, *KB, *VB; float* WI; float* kmp;
    __device__ __forceinline__ void operator()(AccRef acc, const Unit& u, int wr, int wc, int fr_in, int fq_in) const {
        int fr = fr_in, fq = fq_in; asm volatile("" : "+v"(fr), "+v"(fq));
        const int pn = u.pn;
        int type = 0; h16* dst = VA; int pitch = 64, cb = 0; float scl = 1.f; bool iskb = false;
        if (pn < 2) { type = 1; dst = QA; pitch = 512; cb = 256 * pn + 64 * wc; scl = C2; }
        else if (pn == 2) { if (wc == 0) { type = 1; dst = KA; } else if (wc == 1) { type = 0; dst = VA; } else if (wc == 2) { type = 2; dst = KI; } else { type = 3; } }
        else if (pn == 3) { type = 1; dst = QI; pitch = 256; cb = 64 * wc; }
        else if (pn < 6) { type = 1; dst = QB; pitch = 512; cb = 256 * (pn - 4) + 64 * wc; scl = C2; }
        else if (pn < 8) { type = 1; dst = KB; pitch = 512; cb = 256 * (pn - 6) + 64 * wc; iskb = true; }
        else { type = 0; dst = VB; pitch = 512; cb = 256 * (pn - 8) + 64 * wc; }
        float ks[2][2][4];
#pragma unroll
        for (int bj = 0; bj < 2; ++bj)
#pragma unroll
            for (int n = 0; n < 2; ++n)
#pragma unroll
                for (int e = 0; e < 4; ++e) ks[bj][n][e] = 0.f;
        float gl[2][2][4];
        if (type == 2) {
#pragma unroll
            for (int bj = 0; bj < 2; ++bj)
#pragma unroll
                for (int n = 0; n < 2; ++n)
#pragma unroll
                    for (int e = 0; e < 4; ++e) gl[bj][n][e] = gidx[32 * bj + 8 * fq + 4 * n + e];
        }
#pragma unroll
        for (int ai = 0; ai < 2; ++ai)
#pragma unroll
            for (int m = 0; m < 4; ++m) {
                const int row = u.pm * BM + ai * HALF + wr * 64 + m * 16 + fr;
                const float s = rs0[row];
                float v[2][2][4];
#pragma unroll
                for (int bj = 0; bj < 2; ++bj)
#pragma unroll
                    for (int n = 0; n < 2; ++n)
#pragma unroll
                        for (int e = 0; e < 4; ++e) v[bj][n][e] = acc[ai][bj][m][n][e] * s;
                if (type == 3) {
                    if (fq == 0) *(f32x4*)(WI + (size_t)row * 4) = (f32x4){v[0][0][0] * 0.0625f, v[0][0][1] * 0.0625f, v[0][0][2] * 0.0625f, v[0][0][3] * 0.0625f};
                    continue;
                }
                if (type == 2) {
                    float sum = 0.f;
#pragma unroll
                    for (int bj = 0; bj < 2; ++bj)
#pragma unroll
                        for (int n = 0; n < 2; ++n)
#pragma unroll
                            for (int e = 0; e < 4; ++e) sum += v[bj][n][e];
                    sum += __shfl_xor(sum, 16); sum += __shfl_xor(sum, 32);
                    const float mean = sum * (1.f / 64.f); float q = 0.f;
#pragma unroll
                    for (int bj = 0; bj < 2; ++bj)
#pragma unroll
                        for (int n = 0; n < 2; ++n)
#pragma unroll
                            for (int e = 0; e < 4; ++e) { v[bj][n][e] -= mean; q += v[bj][n][e] * v[bj][n][e]; }
                    q += __shfl_xor(q, 16); q += __shfl_xor(q, 32);
                    const float rstd = 1.0f / sqrtf(q * (1.f / 64.f) + EPS);
#pragma unroll
                    for (int bj = 0; bj < 2; ++bj)
#pragma unroll
                        for (int n = 0; n < 2; ++n)
#pragma unroll
                            for (int e = 0; e < 4; ++e) v[bj][n][e] = v[bj][n][e] * rstd * gl[bj][n][e];
                }
                if (type >= 1) {
                    const int pos = row & (SEQ - 1);
                    const f32x4* cs = (const f32x4*)(rope + ((size_t)pos * 32 + 8 * fq) * 2);
#pragma unroll
                    for (int n = 0; n < 2; ++n) { const f32x4 c01 = cs[2 * n], c23 = cs[2 * n + 1];
                        const float cc[4] = {c01[0], c01[2], c23[0], c23[2]}, sn[4] = {c01[1], c01[3], c23[1], c23[3]};
#pragma unroll
                        for (int e = 0; e < 4; ++e) { const float lo = v[0][n][e], hi = v[1][n][e]; v[0][n][e] = lo * cc[e] - hi * sn[e]; v[1][n][e] = hi * cc[e] + lo * sn[e]; } }
                }
#pragma unroll
                for (int bj = 0; bj < 2; ++bj) {
#pragma unroll
                    for (int n = 0; n < 2; ++n)
#pragma unroll
                        for (int e = 0; e < 4; ++e) { v[bj][n][e] *= scl; ks[bj][n][e] += v[bj][n][e]; }
                    u32x4 w; w.x = pkh(v[bj][0][0], v[bj][0][1]); w.y = pkh(v[bj][0][2], v[bj][0][3]); w.z = pkh(v[bj][1][0], v[bj][1][1]); w.w = pkh(v[bj][1][2], v[bj][1][3]);
                    *(u32x4*)(dst + (size_t)row * pitch + cb + 32 * bj + 8 * fq) = w;
                }
                __builtin_amdgcn_sched_barrier(0);
            }
        if (iskb) {
#pragma unroll
            for (int bj = 0; bj < 2; ++bj)
#pragma unroll
                for (int n = 0; n < 2; ++n)
#pragma unroll
                    for (int e = 0; e < 4; ++e) { float t = ks[bj][n][e]; t += __shfl_xor(t, 1); t += __shfl_xor(t, 2); t += __shfl_xor(t, 4); t += __shfl_xor(t, 8); ks[bj][n][e] = t; }
            if (fr == 0) { const int head = 4 * (pn - 6) + wc; float* o = kmp + (((size_t)u.pm * 2 + wr) * 8 + head) * 64;
#pragma unroll
                for (int bj = 0; bj < 2; ++bj)
#pragma unroll
                    for (int n = 0; n < 2; ++n) *(f32x4*)(o + 32 * bj + 8 * fq + 4 * n) = (f32x4){ks[bj][n][0], ks[bj][n][1], ks[bj][n][2], ks[bj][n][3]}; }
        }
    }
};

template <bool BASE_F32> struct EpiRes {
    const void* base; h16* out; float* ssp;
    __device__ __forceinline__ void operator()(AccRef acc, const Unit& u, int wr, int wc, int fr, int fq) const {
        const int col0 = u.pn * BM + wc * 32 + 8 * fq;
#pragma unroll
        for (int ai = 0; ai < 2; ++ai)
#pragma unroll
            for (int m = 0; m < 4; ++m) { const int row = u.pm * BM + ai * HALF + wr * 64 + m * 16 + fr; float ss = 0.f;
#pragma unroll
                for (int bj = 0; bj < 2; ++bj) { const size_t off = (size_t)row * DM + col0 + bj * HALF; float b[8];
                    if (BASE_F32) { const f32x4 b0 = *(const f32x4*)((const float*)base + off), b1 = *(const f32x4*)((const float*)base + off + 4);
                        b[0] = b0[0]; b[1] = b0[1]; b[2] = b0[2]; b[3] = b0[3]; b[4] = b1[0]; b[5] = b1[1]; b[6] = b1[2]; b[7] = b1[3]; }
                    else { const h16x8 hb = *(const h16x8*)((const h16*)base + off);
#pragma unroll
                        for (int e = 0; e < 8; ++e) b[e] = (float)hb[e]; }
                    float v[8];
#pragma unroll
                    for (int e = 0; e < 8; ++e) { v[e] = b[e] + acc[ai][bj][m][e >> 2][e & 3]; ss += v[e] * v[e]; }
                    u32x4 w; w.x = pkh(v[0], v[1]); w.y = pkh(v[2], v[3]); w.z = pkh(v[4], v[5]); w.w = pkh(v[6], v[7]);
                    *(u32x4*)(out + off) = w; }
                ss += __shfl_xor(ss, 16); ss += __shfl_xor(ss, 32);
                if (fq == 0) ssp[(size_t)row * 16 + u.pn * 4 + wc] = ss; }
    }
};
__device__ __forceinline__ float row_rstd(const float* ssp, int row) {
    const f32x4* p = (const f32x4*)(ssp + (size_t)row * 16); const f32x4 a = p[0], b = p[1], c = p[2], d = p[3];
    const float s = ((a[0] + a[1]) + (a[2] + a[3])) + ((b[0] + b[1]) + (b[2] + b[3])) + ((c[0] + c[1]) + (c[2] + c[3])) + ((d[0] + d[1]) + (d[2] + d[3]));
    return 1.0f / sqrtf(s * (1.0f / DM) + EPS);
}
struct EpiSwiGLU {
    const float* ssp; h16* act;
    __device__ __forceinline__ void operator()(AccRef acc, const Unit& u, int wr, int wc, int fr, int fq) const {
        const int col0 = u.pn * HALF + wc * 32 + 8 * fq;
#pragma unroll
        for (int ai = 0; ai < 2; ++ai)
#pragma unroll
            for (int m = 0; m < 4; ++m) { const int row = u.pm * BM + ai * HALF + wr * 64 + m * 16 + fr; const float s = row_rstd(ssp, row); float v[8];
#pragma unroll
                for (int e = 0; e < 8; ++e) { const float gt = acc[ai][0][m][e >> 2][e & 3] * s, up = acc[ai][1][m][e >> 2][e & 3] * s; v[e] = gt * fast_sigmoid(gt) * up; }
                u32x4 w; w.x = pkh(v[0], v[1]); w.y = pkh(v[2], v[3]); w.z = pkh(v[4], v[5]); w.w = pkh(v[6], v[7]);
                *(u32x4*)(act + (size_t)row * DFF + col0) = w; }
    }
};
struct EpiPLE {
    const float* ssp2; const h16* h2; const h16* pp; h16* out; float* ssp3;
    __device__ __forceinline__ void operator()(AccRef acc, const Unit& u, int wr, int wc, int fr, int fq) const {
        const int col0 = u.pn * BM + wc * 32 + 8 * fq;
#pragma unroll
        for (int ai = 0; ai < 2; ++ai)
#pragma unroll
            for (int m = 0; m < 4; ++m) { const int row = u.pm * BM + ai * HALF + wr * 64 + m * 16 + fr; const float s = row_rstd(ssp2, row); float ss = 0.f;
#pragma unroll
                for (int bj = 0; bj < 2; ++bj) { const size_t off = (size_t)row * DM + col0 + bj * HALF;
                    const h16x8 hb = *(const h16x8*)(h2 + off), pb = *(const h16x8*)(pp + off); float v[8];
#pragma unroll
                    for (int e = 0; e < 8; ++e) { v[e] = (float)hb[e] + fast_sigmoid(acc[ai][bj][m][e >> 2][e & 3] * s) * (float)pb[e]; ss += v[e] * v[e]; }
                    u32x4 w; w.x = pkh(v[0], v[1]); w.y = pkh(v[2], v[3]); w.z = pkh(v[4], v[5]); w.w = pkh(v[6], v[7]); *(u32x4*)(out + off) = w; }
                ss += __shfl_xor(ss, 16); ss += __shfl_xor(ss, 32);
                if (fq == 0) ssp3[(size_t)row * 16 + u.pn * 4 + wc] = ss; }
    }
};
}

template <class ColMap>
__device__ __forceinline__ void transpose_items(int K, int Nsrc, h16* WT, int Nrows, ColMap cm, const float* __restrict__ kscale, LAS float* scr, int gw, int NGW, int lane) {
    const int nblk = Nrows / 32, items = (K / 64) * nblk;
    for (int it = gw; it < items; it += NGW) {
        const int kb = it / nblk, nb = it % nblk, k0 = 64 * kb, n0 = 32 * nb;
        const float* src = cm(n0 + (lane & 31));
#pragma unroll 8
        for (int i = 0; i < 32; ++i) { const int kk = 2 * i + (lane >> 5); float v = 0.f;
            if (src) { v = src[(size_t)(k0 + kk) * Nsrc]; if (kscale) v *= kscale[k0 + kk]; }
            scr[kk * 33 + (lane & 31)] = v; }
        asm volatile("s_waitcnt lgkmcnt(0)" ::: "memory");
        const int c = lane & 7;
#pragma unroll
        for (int j = 0; j < 4; ++j) { const int n = (lane >> 3) + 8 * j; const LAS float* s = scr + (8 * c) * 33 + n;
            u32x4 o; o.x = pkh(s[0 * 33], s[1 * 33]); o.y = pkh(s[2 * 33], s[3 * 33]); o.z = pkh(s[4 * 33], s[5 * 33]); o.w = pkh(s[6 * 33], s[7 * 33]);
            *(u32x4*)(WT + (size_t)(n0 + n) * K + k0 + 8 * c) = o; }
        asm volatile("s_waitcnt lgkmcnt(0)" ::: "memory");
    }
}
__device__ __forceinline__ int win_colmap(int np) {
    const int pn = np >> 8, p = np & 255, bj = p >> 7, wc = (p >> 5) & 3, r = p & 31;
    const int LC = 256 * pn + 64 * wc + 32 * bj + r;
    if (LC < 512) return LC;
    if (LC < 576) return LC;
    if (LC < 640) return LC;
    if (LC < 704) return 896 + (LC - 640);
    if (LC < 708) return 960 + (LC - 704);
    if (LC < 768) return -1;
    if (LC < 1024) return 640 + (LC - 768);
    if (LC < 1536) return 964 + (LC - 1024);
    if (LC < 2048) return 1476 + (LC - 1536);
    return 1988 + (LC - 2048);
}

constexpr int DSA_LDS_RED = 0  , DSA_LDS_FRED = 1024  , DSA_LDS_META = 2048  , DSA_LDS_LIST = 2304  , DSA_LDS_VBUF = 10496  ,
              DSA_LDS_QF = 84224  , DSA_LDS_BUF = 92416  , DSA_LDS_CANDB = 133376  , DSA_LDS_TRASH = 137472  ;
constexpr int DSA_CAP = 64, DSA_BUFN = 320;
constexpr float ZEPS = 0x1p-120f;
constexpr int VROW = 144;

struct AttnPtrs { const h16 *QA, *KA, *VA, *QI, *KI, *QB, *KB, *VB; const float* WI; const float* kmp; h16* Y; };

__device__ __forceinline__ void cnt_ge(int& c, float s, float tau) { asm volatile("v_cmp_ge_f32 vcc, %1, %2\n\tv_addc_co_u32 %0, vcc, 0, %0, vcc" : "+v"(c) : "v"(s), "v"(tau) : "vcc"); }
__device__ __forceinline__ void cnt_gt(int& c, float s, float tau) { asm volatile("v_cmp_gt_f32 vcc, %1, %2\n\tv_addc_co_u32 %0, vcc, 0, %0, vcc" : "+v"(c) : "v"(s), "v"(tau) : "vcc"); }
__device__ __forceinline__ void cnt_tie(int& c, float s, float t3, int key, int im) { unsigned long long tmp;
    asm volatile("v_cmp_eq_f32 vcc, %2, %3\n\tv_cmp_le_i32 %1, %4, %5\n\ts_and_b64 vcc, vcc, %1\n\tv_addc_co_u32 %0, vcc, 0, %0, vcc" : "+v"(c), "=&s"(tmp) : "v"(s), "v"(t3), "v"(key), "v"(im) : "vcc"); }
__device__ __forceinline__ int dsa_count_ge(const f32x4 (&S)[8][4], int nch, float tau) {
    int c = 0;
#pragma unroll
    for (int ch = 0; ch < 8; ++ch) if (ch < nch) {
#pragma unroll
        for (int tt = 0; tt < 4; ++tt)
#pragma unroll
            for (int i = 0; i < 4; ++i) cnt_ge(c, S[ch][tt][i], tau);
    }
    return c;
}
__device__ __forceinline__ int dsa_total(int c, LAS unsigned* red, int par, int wid, int q16, int g) {
    c += __shfl_xor(c, 16); c += __shfl_xor(c, 32);
    if (g == 0) red[(par * 8 + wid) * 16 + q16] = (unsigned)c;
    __syncthreads();
    int t = 0;
#pragma unroll
    for (int w = 0; w < 8; ++w) t += (int)red[(par * 8 + w) * 16 + q16];
    return t;
}

__device__ __forceinline__ void dsa_unit(LAS unsigned char* lds, const AttnPtrs& P, int b, int qt, const int wid) {
    const int lane = lane_id_fresh(), tid = wid * 64 + lane, q16 = lane & 15, g = lane >> 4;
    LAS unsigned* red = (LAS unsigned*)(lds + DSA_LDS_RED); LAS float* fred = (LAS float*)(lds + DSA_LDS_FRED);
    LAS unsigned short* list = (LAS unsigned short*)(lds + DSA_LDS_LIST);
    const int t0 = qt * 16, myq = t0 + q16; const size_t brow = (size_t)b * SEQ;
    const int nch = (t0 + 15) / 512 + 1;
    f32x4 S[8][4];
#pragma unroll
    for (int ch = 0; ch < 8; ++ch)
#pragma unroll
        for (int tt = 0; tt < 4; ++tt) S[ch][tt] = (f32x4){NEG_INF, NEG_INF, NEG_INF, NEG_INF};
    float smax = NEG_INF, smin = -NEG_INF; int nvl = 0;
    {
        h16x8 qf[4][2];
#pragma unroll
        for (int h = 0; h < 4; ++h)
#pragma unroll
            for (int ks = 0; ks < 2; ++ks) qf[h][ks] = *(const h16x8*)(P.QI + (brow + myq) * 256 + h * 64 + ks * 32 + g * 8);
        const f32x4 wv = *(const f32x4*)(P.WI + (brow + myq) * 4);
        h16x8 pa[2][2];
#pragma unroll
        for (int u = 0; u < 2; ++u) { pa[u][0] = *(const h16x8*)(P.KI + (brow + 64 * wid + 16 * u + q16) * 64 + g * 8); pa[u][1] = *(const h16x8*)(P.KI + (brow + 64 * wid + 16 * u + q16) * 64 + 32 + g * 8); }
#pragma unroll
        for (int ch = 0; ch < 8; ++ch) if (ch < nch) {
#pragma unroll
            for (int tp = 0; tp < 2; ++tp) {
                h16x8 a[2][2];
#pragma unroll
                for (int u = 0; u < 2; ++u) { a[u][0] = pa[u][0]; a[u][1] = pa[u][1]; }
                { const int nidx = ch * 2 + tp + 1; int kn = 512 * (nidx >> 1) + 64 * wid + 32 * (nidx & 1); kn = kn < SEQ - 32 ? kn : SEQ - 32;
#pragma unroll
                  for (int u = 0; u < 2; ++u) { pa[u][0] = *(const h16x8*)(P.KI + (brow + kn + 16 * u + q16) * 64 + g * 8); pa[u][1] = *(const h16x8*)(P.KI + (brow + kn + 16 * u + q16) * 64 + 32 + g * 8); } }
#pragma unroll
                for (int u = 0; u < 2; ++u) {
                    const int tt = 2 * tp + u; const int kt = 512 * ch + 64 * wid + 16 * tt;
                    if (kt <= t0 + 15) {
                        f32x4 sc = {0.f, 0.f, 0.f, 0.f};
#pragma unroll
                        for (int h = 0; h < 4; ++h) { f32x4 acc = {0.f, 0.f, 0.f, 0.f};
                            acc = __builtin_amdgcn_mfma_f32_16x16x32_f16(a[u][0], qf[h][0], acc, 0, 0, 0);
                            acc = __builtin_amdgcn_mfma_f32_16x16x32_f16(a[u][1], qf[h][1], acc, 0, 0, 0);
#pragma unroll
                            for (int i = 0; i < 4; ++i) sc[i] += wv[h] * __builtin_fmaxf(acc[i], 0.f); }
                        const int key0 = kt + 4 * g;
                        const float zb = -(float)(key0 + 1) * ZEPS;
#pragma unroll
                        for (int i = 0; i < 4; ++i) { const bool ok = (key0 + i) <= myq; float v = sc[i]; v = (v == 0.f) ? (zb - (float)i * ZEPS) : v; v = ok ? v : NEG_INF; sc[i] = v;
                            smax = __builtin_fmaxf(smax, v); smin = __builtin_fminf(smin, ok ? v : -NEG_INF); nvl += ok ? 1 : 0; }
                        S[ch][tt] = sc;
                    }
                }
                __builtin_amdgcn_sched_barrier(0);
            }
        }
    }
    smax = __builtin_fmaxf(smax, __shfl_xor(smax, 16)); smax = __builtin_fmaxf(smax, __shfl_xor(smax, 32));
    smin = __builtin_fminf(smin, __shfl_xor(smin, 16)); smin = __builtin_fminf(smin, __shfl_xor(smin, 32));
    if (g == 0) { fred[(wid * 16 + q16) * 2] = smax; fred[(wid * 16 + q16) * 2 + 1] = smin; }
    __syncthreads();
#pragma unroll
    for (int w = 0; w < 8; ++w) { smax = __builtin_fmaxf(smax, fred[(w * 16 + q16) * 2]); smin = __builtin_fminf(smin, fred[(w * 16 + q16) * 2 + 1]); }
    const int nv = myq + 1; int par = 0;
    float lo = smin, hi; int c_lo = nv, c_hi = 0, cl_lo = nvl, cl_hi = 0;
    { const unsigned mb = __float_as_uint(smax); hi = __uint_as_float(smax > 0.f ? mb + 1u : mb - 1u); }
    const float TZ = -4097.0f * ZEPS;
    bool done = false, ovf = false;
    if (nv <= 256) { hi = lo; c_hi = c_lo; cl_hi = cl_lo; done = true; }
    auto pick = [&](float l, float h) -> float { if (l < 0.f && h > 0.f) return 0.f; if (l < TZ && h > TZ) return TZ; return l + (h - l) * 0.5f; };
    while (__any(!done)) {
        const float tau = done ? -NEG_INF : pick(lo, hi);
        const int clp = dsa_count_ge(S, nch, tau);
        const int c = dsa_total(clp, red, par, wid, q16, g); par ^= 1;
        if (!done) {
            if (c >= 256) { lo = tau; c_lo = c; cl_lo = clp; } else { hi = tau; c_hi = c; cl_hi = clp; }
            if (c_lo == 256) { hi = lo; c_hi = c_lo; cl_hi = cl_lo; done = true; }
            else if (c_lo - c_hi <= DSA_CAP) done = true;
            else { const float nt = pick(lo, hi); if (!(nt > lo && nt < hi)) { done = true; ovf = true; } }
        }
    }
    const int kb0 = 64 * wid + 4 * g;
    int istar = 0x7fffffff;
    if (__any(ovf)) {
        const int R = 256 - c_hi; int ilo = -1, ihi = myq;
        while (__any(ovf && ihi - ilo > 1)) {
            const int im = ovf ? ((ilo + ihi) >> 1) : -1;
            int c = 0;
#pragma unroll
            for (int ch = 0; ch < 8; ++ch) if (ch < nch) {
#pragma unroll
                for (int tt = 0; tt < 4; ++tt)
#pragma unroll
                    for (int i = 0; i < 4; ++i) cnt_tie(c, S[ch][tt][i], lo, kb0, im - (512 * ch + 16 * tt + i));
            }
            c = dsa_total(c, red, par, wid, q16, g); par ^= 1;
            if (ovf && ihi - ilo > 1) { if (c >= R) ihi = im; else ilo = im; }
        }
        if (ovf) istar = ihi;
        int c = 0;
#pragma unroll
        for (int ch = 0; ch < 8; ++ch) if (ch < nch) {
#pragma unroll
            for (int tt = 0; tt < 4; ++tt)
#pragma unroll
                for (int i = 0; i < 4; ++i) { const float s = S[ch][tt][i]; const int key = kb0 + 512 * ch + 16 * tt + i; c += (s >= lo && (s >= hi || key <= istar)) ? 1 : 0; }
        }
        if (ovf) { cl_lo = c; c_lo = 256; c_hi = 256; hi = NEG_INF; }
    }
    unsigned nw;
    {
        const int p = cl_lo;
        const int u1 = __shfl_up(p, 16); const int s1 = p + (g >= 1 ? u1 : 0);
        const int u2 = __shfl_up(s1, 32); const int s2 = s1 + (g >= 2 ? u2 : 0);
        if (g == 3) red[(par * 8 + wid) * 16 + q16] = (unsigned)s2;
        __syncthreads();
        int bw = 0;
#pragma unroll
        for (int w = 0; w < 8; ++w) { const int t = (int)red[(par * 8 + w) * 16 + q16]; bw += (w < wid) ? t : 0; }
        par ^= 1;
        nw = (unsigned)(bw + s2 - p);
    }
    if (wid == 0 && g == 0) ((LAS u32x4*)(lds + DSA_LDS_META))[q16] = (u32x4){(unsigned)c_lo, (unsigned)c_hi, __float_as_uint(hi), 0u};
    {
        const unsigned bufq = (unsigned)(uintptr_t)(lds + DSA_LDS_BUF + q16 * (DSA_BUFN * 8)), trash = (unsigned)(uintptr_t)(lds + DSA_LDS_TRASH + tid * 8);
        if (!__any(ovf)) {
#pragma unroll
            for (int ch = 0; ch < 8; ++ch) if (ch < nch) {
#pragma unroll
                for (int tt = 0; tt < 4; ++tt)
#pragma unroll
                    for (int i = 0; i < 4; ++i) { const float s = S[ch][tt][i]; const int key = kb0 + 512 * ch + 16 * tt + i; unsigned a;
                        asm volatile("v_cmp_ge_f32 vcc, %2, %3\n\tv_lshl_add_u32 %0, %1, 3, %4\n\tv_cndmask_b32 %0, %5, %0, vcc\n\tv_addc_co_u32 %1, vcc, 0, %1, vcc\n\tds_write2_b32 %0, %2, %6 offset1:1"
                                     : "=&v"(a), "+v"(nw) : "v"(s), "v"(lo), "v"(bufq), "v"(trash), "v"(key) : "vcc", "memory"); }
            }
        } else {
#pragma unroll
            for (int ch = 0; ch < 8; ++ch) if (ch < nch) {
#pragma unroll
                for (int tt = 0; tt < 4; ++tt)
#pragma unroll
                    for (int i = 0; i < 4; ++i) { const float s = S[ch][tt][i]; const int key = kb0 + 512 * ch + 16 * tt + i;
                        const bool w = (s >= lo && (s >= hi || key <= istar));
                        const unsigned a = w ? (bufq + nw * 8u) : trash; nw += w ? 1u : 0u;
                        asm volatile("ds_write2_b32 %0, %1, %2 offset1:1" :: "v"(a), "v"(s), "v"(key) : "memory"); }
            }
        }
    }
    asm volatile("s_waitcnt lgkmcnt(0)" ::: "memory");
    __syncthreads();
#ifndef X_NOATT
    int lane_o = lane;
    {
    LAS unsigned char* vbuf = lds + DSA_LDS_VBUF + wid * (2 * 32 * VROW);
#pragma unroll 1
    for (int qq2 = 0; qq2 < 2 * REP_ATT; ++qq2) { const int qq = qq2 & 1;
        asm volatile("" : "+v"(lane_o));
        const int lane = lane_o, q16 = lane & 15, g = lane >> 4;
        const int ql = 2 * wid + qq; const int qpos = t0 + ql; const int n = (qpos + 1 < 256) ? qpos + 1 : 256;
        LAS unsigned short* ql_list = list + ql * 256;
        {
            const u32x4 mt = ((const LAS u32x4*)(lds + DSA_LDS_META))[ql];
            const int n_e = (int)mt.x, chi = (int)mt.y; const float hiv = __uint_as_float(mt.z); const int R = 256 - chi;
            const LAS u32x2* bq = (const LAS u32x2*)(lds + DSA_LDS_BUF) + ql * DSA_BUFN;
            LAS u32x2* cb = (LAS u32x2*)(lds + DSA_LDS_CANDB) + wid * 64;
            int base_s = 0, base_c = 0;
#pragma unroll
            for (int k = 0; k < 5; ++k) { const int e = lane + 64 * k; const bool valid = e < n_e; const u32x2 ent = bq[e];
                const float s = __uint_as_float(ent.x); const bool sure = valid && (s >= hiv), cand = valid && !(s >= hiv);
                const unsigned long long bs = __ballot(sure), bc = __ballot(cand);
                const int ps = base_s + (int)__builtin_amdgcn_mbcnt_hi((unsigned)(bs >> 32), __builtin_amdgcn_mbcnt_lo((unsigned)bs, 0u));
                const int pc = base_c + (int)__builtin_amdgcn_mbcnt_hi((unsigned)(bc >> 32), __builtin_amdgcn_mbcnt_lo((unsigned)bc, 0u));
                if (sure && ps < 256) ql_list[ps] = (unsigned short)ent.y;
                if (cand && pc < 64) cb[pc] = ent;
                base_s += __popcll(bs); base_c += __popcll(bc); }
            const int m = base_c < 64 ? base_c : 64;
            asm volatile("s_waitcnt lgkmcnt(0)" ::: "memory");
            u32x2 my = {0u, 0u}; if (lane < m) my = cb[lane];
            const float mys = __uint_as_float(my.x); int rank = 0;
#pragma unroll 4
            for (int jx = 0; jx < m; ++jx) { const u32x2 o = cb[jx]; const float os = __uint_as_float(o.x); rank += (os > mys || (os == mys && o.y < my.y)) ? 1 : 0; }
            if (lane < m && rank < R && chi + rank < 256) ql_list[chi + rank] = (unsigned short)my.y;
            asm volatile("s_waitcnt lgkmcnt(0)" ::: "memory");
        }
        const int head = q16 & 7;
        h16x8 qf[2];
#pragma unroll
        for (int ks = 0; ks < 2; ++ks) qf[ks] = *(const h16x8*)(P.QA + (brow + qpos) * 512 + head * 64 + ks * 32 + g * 8);
        f32x4 L[16];
        {
            h16x8 ka[2][4][2];
#pragma unroll
            for (int u = 0; u < 4; ++u) { const int e = 16 * u + q16; const int kraw = (int)ql_list[e]; const int key = (e < n) ? kraw : 0;
                ka[0][u][0] = *(const h16x8*)(P.KA + (brow + key) * 64 + g * 8); ka[0][u][1] = *(const h16x8*)(P.KA + (brow + key) * 64 + 32 + g * 8); }
#pragma unroll
            for (int gi = 0; gi < 4; ++gi) {
                if (gi < 3) {
#pragma unroll
                    for (int u = 0; u < 4; ++u) { const int e = 16 * (4 * (gi + 1) + u) + q16; const int kraw = (int)ql_list[e]; const int key = (e < n) ? kraw : 0;
                        ka[(gi + 1) & 1][u][0] = *(const h16x8*)(P.KA + (brow + key) * 64 + g * 8); ka[(gi + 1) & 1][u][1] = *(const h16x8*)(P.KA + (brow + key) * 64 + 32 + g * 8); }
                }
#pragma unroll
                for (int u = 0; u < 4; ++u) { const int T = 4 * gi + u;
                    f32x4 acc = {0.f, 0.f, 0.f, 0.f};
                    acc = __builtin_amdgcn_mfma_f32_16x16x32_f16(ka[gi & 1][u][0], qf[0], acc, 0, 0, 0);
                    acc = __builtin_amdgcn_mfma_f32_16x16x32_f16(ka[gi & 1][u][1], qf[1], acc, 0, 0, 0);
#pragma unroll
                    for (int i = 0; i < 4; ++i) if (16 * T + 4 * g + i >= n) acc[i] = NEG_INF;
                    L[T] = acc; }
                __builtin_amdgcn_sched_barrier(0);
            }
        }
        u32x4 vreg[2][4];
#pragma unroll
        for (int c2 = 0; c2 < 2; ++c2)
#pragma unroll
            for (int i = 0; i < 4; ++i) { const int j = lane >> 3; const int e = 16 * (2 * c2 + (j >> 2)) + 4 * i + (j & 3); const int kraw = (int)ql_list[e]; const int key = (e < n) ? kraw : 0;
                vreg[c2][i] = *(const u32x4*)(P.VA + (brow + key) * 64 + 8 * (lane & 7)); }
        __builtin_amdgcn_sched_barrier(0);
        float mx = NEG_INF;
#pragma unroll
        for (int T = 0; T < 16; ++T)
#pragma unroll
            for (int i = 0; i < 4; ++i) mx = __builtin_fmaxf(mx, L[T][i]);
        mx = __builtin_fmaxf(mx, __shfl_xor(mx, 16)); mx = __builtin_fmaxf(mx, __shfl_xor(mx, 32));
        float lsum = 0.f;
#pragma unroll
        for (int T = 0; T < 16; ++T)
#pragma unroll
            for (int i = 0; i < 4; ++i) { const float p = __builtin_amdgcn_exp2f(L[T][i] - mx); L[T][i] = p; lsum += p; }
        lsum += __shfl_xor(lsum, 16); lsum += __shfl_xor(lsum, 32);
        __builtin_amdgcn_sched_barrier(0);
        f32x4 O[4];
#pragma unroll
        for (int db = 0; db < 4; ++db) O[db] = (f32x4){0.f, 0.f, 0.f, 0.f};
#pragma unroll
        for (int cc = 0; cc < 8; ++cc) {
            LAS unsigned char* vb = vbuf + (cc & 1) * (32 * VROW);
#pragma unroll
            for (int i = 0; i < 4; ++i) *(LAS u32x4*)(vb + (8 * i + (lane >> 3)) * VROW + 16 * (lane & 7)) = vreg[cc & 1][i];
            if (cc < 6) {
#pragma unroll
                for (int i = 0; i < 4; ++i) { const int j = lane >> 3; const int e = 16 * (2 * (cc + 2) + (j >> 2)) + 4 * i + (j & 3); const int kraw = (int)ql_list[e]; const int key = (e < n) ? kraw : 0;
                    vreg[cc & 1][i] = *(const u32x4*)(P.VA + (brow + key) * 64 + 8 * (lane & 7)); }
            }
            asm volatile("s_waitcnt lgkmcnt(0)" ::: "memory");
            h16x8 pa;
#pragma unroll
            for (int i = 0; i < 4; ++i) { pa[i] = (h16)L[2 * cc][i]; pa[4 + i] = (h16)L[2 * cc + 1][i]; }
#pragma unroll
            for (int db = 0; db < 4; ++db) {
                const LAS unsigned char* pb = vb + (8 * g + ((lane & 15) >> 2)) * VROW + (16 * db + 4 * (lane & 3)) * 2;
                const s16x4 lo4 = __builtin_amdgcn_ds_read_tr16_b64_v4i16((LAS s16x4*)pb);
                const s16x4 hi4 = __builtin_amdgcn_ds_read_tr16_b64_v4i16((LAS s16x4*)(pb + 4 * VROW));
                const s16x8 bf = {lo4[0], lo4[1], lo4[2], lo4[3], hi4[0], hi4[1], hi4[2], hi4[3]};
                O[db] = __builtin_amdgcn_mfma_f32_16x16x32_f16(pa, __builtin_bit_cast(h16x8, bf), O[db], 0, 0, 0);
            }
            __builtin_amdgcn_sched_barrier(0);
        }
#pragma unroll
        for (int i = 0; i < 4; ++i) { const float lh = __shfl(lsum, (4 * g + i) & 7); const float rl = 1.0f / lh;
            if (g < 2) {
#pragma unroll
                for (int db = 0; db < 4; ++db) P.Y[(brow + qpos) * DM + (4 * g + i) * 64 + 16 * db + q16] = (h16)(O[db][i] * rl); } }
    }
    }
#endif
    __syncthreads();
}

constexpr int MB_LDS_KM = 0  , MB_LDS_KV = 4096  , MB_TILE = 64 * VROW;
__device__ __forceinline__ int crow(int r, int hi) { return (r & 3) + 8 * (r >> 2) + 4 * hi; }

__device__ __forceinline__ void moba_unit(LAS unsigned char* lds, const AttnPtrs& P, int b, int h, int j) {
    const int tid = threadIdx.x, lane = tid & 63, wid = __builtin_amdgcn_readfirstlane(tid >> 6), r32 = lane & 31, hi = lane >> 5;
    const size_t brow = (size_t)b * SEQ; const int q0 = 256 * j; const int qrel = 32 * wid + r32; const size_t qrow = brow + q0 + qrel;
    LAS float* km = (LAS float*)(lds + MB_LDS_KM);
    for (int i = tid; i < 16 * 64; i += 512) { const int n = i >> 6, d = i & 63; const size_t pm = (size_t)b * 16 + n;
        km[i] = (P.kmp[((pm * 2 + 0) * 8 + h) * 64 + d] + P.kmp[((pm * 2 + 1) * 8 + h) * 64 + d]) * (1.0f / 256.0f); }
    __syncthreads();
    h16x8 qf[4];
#pragma unroll
    for (int d0 = 0; d0 < 4; ++d0) qf[d0] = *(const h16x8*)(P.QB + qrow * 512 + h * 64 + d0 * 16 + hi * 8);
    unsigned selmask = 0u;
    {
        float gate[8];
#pragma unroll
        for (int nb = 0; nb < 8; ++nb) gate[nb] = 0.f;
#pragma unroll
        for (int c8 = 0; c8 < 8; ++c8) {
            const h16x8 qv = *(const h16x8*)(P.QB + qrow * 512 + h * 64 + c8 * 8);
#pragma unroll
            for (int nb = 0; nb < 8; ++nb) { const LAS float* kr = km + (8 * hi + nb) * 64 + c8 * 8;
#pragma unroll
                for (int e = 0; e < 8; ++e) gate[nb] += (float)qv[e] * kr[e]; }
        }
        float gall[16];
#pragma unroll
        for (int nb = 0; nb < 8; ++nb) { const float o = __shfl_xor(gate[nb], 32); gall[nb] = hi ? o : gate[nb]; gall[8 + nb] = hi ? gate[nb] : o; }
#pragma unroll
        for (int n = 0; n < 16; ++n) if (n >= j) gall[n] = NEG_INF;
#pragma unroll
        for (int pick = 0; pick < 3; ++pick) { float best = NEG_INF; int bi = -1;
#pragma unroll
            for (int n = 0; n < 16; ++n) if (gall[n] > best) { best = gall[n]; bi = n; }
            if (bi >= 0) { selmask |= 1u << bi;
#pragma unroll
                for (int n = 0; n < 16; ++n) if (n == bi) gall[n] = NEG_INF; } }
    }
    const int NT = 4 * (j + 1);
    const h16* Kg = P.KB + brow * 512 + h * 64; const h16* Vg = P.VB + brow * 512 + h * 64;
    const int lrow = tid >> 3, lch = tid & 7;
    auto tile_key0 = [&](int t) { return (t < 4) ? (q0 + 64 * t) : (64 * (t - 4)); };
    u32x4 kreg, vreg;
    { const int k0 = tile_key0(0); kreg = *(const u32x4*)(Kg + (size_t)(k0 + lrow) * 512 + lch * 8); vreg = *(const u32x4*)(Vg + (size_t)(k0 + lrow) * 512 + lch * 8); }
    { LAS unsigned char* kb = lds + MB_LDS_KV; *(LAS u32x4*)(kb + lrow * VROW + lch * 16) = kreg; *(LAS u32x4*)(kb + MB_TILE + lrow * VROW + lch * 16) = vreg; }
    __syncthreads();
    float mrun = NEG_INF, lrun = 0.f; f32x16 o[2]; o[0] = f32x16{}; o[1] = f32x16{};
#pragma unroll 1
    for (int t = 0; t < NT; ++t) {
        if (t + 1 < NT) { const int k0 = tile_key0(t + 1); kreg = *(const u32x4*)(Kg + (size_t)(k0 + lrow) * 512 + lch * 8); vreg = *(const u32x4*)(Vg + (size_t)(k0 + lrow) * 512 + lch * 8); }
        const LAS unsigned char* kb = lds + MB_LDS_KV + (t & 1) * (2 * MB_TILE); const LAS unsigned char* vb = kb + MB_TILE;
        bool active;
        if (t < 4) active = (64 * t) <= (32 * wid + 31);
        else active = __any((selmask >> ((t - 4) >> 2)) & 1u);
        if (active) {
            f32x16 p0 = f32x16{}, p1 = f32x16{};
#pragma unroll
            for (int d0 = 0; d0 < 4; ++d0) {
                const h16x8 k0f = *(const LAS h16x8*)(kb + r32 * VROW + (16 * d0 + 8 * hi) * 2);
                const h16x8 k1f = *(const LAS h16x8*)(kb + (32 + r32) * VROW + (16 * d0 + 8 * hi) * 2);
                p0 = __builtin_amdgcn_mfma_f32_32x32x16_f16(k0f, qf[d0], p0, 0, 0, 0);
                p1 = __builtin_amdgcn_mfma_f32_32x32x16_f16(k1f, qf[d0], p1, 0, 0, 0);
            }
            if (t < 4) {
#pragma unroll
                for (int r = 0; r < 16; ++r) { const int kv = 64 * t + crow(r, hi); if (kv > qrel) p0[r] = NEG_INF; if (kv + 32 > qrel) p1[r] = NEG_INF; }
            } else if (!((selmask >> ((t - 4) >> 2)) & 1u)) {
#pragma unroll
                for (int r = 0; r < 16; ++r) { p0[r] = NEG_INF; p1[r] = NEG_INF; }
            }
            float mt = NEG_INF;
#pragma unroll
            for (int r = 0; r < 16; ++r) mt = __builtin_fmaxf(mt, __builtin_fmaxf(p0[r], p1[r]));
            mt = __builtin_fmaxf(mt, __shfl_xor(mt, 32));
            const float mnew = __builtin_fmaxf(mrun, mt);
            const float alpha = (mnew == NEG_INF) ? 1.0f : __builtin_amdgcn_exp2f(mrun - mnew);
            const float msub = (mnew == NEG_INF) ? 0.f : mnew;
            float ps = 0.f;
#pragma unroll
            for (int r = 0; r < 16; ++r) { p0[r] = __builtin_amdgcn_exp2f(p0[r] - msub); p1[r] = __builtin_amdgcn_exp2f(p1[r] - msub); ps += p0[r] + p1[r]; }
            lrun = lrun * alpha + ps; mrun = mnew;
            if (__any(alpha != 1.0f)) {
#pragma unroll
                for (int r = 0; r < 16; ++r) { o[0][r] *= alpha; o[1][r] *= alpha; }
            }
#pragma unroll
            for (int kt = 0; kt < 2; ++kt)
#pragma unroll
                for (int s = 0; s < 2; ++s) {
                    h16x8 pb;
#pragma unroll
                    for (int e = 0; e < 8; ++e) pb[e] = (h16)(kt ? p1[8 * s + e] : p0[8 * s + e]);
#pragma unroll
                    for (int db = 0; db < 2; ++db) {
                        const LAS unsigned char* pa = vb + (32 * kt + 16 * s + 4 * hi + ((lane & 15) >> 2)) * VROW + (32 * db + 16 * ((lane >> 4) & 1) + 4 * (lane & 3)) * 2;
                        const s16x4 lo4 = __builtin_amdgcn_ds_read_tr16_b64_v4i16((LAS s16x4*)pa);
                        const s16x4 hi4 = __builtin_amdgcn_ds_read_tr16_b64_v4i16((LAS s16x4*)(pa + 8 * VROW));
                        const s16x8 af = {lo4[0], lo4[1], lo4[2], lo4[3], hi4[0], hi4[1], hi4[2], hi4[3]};
                        o[db] = __builtin_amdgcn_mfma_f32_32x32x16_f16(__builtin_bit_cast(h16x8, af), pb, o[db], 0, 0, 0);
                    }
                }
        }
        if (t + 1 < NT) { LAS unsigned char* nb = lds + MB_LDS_KV + ((t + 1) & 1) * (2 * MB_TILE); *(LAS u32x4*)(nb + lrow * VROW + lch * 16) = kreg; *(LAS u32x4*)(nb + MB_TILE + lrow * VROW + lch * 16) = vreg; }
        __syncthreads();
    }
    lrun += __shfl_xor(lrun, 32);
    const float rl = 1.0f / lrun;
    h16* yrow = P.Y + qrow * DM + 512 + h * 64;
#pragma unroll
    for (int db = 0; db < 2; ++db)
#pragma unroll
        for (int rg = 0; rg < 4; ++rg) { u32x2 w; w.x = pkh(o[db][4 * rg] * rl, o[db][4 * rg + 1] * rl); w.y = pkh(o[db][4 * rg + 2] * rl, o[db][4 * rg + 3] * rl);
            *(u32x2*)(yrow + 32 * db + 8 * rg + 4 * hi) = w; }
}


namespace moba_fast {
using bf16=_Float16;
using bf16x8=__attribute__((ext_vector_type(8)))short;
using s16x4=__attribute__((ext_vector_type(4)))short;
using f32x16=__attribute__((ext_vector_type(16)))float;
using u32x4=__attribute__((ext_vector_type(4)))unsigned;
constexpr int BATCH=8,NHEAD=8,SEQ=4096,D=64,DM=NHEAD*D,OPITCH=1024,OCOL=512;
constexpr int NW=8,QBLK=32,QB=QBLK*NW,KVBLK=64,NQB=SEQ/QB;
constexpr int ATTN_PITCH=DM, ATTN_UNIT_ROWS=QB;
__device__ __forceinline__ int crow(int r,int hi){return (r&3)+8*(r>>2)+4*hi;}
#define SBAR() __builtin_amdgcn_sched_barrier(0)
#define MFMAH(a,b,c) __builtin_amdgcn_mfma_f32_32x32x16_f16(__builtin_bit_cast(h16x8,(a)),__builtin_bit_cast(h16x8,(b)),(c),0,0,0)
__device__ __forceinline__ void cmask(f32x16&p0,f32x16&p1,int jb,int qrel,int hi){
  const float NEG=(-__builtin_huge_valf()); int kb=64*jb+4*hi;
  #pragma unroll
  for(int r=0;r<16;++r){int kv=kb+(r&3)+8*(r>>2); if(kv>qrel)p0[r]=NEG; if(kv+32>qrel)p1[r]=NEG;}
}

constexpr int NSLOT=3, SLOTB=8192;
constexpr int LDS_K=0, LDS_V=NSLOT*SLOTB, LDS_WS=2*NSLOT*SLOTB, LDS_OST=LDS_WS+NW*64*4, LDS_BYTES=LDS_OST+NW*4096;
constexpr float C2=0.125f*1.4426950408889634f;
__device__ __forceinline__ void glds16(const void*gsrc,unsigned lds_dst){unsigned keep;
  asm volatile("s_mov_b32 %0, m0\n\ts_mov_b32 m0, %2\n\ts_nop 0\n\tglobal_load_lds_dwordx4 %1, off\n\ts_mov_b32 m0, %0":"=&s"(keep):"v"(gsrc),"s"(lds_dst):"memory");}
__device__ __forceinline__ void glds16s(unsigned voff,const void*sbase,unsigned lds_dst){unsigned keep;
  asm volatile("s_mov_b32 %0, m0\n\ts_mov_b32 m0, %3\n\ts_nop 0\n\tglobal_load_lds_dwordx4 %1, %2\n\ts_mov_b32 m0, %0":"=&s"(keep):"v"(voff),"s"(sbase),"s"(lds_dst):"memory");}
__device__ __forceinline__ float max3f(float a,float b,float c){float r;asm("v_max3_f32 %0, %1, %2, %3":"=v"(r):"v"(a),"v"(b),"v"(c));return r;}
__device__ __forceinline__ float max2f(float a,float b){float r;asm("v_max_f32_e32 %0, %1, %2":"=v"(r):"v"(a),"v"(b));return r;}
__device__ __forceinline__ float fadd_s(float a,float b){float r;asm("v_add_f32_e32 %0, %1, %2":"=v"(r):"v"(a),"v"(b));return r;}
__device__ __forceinline__ float fsub_s(float a,float b){float r;asm("v_sub_f32_e32 %0, %1, %2":"=v"(r):"v"(a),"v"(b));return r;}
typedef float f32x2_t __attribute__((ext_vector_type(2))); typedef _Float16 bf16x2_t __attribute__((ext_vector_type(2)));
__device__ __forceinline__ unsigned cvtpk_s(float lo,float hi){f32x2_t v={lo,hi};bf16x2_t b=__builtin_convertvector(v,bf16x2_t);return __builtin_bit_cast(unsigned,b);}
#define WAIT_BAR(N) asm volatile("s_waitcnt vmcnt(" #N ") lgkmcnt(0)\n\ts_barrier":::"memory")

__device__ __forceinline__ void qkt(f32x16&p0,f32x16&p1,const char*Kslot,const bf16x8*qr,const f32x16&negm,int r32,int hi){
  const char*kb=Kslot+hi*1024+r32*16;
  #pragma unroll
  for(int d0=0;d0<4;++d0){
    const bf16x8 b0=*reinterpret_cast<const bf16x8*>(kb+d0*2048);
    const bf16x8 b1=*reinterpret_cast<const bf16x8*>(kb+d0*2048+512);
    if(d0==0){p0=MFMAH(b0,qr[0],negm);p1=MFMAH(b1,qr[0],negm);}
    else{p0=MFMAH(b0,qr[d0],p0);p1=MFMAH(b1,qr[d0],p1);}}
}
typedef __attribute__((address_space(3))) const char* lds_cptr;
typedef short v4i16_t __attribute__((ext_vector_type(4)));
__device__ __forceinline__ void kload8(bf16x8*kf,lds_cptr kp){
  kf[0]=*(const __attribute__((address_space(3))) bf16x8*)(kp);      kf[1]=*(const __attribute__((address_space(3))) bf16x8*)(kp+512);
  kf[2]=*(const __attribute__((address_space(3))) bf16x8*)(kp+2048); kf[3]=*(const __attribute__((address_space(3))) bf16x8*)(kp+2560);
  kf[4]=*(const __attribute__((address_space(3))) bf16x8*)(kp+4096); kf[5]=*(const __attribute__((address_space(3))) bf16x8*)(kp+4608);
  kf[6]=*(const __attribute__((address_space(3))) bf16x8*)(kp+6144); kf[7]=*(const __attribute__((address_space(3))) bf16x8*)(kp+6656);
}
__device__ __forceinline__ void kload2(bf16x8*kf,lds_cptr kp,int j){ kf[2*j]=*(const __attribute__((address_space(3))) bf16x8*)(kp+j*2048); kf[2*j+1]=*(const __attribute__((address_space(3))) bf16x8*)(kp+j*2048+512); }
__device__ __forceinline__ s16x4 vtr(lds_cptr p){ return __builtin_bit_cast(s16x4,__builtin_amdgcn_ds_read_tr16_b64_v4i16((__attribute__((address_space(3))) v4i16_t*)p)); }
__device__ __forceinline__ float rowmax(const f32x16&p0,const f32x16&p1){
  float a=max3f(p0[0],p0[1],p1[0]),b=max3f(p0[2],p0[3],p1[1]);a=max3f(a,p1[2],p1[3]);
  #pragma unroll
  for(int r=4;r<16;r+=4){a=max3f(a,p0[r],p0[r+1]);b=max3f(b,p0[r+2],p0[r+3]);a=max3f(a,p1[r],p1[r+1]);b=max3f(b,p1[r+2],p1[r+3]);}
  const float m=max2f(a,b);
  auto rr=__builtin_amdgcn_permlane32_swap(__float_as_uint(m),__float_as_uint(m),false,false);
  return max2f(__uint_as_float(rr[0]),__uint_as_float(rr[1]));
}
__device__ __forceinline__ void pv(f32x16*o,int vb,bf16x8 pa0,bf16x8 pa1,bf16x8 pa2,bf16x8 pa3){
  #pragma unroll
  for(int d0=0;d0<2;++d0){s16x4 lo[4],hi[4];
    #pragma unroll
    for(int ks=0;ks<4;++ks){
      asm volatile("ds_read_b64_tr_b16 %0,%1 offset:%c2":"=&v"(lo[ks]):"v"(vb),"i"(d0*4096+ks*1024):"memory");
      asm volatile("ds_read_b64_tr_b16 %0,%1 offset:%c2":"=&v"(hi[ks]):"v"(vb),"i"(d0*4096+ks*1024+512):"memory");}
    asm volatile("s_waitcnt lgkmcnt(0)":::"memory");SBAR();
    #define PK(k) (bf16x8){lo[k][0],lo[k][1],lo[k][2],lo[k][3],hi[k][0],hi[k][1],hi[k][2],hi[k][3]}
    o[d0]=MFMAH(pa0,PK(0),o[d0]);
    o[d0]=MFMAH(pa1,PK(1),o[d0]);
    o[d0]=MFMAH(pa2,PK(2),o[d0]);
    o[d0]=MFMAH(pa3,PK(3),o[d0]);
    #undef PK
  }
}

#ifndef ATTN_STORE16
#define ATTN_STORE16(p,v) (*(u32x4*)(p)=(v))
#endif
template<int THRL> __device__ __forceinline__ void attn_unit(int b,int h,int qb,const bf16*Q,const bf16*__restrict__ K,const bf16*__restrict__ V,bf16*O,char*shm,const unsigned selmask,const int wid_s){
  #define KT(t) (((t)<4)?(4*qb+(t)):((t)-4))
  const int lane=lane_id_fresh(),r32=lane&31,hi=lane>>5; const int wid=wid_s;
  const long rowbase=(long)b*SEQ; const int q0=qb*QB;
  const bf16*Qw=Q+(rowbase+q0+wid*QBLK)*DM+h*D;
  const bf16*Kh=K+rowbase*DM+h*D,*Vh=V+rowbase*DM+h*D;
  const unsigned lds0=(unsigned)(uintptr_t)shm;
  float*wsf=(float*)(shm+LDS_WS)+wid*64;
  const unsigned koff=(unsigned)((lane*DM+wid*8)*2);
  const unsigned voff=(unsigned)(((16*(wid&3)+(lane>>2))*DM+(wid>>2)*32+(lane&3)*8)*2);
  const unsigned kdst=lds0+LDS_K+wid*1024, vdst=lds0+LDS_V+wid*1024;
  #define DMA_K(t,slot) glds16s(koff,(const char*)Kh+(long)KT(t)*(KVBLK*DM*2),(unsigned)__builtin_amdgcn_readfirstlane(kdst+(slot)))
  #define DMA_V(t,slot) glds16s(voff,(const char*)Vh+(long)KT(t)*(KVBLK*DM*2),(unsigned)__builtin_amdgcn_readfirstlane(vdst+(slot)))
  const int vb0=(int)(lds0+LDS_V)+((lane>>4)&1)*32+(lane&3)*8+(4*hi+((lane&15)>>2))*64;
  const char*Kbase=shm+LDS_K; bf16x8 kf[8];
  const lds_cptr shm3=(lds_cptr)shm; const lds_cptr kp0=shm3+LDS_K+hi*1024+r32*16; const lds_cptr vp0=shm3+LDS_V+((lane>>4)&1)*32+(lane&3)*8+(4*hi+((lane&15)>>2))*64;
  const int NT=(q0+QB)/KVBLK;
  DMA_K(0,0);DMA_V(0,0);DMA_K(1,SLOTB);
  bf16x8 qr[4];
  #pragma unroll
  for(int d0=0;d0<4;++d0)qr[d0]=*reinterpret_cast<const bf16x8*>(&Qw[(long)r32*DM+d0*16+hi*8]);
  float mhat=0.f,l_reg=0.f;f32x16 o[2];o[0]=f32x16{};o[1]=f32x16{};const f32x16 negm=f32x16{}; float msub_=0.f;
  const int qrel=wid*QBLK+r32;
  #define CMASK(P0,P1,t) do{ if((t)<4)cmask(P0,P1,(t),qrel,hi); }while(0)
  bool resc=false;
  #define START(P0,P1) do{ const float rm=rowmax(P0,P1); resc=false; \
    { const float dl=rm; mhat=fadd_s(mhat,dl); \
      _Pragma("unroll") for(int r=0;r<16;++r){P0[r]=fsub_s(P0[r],dl);P1[r]=fsub_s(P1[r],dl);} \
      } \
    _Pragma("unroll") for(int r=0;r<16;++r)P0[r]=__builtin_amdgcn_exp2f(P0[r]); }while(0)
  #define RESC() do{ if(resc){ asm volatile("s_waitcnt lgkmcnt(0)":::"memory"); \
      _Pragma("unroll") for(int d_=0;d_<2;++d_) _Pragma("unroll") for(int r=0;r<16;++r)o[d_][r]*=wsf[crow(r,hi)]; } }while(0)
  f32x16 pA0,pA1,pB0,pB1;
  int sl_prev=0,sl_cur=0,sl_next=SLOTB;
  #define ROT() do{sl_prev=sl_cur;sl_cur=sl_next;sl_next=(sl_next==(NSLOT-1)*SLOTB)?0:sl_next+SLOTB;}while(0)
  DMA_K(2,2*SLOTB);
  WAIT_BAR(3);
  qkt(pA0,pA1,Kbase,qr,negm,r32,hi);asm volatile("s_nop 15\n\ts_nop 7":"+v"(pA0),"+v"(pA1));CMASK(pA0,pA1,0);
  START(pA0,pA1);
  _Pragma("unroll") for(int r=0;r<16;++r)pA1[r]=__builtin_amdgcn_exp2f(pA1[r]);
  WAIT_BAR(0);
  DMA_K(3,0);DMA_V(1,SLOTB);
  ROT();
  kload8(kf,kp0+sl_cur);
  WAIT_BAR(2);
  s16x4 vlo[8],vhi[8]; u32x4 pw0,pw1,pw2,pw3;
  #define PKW(P,B) cvtpk_s(P[B],P[B+1])
  #define PAF(k) __builtin_bit_cast(bf16x8,pw##k)
  #define VFR(i) (bf16x8){vlo[i][0],vlo[i][1],vlo[i][2],vlo[i][3],vhi[i][0],vhi[i][1],vhi[i][2],vhi[i][3]}
  #define PIN(x) asm volatile("":"+v"(x))
  #define MX3(a,b,c) __builtin_fmaxf(__builtin_fmaxf((a),(b)),(c))
  #define GAPA(MF,A0,A1,A2,A3,W0,W1,PW) do{ MF; sacc+=A0; sacc+=A1; sacc+=A2; sacc+=A3; PIN(sacc); W0; W1; PIN(PW); SBAR(); }while(0)
  #define EX(v) __builtin_amdgcn_exp2f((v)-msub_)
  #define GAPB(MF,X,B) do{ MF; X[B]=EX(X[B]); X[B+1]=EX(X[B+1]); X[B+2]=EX(X[B+2]); X[B+3]=EX(X[B+3]); PIN(X); SBAR(); }while(0)
  #define VRD(i) do{ vlo[i]=vtr(vp_+(((i)>>2)*4096+((i)&3)*1024)); vhi[i]=vtr(vp_+(((i)>>2)*4096+((i)&3)*1024+512)); }while(0)
  #define KRD(G,j) do{ if(G){ kload2(kf,kp0+sl_next,j); SBAR(); } }while(0)
  #define STEP(C0,C1,P0,P1,t,GK,GV,GL) do{ SBAR(); \
    const bool st_=((t)<4)||((selmask>>(((t)-4)>>2))&1u); \
    const lds_cptr vp_=vp0+sl_prev; \
    VRD(0); SBAR(); float sacc=(P0[0]+P0[1]); \
    GAPA(C0=MFMAH(kf[0],qr[0],(f32x16{})), P0[2],P0[3],P0[4],P0[5],     pw0[0]=PKW(P0,0), pw0[1]=PKW(P0,2), pw0); \
    VRD(4); SBAR(); GAPA(C1=MFMAH(kf[1],qr[0],(f32x16{})), P0[6],P0[7],P0[8],P0[9],     pw0[2]=PKW(P0,4), pw0[3]=PKW(P0,6), pw0); \
    VRD(1); SBAR(); GAPA(C0=MFMAH(kf[2],qr[1],C0),   P0[10],P0[11],P0[12],P0[13], pw1[0]=PKW(P0,8), pw1[1]=PKW(P0,10), pw1); \
    VRD(5); SBAR(); GAPA(C1=MFMAH(kf[3],qr[1],C1),   P0[14],P0[15],P1[0],P1[1],   pw1[2]=PKW(P0,12),pw1[3]=PKW(P0,14), pw1); \
    VRD(2); SBAR(); GAPA(C0=MFMAH(kf[4],qr[2],C0),   P1[2],P1[3],P1[4],P1[5],     pw2[0]=PKW(P1,0), pw2[1]=PKW(P1,2), pw2); \
    VRD(6); SBAR(); GAPA(C1=MFMAH(kf[5],qr[2],C1),   P1[6],P1[7],P1[8],P1[9],     pw2[2]=PKW(P1,4), pw2[3]=PKW(P1,6), pw2); \
    VRD(3); SBAR(); GAPA(C0=MFMAH(kf[6],qr[3],C0),   P1[10],P1[11],P1[12],P1[13], pw3[0]=PKW(P1,8), pw3[1]=PKW(P1,10), pw3); \
    VRD(7); SBAR(); GAPA(C1=MFMAH(kf[7],qr[3],C1),   P1[14],P1[15],0.f,0.f,       pw3[2]=PKW(P1,12),pw3[3]=PKW(P1,14), pw3); \
    l_reg+=sacc; \
    if(GK){DMA_K((t)+3,sl_cur);} if(GV){DMA_V((t)+1,sl_next);} \
    CMASK(C0,C1,t); \
    { float a=MX3(C0[0],C0[1],C1[0]),b=MX3(C0[2],C0[3],C1[1]); a=MX3(a,C1[2],C1[3]); \
      _Pragma("unroll") for(int r=4;r<16;r+=4){a=MX3(a,C0[r],C0[r+1]);b=MX3(b,C0[r+2],C0[r+3]);a=MX3(a,C1[r],C1[r+1]);b=MX3(b,C1[r+2],C1[r+3]);} \
      float rm=__builtin_fmaxf(a,b); { auto rr=__builtin_amdgcn_permlane32_swap(__float_as_uint(rm),__float_as_uint(rm),false,false); rm=__builtin_fmaxf(__uint_as_float(rr[0]),__uint_as_float(rr[1])); } \
      rm=st_?rm:(-__builtin_huge_valf()); const float rel_=rm-mhat; \
      resc=false; \
      if(__builtin_expect(__any(rel_>(float)THRL),0)){ const float dl=__builtin_fmaxf(rel_,0.f); mhat+=dl; \
        const float f=__builtin_amdgcn_exp2f(-dl); l_reg*=f; if(hi==0)wsf[r32]=f; resc=true; } } \
    msub_=st_?mhat:__builtin_huge_valf(); \
    SBAR(); \
    GAPB(o[0]=MFMAH(PAF(0),VFR(0),o[0]), C0,0); \
    GAPB(o[1]=MFMAH(PAF(0),VFR(4),o[1]), C0,4); \
    KRD(GL,0); GAPB(o[0]=MFMAH(PAF(1),VFR(1),o[0]), C0,8); \
    KRD(GL,1); GAPB(o[1]=MFMAH(PAF(1),VFR(5),o[1]), C0,12); \
    KRD(GL,2); GAPB(o[0]=MFMAH(PAF(2),VFR(2),o[0]), C1,0); \
    KRD(GL,3); GAPB(o[1]=MFMAH(PAF(2),VFR(6),o[1]), C1,4); \
    GAPB(o[0]=MFMAH(PAF(3),VFR(3),o[0]), C1,8); \
    GAPB(o[1]=MFMAH(PAF(3),VFR(7),o[1]), C1,12); \
    }while(0)
  int t=1;
  for(;t+5<NT;t+=2){
    STEP(pB0,pB1,pA0,pA1,t,true,true,true);     WAIT_BAR(2); RESC(); ROT();
    STEP(pA0,pA1,pB0,pB1,t+1,true,true,true);   WAIT_BAR(2); RESC(); ROT();
  }
  #define ENDW(tt) do{ if((tt)+3<NT){WAIT_BAR(2);} else if((tt)+2<NT){WAIT_BAR(1);} else {WAIT_BAR(0);} }while(0)
  for(;t+1<NT;t+=2){
    STEP(pB0,pB1,pA0,pA1,t,(t+3<NT),(t+1<NT),(t+1<NT));       ENDW(t);   RESC(); ROT();
    STEP(pA0,pA1,pB0,pB1,t+1,(t+4<NT),(t+2<NT),(t+2<NT));     ENDW(t+1); RESC(); ROT();
  }
  STEP(pB0,pB1,pA0,pA1,NT-1,false,false,false); RESC();
  { float sacc=pB0[0]+pB0[1]; _Pragma("unroll") for(int r=2;r<16;++r)sacc+=pB0[r]; _Pragma("unroll") for(int r=0;r<16;++r)sacc+=pB1[r]; l_reg+=sacc;
    pw0=(u32x4){PKW(pB0,0),PKW(pB0,2),PKW(pB0,4),PKW(pB0,6)};pw1=(u32x4){PKW(pB0,8),PKW(pB0,10),PKW(pB0,12),PKW(pB0,14)};pw2=(u32x4){PKW(pB1,0),PKW(pB1,2),PKW(pB1,4),PKW(pB1,6)};pw3=(u32x4){PKW(pB1,8),PKW(pB1,10),PKW(pB1,12),PKW(pB1,14)};
    SBAR(); pv(o,vb0+sl_cur,PAF(0),PAF(1),PAF(2),PAF(3)); }
  #undef PKW
  #undef PAF
  #undef VFR
  #undef PIN
  #undef MX3
  #undef GAPA
  #undef GAPB
  #undef EX
  #undef VRD
  #undef KRD
  #undef STEP
  #undef ENDW
  {auto rr=__builtin_amdgcn_permlane32_swap(__float_as_uint(l_reg),__float_as_uint(l_reg),false,false);l_reg=__uint_as_float(rr[0])+__uint_as_float(rr[1]);}
  if(hi==0)wsf[32+r32]=l_reg;asm volatile("s_waitcnt lgkmcnt(0)":::"memory");
  float rli[16];
  #pragma unroll
  for(int r=0;r<16;++r)rli[r]=__builtin_amdgcn_rcpf(wsf[32+crow(r,hi)]);
  bf16*Ow=O+(rowbase+q0+wid*QBLK)*OPITCH+OCOL+h*D;
  { bf16*stg=(bf16*)(shm+LDS_OST)+wid*2048;
    #pragma unroll
    for(int r=0;r<16;++r){const int orow=crow(r,hi);
      #pragma unroll
      for(int d0=0;d0<2;++d0)stg[orow*64+d0*32+r32]=(bf16)(o[d0][r]*rli[r]);}
    asm volatile("s_waitcnt lgkmcnt(0)":::"memory");
    #pragma unroll
    for(int i=0;i<4;++i){const int row=i*8+(lane>>3),ch=lane&7; const u32x4 v=*(const u32x4*)(stg+row*64+ch*8); ATTN_STORE16(Ow+(long)row*OPITCH+ch*8,v);} }
  asm volatile("s_waitcnt lgkmcnt(0)\n\ts_barrier":::"memory");
  #undef DMA_K
  #undef DMA_V
  #undef CMASK
  #undef START
  #undef RESC
  #undef ROT
}
constexpr int ATTN_LDS_BYTES=LDS_BYTES;
#undef KT
#undef MFMAH
#undef SBAR
#undef WAIT_BAR
}


constexpr int MBF_KM = 86016;
__device__ __forceinline__ void moba_unit_fast(char* lds_gen, LAS unsigned char* lds, const AttnPtrs& P, int b, int h, int j, const int wid) {
    const int lane = lane_id_fresh(), tid = wid * 64 + lane, r32 = lane & 31, hi = lane >> 5;
    const size_t qrow = (size_t)b * SEQ + 256 * j + 32 * wid + r32;
    LAS float* km = (LAS float*)(lds + MBF_KM);
    for (int i = tid; i < 16 * 64; i += 512) { const int n = i >> 6, d = i & 63; const size_t pm = (size_t)b * 16 + n;
        km[i] = (P.kmp[((pm * 2 + 0) * 8 + h) * 64 + d] + P.kmp[((pm * 2 + 1) * 8 + h) * 64 + d]) * (1.0f / 256.0f); }
    __syncthreads();
    unsigned selmask = 0u;
    {
        float gate[8];
#pragma unroll
        for (int nb = 0; nb < 8; ++nb) gate[nb] = 0.f;
#pragma unroll
        for (int c8 = 0; c8 < 8; ++c8) {
            const h16x8 qv = *(const h16x8*)(P.QB + qrow * 512 + h * 64 + c8 * 8);
#pragma unroll
            for (int nb = 0; nb < 8; ++nb) { const LAS float* kr = km + (8 * hi + nb) * 64 + c8 * 8;
#pragma unroll
                for (int e = 0; e < 8; ++e) gate[nb] += (float)qv[e] * kr[e]; }
        }
        float gall[16];
#pragma unroll
        for (int nb = 0; nb < 8; ++nb) { const float o = __shfl_xor(gate[nb], 32); gall[nb] = hi ? o : gate[nb]; gall[8 + nb] = hi ? gate[nb] : o; }
#pragma unroll
        for (int n = 0; n < 16; ++n) if (n >= j) gall[n] = NEG_INF;
#pragma unroll
        for (int pick = 0; pick < 3; ++pick) { float best = NEG_INF; int bi = -1;
#pragma unroll
            for (int n = 0; n < 16; ++n) if (gall[n] > best) { best = gall[n]; bi = n; }
            if (bi >= 0) { selmask |= 1u << bi;
#pragma unroll
                for (int n = 0; n < 16; ++n) if (n == bi) gall[n] = NEG_INF; } }
    }
    moba_fast::attn_unit<8>(b, h, j, (const _Float16*)P.QB, (const _Float16*)P.KB, (const _Float16*)P.VB, (_Float16*)P.Y, lds_gen, selmask, wid);
}

#define XB_TMO      128
#define XB_XCNT(j)  (256  + 64 * (j))
#define XB_XSUB(j)  (1280 + 64 * (j))
#define XB_XGEN(j)  (2304 + 64 * (j))
#define XB_TOP      3328
#define XB_TOPGEN   3392
#define XCD_BAR_WORDS 3456
#define XB_SPIN_CAP (1u << 22)
__device__ __forceinline__ unsigned xb_ld(unsigned* p)              { return __hip_atomic_load(p, __ATOMIC_RELAXED, __HIP_MEMORY_SCOPE_AGENT); }
__device__ __forceinline__ unsigned xb_add(unsigned* p, unsigned v) { return __hip_atomic_fetch_add(p, v, __ATOMIC_RELAXED, __HIP_MEMORY_SCOPE_AGENT); }
__device__ __forceinline__ unsigned xb_xcc_id() { return (unsigned)__builtin_amdgcn_s_getreg((3 << 11) | 20) & 0xFu; }
#define XB_SPIN(cond, bar) do { unsigned _sp = 0; while (cond) { __builtin_amdgcn_s_sleep(1); \
    if ((++_sp & 255u) == 0u) { if (xb_ld(&(bar)[XB_TMO])) break; if (_sp > XB_SPIN_CAP) { atomicAdd(&(bar)[XB_TMO], 1u); break; } } } } while (0)
struct XcdBarrier { unsigned* bar; unsigned x; volatile LAS unsigned* st; };
__device__ __forceinline__ XcdBarrier xcd_barrier_post(unsigned* bar, volatile LAS unsigned* st) {
    XcdBarrier b; b.bar = bar; b.x = xb_xcc_id(); b.st = st;
    if (threadIdx.x == 0) (void)xb_add(&bar[XB_XCNT(b.x)], 1u);
    return b;
}
__device__ __forceinline__ void xcd_barrier_complete(unsigned* bar, unsigned x, unsigned& nloc, unsigned& nx) {
    const unsigned G = gridDim.x * gridDim.y * gridDim.z;
    unsigned sum, cnt, mine, sp = 0u;
    for (;;) {
        sum = 0u; cnt = 0u; mine = 0u;
#pragma unroll
        for (unsigned j = 0; j < 16; ++j) { const unsigned c = xb_ld(&bar[XB_XCNT(j)]); sum += c; cnt += (c > 0u) ? 1u : 0u; mine = (j == x) ? c : mine; }
        if (sum == G) break;
        __builtin_amdgcn_s_sleep(1);
        if ((++sp & 255u) == 0u) { if (xb_ld(&bar[XB_TMO])) break; if (sp > XB_SPIN_CAP) { atomicAdd(&bar[XB_TMO], 1u); break; } }
    }
    nloc = mine > 0u ? mine : 1u; nx = cnt > 0u ? cnt : 1u;
}
__device__ __forceinline__ void xcd_barrier(const XcdBarrier& b) {
    asm volatile("s_waitcnt vmcnt(0)" ::: "memory");
    __syncthreads();
    if (threadIdx.x == 0) {
        unsigned* bar = b.bar;
        __builtin_amdgcn_s_waitcnt(0);
        unsigned nloc = b.st[0], nx = b.st[1];
        if (nloc == 0u) { xcd_barrier_complete(bar, b.x, nloc, nx); b.st[0] = nloc; b.st[1] = nx; }
        const unsigned old = xb_add(&bar[XB_XSUB(b.x)], 1u);
        const unsigned gen = old / nloc;
        if (old + 1u == (gen + 1u) * nloc) {
            __builtin_amdgcn_fence(__ATOMIC_RELEASE, "agent");
            asm volatile("s_waitcnt vmcnt(0)" ::: "memory");
            const unsigned og = xb_add(&bar[XB_TOP], 1u);
            const unsigned tg = og / nx;
            if (og + 1u == (tg + 1u) * nx) xb_add(&bar[XB_TOPGEN], 1u);
            else XB_SPIN(xb_ld(&bar[XB_TOPGEN]) == tg, bar);
            __builtin_amdgcn_fence(__ATOMIC_ACQUIRE, "agent");
            xb_add(&bar[XB_XGEN(b.x)], 1u);
            asm volatile("s_waitcnt vmcnt(0)" ::: "memory");
        } else {
            XB_SPIN(xb_ld(&bar[XB_XGEN(b.x)]) == gen, bar);
            __builtin_amdgcn_fence(__ATOMIC_ACQUIRE, "agent");
            asm volatile("s_waitcnt vmcnt(0)" ::: "memory");
        }
    }
    __syncthreads();
}

constexpr int LDS_BYTES = 147456;
struct Args { const float* in[14]; float* out; unsigned char* ws; int ph_lo, ph_hi; };

__global__ void __launch_bounds__(512, 2) hymba_fwd(Args args) {
    extern __shared__ __attribute__((aligned(16))) unsigned char lds_raw[];
    LAS unsigned char* lds = (LAS unsigned char*)lds_raw;
    cg::grid_group grid = cg::this_grid();
    const int tid = threadIdx.x, lane = tid & 63, wave = __builtin_amdgcn_readfirstlane(tid >> 6);
    const int G = gridDim.x, bx = blockIdx.x;
    unsigned char* ws = args.ws;
    const float* x = args.in[0]; const float* p_in = args.in[1]; const float* g_attn = args.in[2]; const float* w_in = args.in[3]; const float* g_idx = args.in[4];
    const float* w_out = args.in[5]; const float* g_ffn = args.in[6]; const float* w_gate = args.in[7]; const float* w_up = args.in[8]; const float* w_down = args.in[9];
    const float* g_ple = args.in[10]; const float* w_pg = args.in[11]; const float* w_pp = args.in[12]; const float* g_final = args.in[13];
    h16* Wt_in = (h16*)(ws + WS_WIN); h16* Wt_out = (h16*)(ws + WS_WOUT); h16* Wt_gu = (h16*)(ws + WS_WGU); h16* Wt_dn = (h16*)(ws + WS_WDN); h16* Wt_pg = (h16*)(ws + WS_WPG); h16* Wt_pp = (h16*)(ws + WS_WPP);
    float* rope = (float*)(ws + WS_ROPE); float* rs0 = (float*)(ws + WS_RS0); float* ssp1 = (float*)(ws + WS_SSP1); float* ssp2 = (float*)(ws + WS_SSP2); float* ssp3 = (float*)(ws + WS_SSP3);
    float* kmp = (float*)(ws + WS_KMP); float* WI = (float*)(ws + WS_WI);
    h16* PH = (h16*)(ws + WS_PH); h16* PP = (h16*)(ws + WS_PP); h16* XH = (h16*)(ws + WS_XH); h16* H1 = XH; h16* H3 = XH; h16* Y = (h16*)(ws + WS_Y); h16* H2 = Y;
    h16* QA = (h16*)(ws + WS_QA); h16* KA = (h16*)(ws + WS_KA); h16* VA = (h16*)(ws + WS_VA); h16* QI = (h16*)(ws + WS_QI); h16* KI = (h16*)(ws + WS_KI);
    h16* QB = (h16*)(ws + WS_QB); h16* KB = (h16*)(ws + WS_KB); h16* VB = (h16*)(ws + WS_VB); h16* ACT = (h16*)(ws + WS_ACT);
    const int lo = args.ph_lo, hi_ph = args.ph_hi;
#ifndef PH_MASK
#define PH_MASK 0xff
#endif
#define IN(k) (((PH_MASK >> (k)) & 1) && lo <= (k) && (k) < hi_ph)
    volatile LAS unsigned* MISC = (volatile LAS unsigned*)(lds + LDS_BYTES - 256);
    unsigned* barw = (unsigned*)(ws + 0);
    XcdBarrier xbar; xbar.bar = barw; xbar.x = 0; xbar.st = MISC;
#define SEAM(k) do { if (IN(k) && IN((k) + 1)) { if ((k) == 0) { grid.sync(); if (tid == 0) { MISC[0] = 0u; MISC[1] = 0u; } __syncthreads(); xbar = xcd_barrier_post(barw, MISC); } else xcd_barrier(xbar); } } while (0)

    if (IN(0)) for (int rep_ph = 0; rep_ph < 1 + (REPMASK & 1); ++rep_ph) {
        if (bx == 0) for (int i = tid; i < XCD_BAR_WORDS; i += 512) barw[i] = 0u;
        LAS float* scr = (LAS float*)(lds + wave * 16384);
        const int gw = bx * 8 + wave, NGW = G * 8;
        transpose_items(DM, NIN_SRC, Wt_in, NIN, [=](int np) -> const float* { const int c = win_colmap(np); return c >= 0 ? w_in + c : nullptr; }, g_attn, scr, gw, NGW, lane);
        transpose_items(DM, DM, Wt_out, DM, [=](int np) -> const float* { return w_out + np; }, nullptr, scr, gw, NGW, lane);
        transpose_items(DM, DFF, Wt_gu, 2 * DFF, [=](int np) -> const float* { const int p = np & 255, t = np >> 8; return (p < 128) ? (w_gate + t * 128 + p) : (w_up + t * 128 + p - 128); }, g_ffn, scr, gw, NGW, lane);
        transpose_items(DFF, DM, Wt_dn, DM, [=](int np) -> const float* { return w_down + np; }, nullptr, scr, gw, NGW, lane);
        transpose_items(DM, DM, Wt_pg, DM, [=](int np) -> const float* { return w_pg + np; }, g_ple, scr, gw, NGW, lane);
        transpose_items(DPLE, DM, Wt_pp, DM, [=](int np) -> const float* { return w_pp + np; }, nullptr, scr, gw, NGW, lane);
        for (int m0 = 2 * gw; m0 < NTOK; m0 += 2 * NGW) {
            f32x4 v[2][4]; float s[2];
#pragma unroll
            for (int r2 = 0; r2 < 2; ++r2) { const f32x4* xr = (const f32x4*)(x + (size_t)(m0 + r2) * DM) + lane;
#pragma unroll
                for (int jj = 0; jj < 4; ++jj) v[r2][jj] = __builtin_nontemporal_load(xr + 64 * jj); }
#pragma unroll
            for (int r2 = 0; r2 < 2; ++r2) { float t = 0.f;
#pragma unroll
                for (int jj = 0; jj < 4; ++jj) t += (v[r2][jj].x * v[r2][jj].x + v[r2][jj].y * v[r2][jj].y) + (v[r2][jj].z * v[r2][jj].z + v[r2][jj].w * v[r2][jj].w);
                s[r2] = wave_sum(t); }
#pragma unroll
            for (int r2 = 0; r2 < 2; ++r2) {
                if (lane == 0) rs0[m0 + r2] = 1.0f / sqrtf(s[r2] * (1.0f / DM) + EPS);
                u32x2* o8 = (u32x2*)(XH + (size_t)(m0 + r2) * DM) + lane;
#pragma unroll
                for (int jj = 0; jj < 4; ++jj) { u32x2 w; w.x = pkh(v[r2][jj].x, v[r2][jj].y); w.y = pkh(v[r2][jj].z, v[r2][jj].w); o8[64 * jj] = w; } }
        }
        for (int m0 = 4 * gw; m0 < NTOK; m0 += 4 * NGW) {
            f32x4 v[4];
#pragma unroll
            for (int r4 = 0; r4 < 4; ++r4) v[r4] = __builtin_nontemporal_load((const f32x4*)(p_in + (size_t)(m0 + r4) * DPLE) + lane);
#pragma unroll
            for (int r4 = 0; r4 < 4; ++r4) { u32x2 w; w.x = pkh(v[r4].x, v[r4].y); w.y = pkh(v[r4].z, v[r4].w); *((u32x2*)(PH + (size_t)(m0 + r4) * DPLE) + lane) = w; }
        }
        for (int i = bx * 512 + tid; i < SEQ * 32; i += G * 512) {
            const int pos = i >> 5, jx = i & 31;
            const float inv = ROPE_INV[jx];
            const float ang = (float)pos * inv;
            const double a = (double)ang; const double kq = __builtin_rint(a * 0.15915494309189535);
            double r = __builtin_fma(-kq, 6.283185307179586, a); r = __builtin_fma(-kq, 2.4492935982947064e-16, r);
            const double r2 = r * r; double sn = 0.0, cs = 0.0;
            double ts = 1.0, tc = 1.0;
#pragma unroll
            for (int n = 13; n >= 1; --n) { ts = 1.0 - ts * r2 / (double)((2 * n) * (2 * n + 1)); tc = 1.0 - tc * r2 / (double)((2 * n - 1) * (2 * n)); }
            sn = r * ts; cs = tc;
            rope[(size_t)i * 2] = (float)cs; rope[(size_t)i * 2 + 1] = (float)sn;
        }
    }
    SEAM(0);
    if (IN(1)) for (int rep_ph = 0; rep_ph < 1 + ((REPMASK >> 1) & 1); ++rep_ph) {
        { pg8::Gemm g{XH, Wt_in, NTOK, NIN, DM}; pg8::StaticOrder S; S.init(NTOK, NIN, G, bx);
          pg8::EpiInProj E{rs0, rope, g_idx, QA, KA, VA, QI, KI, QB, KB, VB, WI, kmp};
          pg8::gemm_phase(lds, g, S, E); }
        { pg8::Gemm g{PH, Wt_pp, NTOK, DM, DPLE}; pg8::StaticOrder S; S.init(NTOK, DM, G, bx);
          pg8::EpiPlain E{PP, DM};
          pg8::gemm_phase(lds, g, S, E); }
    }
    SEAM(1);
    if (IN(2)) {
        AttnPtrs P{QA, KA, VA, QI, KI, QB, KB, VB, WI, kmp, Y};
        const int b = bx & 7, r = bx >> 3;
        const int nr = G >> 3;
#ifndef NO_DSA
        for (int rep = 0; rep < REP_DSA; ++rep)
        for (int s = r; s < 128; s += nr) { dsa_unit(lds, P, b, s, wave); dsa_unit(lds, P, b, 255 - s, wave); }
#endif
#ifndef NO_MOBA
        for (int rep = 0; rep < REP_MOBA; ++rep)
        for (int uu = r; uu < 64; uu += nr) { const int h = uu >> 3, s = uu & 7; moba_unit_fast((char*)lds_raw, lds, P, b, h, s, wave); moba_unit_fast((char*)lds_raw, lds, P, b, h, 15 - s, wave); }
#endif
    }
    SEAM(2);
    if (IN(3)) for (int rep_ph = 0; rep_ph < 1 + ((REPMASK >> 3) & 1); ++rep_ph) {
        pg8::Gemm g{Y, Wt_out, NTOK, DM, DM}; pg8::StaticOrder S; S.init(NTOK, DM, G, bx);
        pg8::EpiRes<false> E{XH, H1, ssp1};
        pg8::gemm_phase(lds, g, S, E);
    }
    SEAM(3);
    if (IN(4)) for (int rep_ph = 0; rep_ph < 1 + ((REPMASK >> 4) & 1); ++rep_ph) {
        pg8::Gemm g{H1, Wt_gu, NTOK, 2 * DFF, DM}; pg8::StaticOrder S; S.init(NTOK, 2 * DFF, G, bx);
        pg8::EpiSwiGLU E{ssp1, ACT};
        pg8::gemm_phase(lds, g, S, E);
    }
    SEAM(4);
    if (IN(5)) for (int rep_ph = 0; rep_ph < 1 + ((REPMASK >> 5) & 1); ++rep_ph) {
        pg8::Gemm g{ACT, Wt_dn, NTOK, DM, DFF}; pg8::StaticOrder S; S.init(NTOK, DM, G, bx);
        pg8::EpiRes<false> E{H1, H2, ssp2};
        pg8::gemm_phase(lds, g, S, E);
    }
    SEAM(5);
    if (IN(6)) for (int rep_ph = 0; rep_ph < 1 + ((REPMASK >> 6) & 1); ++rep_ph) {
        pg8::Gemm g{H2, Wt_pg, NTOK, DM, DM}; pg8::StaticOrder S; S.init(NTOK, DM, G, bx);
        pg8::EpiPLE E{ssp2, H2, PP, H3, ssp3};
        pg8::gemm_phase(lds, g, S, E);
    }
    SEAM(6);
    if (IN(7)) {
        const int gw = bx * 8 + wave, NGW = G * 8;
        f32x4 gf[2][2];
#pragma unroll
        for (int hh = 0; hh < 2; ++hh) { gf[hh][0] = *(const f32x4*)(g_final + 512 * hh + 8 * lane); gf[hh][1] = *(const f32x4*)(g_final + 512 * hh + 8 * lane + 4); }
        for (int m = gw; m < NTOK; m += NGW) {
            const float s = pg8::row_rstd(ssp3, m);
#pragma unroll
            for (int hh = 0; hh < 2; ++hh) {
                const h16x8 hv = *(const h16x8*)(H3 + (size_t)m * DM + 512 * hh + 8 * lane);
                float* o = args.out + (size_t)m * DM + 512 * hh + 8 * lane;
                f32x4 v0 = {(float)hv[0], (float)hv[1], (float)hv[2], (float)hv[3]}, v1 = {(float)hv[4], (float)hv[5], (float)hv[6], (float)hv[7]};
                v0 = v0 * s * gf[hh][0]; v1 = v1 * s * gf[hh][1];
                *(f32x4*)o = v0; *(f32x4*)(o + 4) = v1;
            }
        }
    }
#undef IN
#undef SEAM
}

extern "C" void kernel_launch(void* const* d_in, const int* in_sizes, int n_in, void* d_out, int out_size, void* d_ws, size_t ws_size, hipStream_t stream) {
    static int grid = 0;
    if (grid == 0) {
        if (n_in != 14 || out_size != NTOK * DM || ws_size < WS_END) { fprintf(stderr, "kernel_launch: unexpected shapes (n_in %d out %d ws %zu)\n", n_in, out_size, ws_size); grid = -1; return; }
        int dev = 0, cus = 0, per_cu = 0;
        (void)hipGetDevice(&dev);
        (void)hipDeviceGetAttribute(&cus, hipDeviceAttributeMultiprocessorCount, dev);
        (void)hipFuncSetAttribute((const void*)hymba_fwd, hipFuncAttributeMaxDynamicSharedMemorySize, LDS_BYTES);
        (void)hipOccupancyMaxActiveBlocksPerMultiprocessor(&per_cu, (const void*)hymba_fwd, 512, LDS_BYTES);
        if (per_cu < 1) { fprintf(stderr, "kernel_launch: occupancy query says %d blocks/CU\n", per_cu); }
        grid = cus;
        if (grid % 8 != 0 || grid > 256) grid = (grid / 8) * 8 > 256 ? 256 : (grid / 8) * 8;
    }
    if (grid <= 0) return;
    Args a{};
    for (int i = 0; i < 14; ++i) a.in[i] = (const float*)d_in[i];
    a.out = (float*)d_out; a.ws = (unsigned char*)d_ws;
#if MK_COOP
    a.ph_lo = 0; a.ph_hi = 8;
    void* kargs[] = {&a};
    hipError_t e = hipLaunchCooperativeKernel((const void*)hymba_fwd, dim3(grid), dim3(512), kargs, LDS_BYTES, stream);
    if (e != hipSuccess) fprintf(stderr, "cooperative launch failed: %s (grid %d)\n", hipGetErrorString(e), grid);
#else
    for (int ph = 0; ph < 8; ++ph) { a.ph_lo = ph; a.ph_hi = ph + 1; hipLaunchKernelGGL(hymba_fwd, dim3(grid), dim3(512), LDS_BYTES, stream, a); }
#endif
}
```

```cpp
#include <hip/hip_runtime.h>
#include <hip/hip_cooperative_groups.h>
#include <cstdio>
#include <cstdint>
#include <cmath>
namespace cg = cooperative_groups;

#ifndef REP_DSA
#define REP_DSA 1
#endif
#ifndef REP_MOBA
#define REP_MOBA 1
#endif
#ifndef REP_ATT
#define REP_ATT 1
#endif
#ifndef REP_SC
#define REP_SC 1
#endif
#ifndef REP_SEL
#define REP_SEL 1
#endif
#ifndef REP_EM
#define REP_EM 1
#endif
#ifndef REPMASK
#define REPMASK 0
#endif
#ifndef REP_BIS
#define REP_BIS 1
#endif
#ifndef PROBE_MULT
#define PROBE_MULT 4
#endif
#ifndef MK_COOP
#define MK_COOP 1
#endif

#define LAS __attribute__((address_space(3)))
typedef _Float16 h16;
typedef _Float16 h16x8 __attribute__((ext_vector_type(8)));
typedef _Float16 h16x4 __attribute__((ext_vector_type(4)));
typedef _Float16 h16x2 __attribute__((ext_vector_type(2)));
typedef short s16x8 __attribute__((ext_vector_type(8)));
typedef short s16x4 __attribute__((ext_vector_type(4)));
typedef float f32x2 __attribute__((ext_vector_type(2)));
typedef float f32x4 __attribute__((ext_vector_type(4)));
typedef float f32x16 __attribute__((ext_vector_type(16)));
typedef unsigned u32x2 __attribute__((ext_vector_type(2)));
typedef unsigned u32x4 __attribute__((ext_vector_type(4)));

constexpr int BATCH = 8, SEQ = 4096, DM = 1024, NTOK = BATCH * SEQ, NIN = 2560, NIN_SRC = 2500, DFF = 2816, DPLE = 256;
constexpr float EPS = 1e-6f;
constexpr float C2 = 0.125f * 1.4426950408889634f;
constexpr float NEG_INF = -__builtin_huge_valf();

constexpr size_t MiB = 1u << 20;
constexpr size_t WS_WIN = 1 * MiB, WS_WOUT = 6 * MiB, WS_WGU = 8 * MiB, WS_WDN = 19 * MiB, WS_WPG = 25 * MiB, WS_WPP = 27 * MiB;
constexpr size_t WS_ROPE = 28 * MiB, WS_RS0 = 29 * MiB, WS_SSP1 = 30 * MiB, WS_SSP2 = 32 * MiB, WS_SSP3 = 34 * MiB, WS_KMP = 36 * MiB, WS_WI = 37 * MiB;
constexpr size_t WS_PH = 38 * MiB, WS_PP = 54 * MiB, WS_XH = 118 * MiB  , WS_Y = 182 * MiB  ;
constexpr size_t WS_QA = 246 * MiB, WS_KA = 278 * MiB, WS_VA = 282 * MiB, WS_QI = 286 * MiB, WS_KI = 302 * MiB, WS_QB = 306 * MiB, WS_KB = 338 * MiB, WS_VB = 370 * MiB;
constexpr size_t WS_ACT = 246 * MiB  , WS_END = 422 * MiB;

__constant__ float ROPE_INV[32] = {0x1.0000000000000p+0f, 0x1.7ff2220000000p-1f, 0x1.1feb340000000p-1f, 0x1.afd1360000000p-2f, 0x1.43d1360000000p-2f, 0x1.e5a8480000000p-3f, 0x1.6c310e0000000p-3f, 0x1.111aee0000000p-3f,
    0x1.99999a0000000p-4f, 0x1.33281c0000000p-4f, 0x1.ccab860000000p-5f, 0x1.59742a0000000p-5f, 0x1.030dc40000000p-5f, 0x1.8486a00000000p-6f, 0x1.235a720000000p-6f, 0x1.b4f7e20000000p-7f,
    0x1.47ae140000000p-7f, 0x1.eb73600000000p-8f, 0x1.7089380000000p-8f, 0x1.145cee0000000p-8f, 0x1.9e7c6e0000000p-9f, 0x1.36d21a0000000p-9f, 0x1.d22a500000000p-10f, 0x1.5d931c0000000p-10f,
    0x1.0624de0000000p-10f, 0x1.8929180000000p-11f, 0x1.26d42c0000000p-11f, 0x1.ba2e4c0000000p-12f, 0x1.4b96be0000000p-12f, 0x1.f150280000000p-13f, 0x1.74eea60000000p-13f, 0x1.17a8e40000000p-13f};
__device__ __forceinline__ int lane_id_fresh() { int l; asm volatile("v_mbcnt_lo_u32_b32 %0, -1, 0\n\tv_mbcnt_hi_u32_b32 %0, -1, %0" : "=v"(l)); return l; }
__device__ __forceinline__ unsigned pkh(float lo, float hi) { h16x2 v = {(h16)lo, (h16)hi}; return __builtin_bit_cast(unsigned, v); }
__device__ __forceinline__ float wave_sum(float v) {
#pragma unroll
    for (int o = 1; o < 64; o <<= 1) v += __shfl_xor(v, o);
    return v;
}
__device__ __forceinline__ float fast_sigmoid(float x) { return __builtin_amdgcn_rcpf(1.0f + __builtin_amdgcn_exp2f(-1.4426950408889634f * x)); }

namespace pg8 {
constexpr int BM = 256, BK = 64, HALF = 128, HTB = HALF * BK * 2, STAGE_BYTES = 8 * HTB, NXCD = 8, WGM = 8;
__host__ __device__ __forceinline__ int lds_byte(int r, int c) { const int st = (r >> 4) * 2 + (c >> 5), rr = r & 15, cc = c & 31, ob = rr * 64 + cc * 2; return st * 1024 + (ob ^ (((ob >> 9) & 1) << 5)); }
__host__ __device__ __forceinline__ void stage_rc(int b, int& R, int& C) { const int st = b / 1024, sb = b % 1024, swz = sb ^ (((sb >> 9) & 1) << 5); R = (st >> 1) * 16 + swz / 64; C = (st & 1) * 32 + (swz % 64) / 2; }
__host__ __device__ __forceinline__ int perm32(int rho) { const int n = rho >> 4, i = rho & 15; return 8 * (i >> 2) + 4 * n + (i & 3); }
struct Unit { int pm, pn; };
struct Gemm { const h16* A; const h16* Bt; int M, N, K; };
struct StaticOrder {
    int nM, nN, nwg, G, c;
    __host__ __device__ void init(int M, int N, int G_, int c_) { nM = M / BM; nN = N / BM; nwg = nM * nN; G = G_; c = c_; }
    __host__ __device__ bool next(int i, Unit& u) const {
        const long L = (long)i * G + c; if (L >= nwg) return false;
        int wgid = (int)L; { const int q = nwg / NXCD, r = nwg % NXCD, xcd = wgid % NXCD, off = wgid / NXCD; wgid = (xcd < r ? xcd * (q + 1) : r * (q + 1) + (xcd - r) * q) + off; }
        const int nig = WGM * nN, gid = wgid / nig, fm = gid * WGM, gsz = (nM - fm) < WGM ? (nM - fm) : WGM;
        u.pm = fm + ((wgid % nig) % gsz); u.pn = (wgid % nig) / gsz; return true;
    }
};
template <class Epi>
__device__ __forceinline__ void gemm_phase(LAS unsigned char* lds, const Gemm g, const StaticOrder& S, const Epi& E) {
    const int tid = threadIdx.x, wid = __builtin_amdgcn_readfirstlane(tid >> 6), lane = tid & 63, wr = wid >> 2, wc = wid & 3, fr = lane & 15, fq = lane >> 4;
    const int K = g.K, nt = K / BK;
    unsigned voffA[2], voffB[2];
#pragma unroll
    for (int i = 0; i < 2; ++i) { int R, C; stage_rc(tid * 16 + i * 8192, R, C); const int Rb = (R & ~31) + perm32(R & 31);
        voffA[i] = (unsigned)(R * K + C) * 2u; voffB[i] = (unsigned)(Rb * K + C) * 2u; }
    const size_t kstep = (size_t)(BK * 2);
    const size_t hstep = (size_t)HALF * K * 2;
    const size_t tstep = 2 * hstep;
    const unsigned ldsw = (unsigned)wid * 1024u;
    const int aoff = lds_byte(wr * 64 + fr, fq * 8), boff = lds_byte(wc * 32 + fr, fq * 8);
#define PG8_SA(b, h) (((b) * 2 + (h)) * HTB)
#define PG8_SB(b, h) ((4 + (b) * 2 + (h)) * HTB)
#define PG8_STAGE(bufoff, gbase, voff) do { _Pragma("unroll") for (int _i = 0; _i < 2; ++_i) \
        __builtin_amdgcn_global_load_lds((const unsigned*)((const char*)(gbase) + (voff)[_i]), (LAS unsigned*)(lds + (bufoff) + ldsw + _i * 8192), 16, 0, 0); } while (0)
#define PG8_LDA(dst, b, h) do { _Pragma("unroll") for (int m = 0; m < 4; ++m) _Pragma("unroll") for (int k = 0; k < 2; ++k) dst[m][k] = *(const LAS s16x8*)(lds + PG8_SA(b, h) + aoff + m * 2048 + k * 1024); } while (0)
#define PG8_LDB(dst, b, h) do { _Pragma("unroll") for (int n = 0; n < 2; ++n) _Pragma("unroll") for (int k = 0; k < 2; ++k) dst[n][k] = *(const LAS s16x8*)(lds + PG8_SB(b, h) + boff + n * 2048 + k * 1024); } while (0)
#define PG8_MMA(ai, bj, At, Bt) do { __builtin_amdgcn_s_setprio(1); _Pragma("unroll") for (int m = 0; m < 4; ++m) _Pragma("unroll") for (int n = 0; n < 2; ++n) _Pragma("unroll") for (int k = 0; k < 2; ++k) \
        acc[ai][bj][m][n] = __builtin_amdgcn_mfma_f32_16x16x32_f16(__builtin_bit_cast(h16x8, Bt[n][k]), __builtin_bit_cast(h16x8, At[m][k]), acc[ai][bj][m][n], 0, 0, 0); __builtin_amdgcn_s_setprio(0); } while (0)
#define PG8_WAIT_V(n) asm volatile("s_waitcnt vmcnt(" #n ")" ::: "memory")
#define PG8_WAIT_L(n) asm volatile("s_waitcnt lgkmcnt(" #n ")" ::: "memory")
#define PG8_BAR __builtin_amdgcn_s_barrier()
#define PG8_SCHED __builtin_amdgcn_sched_barrier(0)
    Unit cur, nxt; int ui = 0;
    if (!S.next(0, cur)) return;
    f32x4 acc[2][2][4][2];
#pragma unroll
    for (int a = 0; a < 2; ++a)
#pragma unroll
        for (int b = 0; b < 2; ++b)
#pragma unroll
            for (int m = 0; m < 4; ++m)
#pragma unroll
                for (int n = 0; n < 2; ++n) acc[a][b][m][n] = (f32x4){0.f, 0.f, 0.f, 0.f};
    s16x8 At[4][2], B0[2][2], B1[2][2];
    const char* cA = (const char*)g.A + (size_t)cur.pm * tstep; const char* cB = (const char*)g.Bt + (size_t)cur.pn * tstep;
    PG8_STAGE(PG8_SB(0, 0), cB, voffB); PG8_STAGE(PG8_SB(0, 1), cB + hstep, voffB); PG8_STAGE(PG8_SA(0, 0), cA, voffA); PG8_STAGE(PG8_SA(0, 1), cA + hstep, voffA);
    if (wr == 1) PG8_BAR;
    PG8_WAIT_V(2); PG8_BAR;
    PG8_STAGE(PG8_SB(1, 0), cB + kstep, voffB); PG8_STAGE(PG8_SA(1, 0), cA + kstep, voffA); PG8_STAGE(PG8_SB(1, 1), cB + hstep + kstep, voffB);
    PG8_WAIT_V(6); PG8_BAR;
    for (;;) {
        const bool has_next = S.next(ui + 1, nxt);
        const char* nA = has_next ? (const char*)g.A + (size_t)nxt.pm * tstep : cA; const char* nB = has_next ? (const char*)g.Bt + (size_t)nxt.pn * tstep : cB;
#pragma unroll 1
        for (int t = 0; t < nt; t += 2) {
            const bool last = (t == nt - 2);
            const char* a1 = cA + (size_t)(t + 1) * kstep;
            const char* a2 = last ? nA : cA + (size_t)(t + 2) * kstep; const char* b2 = last ? nB : cB + (size_t)(t + 2) * kstep;
            const char* a3 = a2 + kstep; const char* b3 = b2 + kstep;
            PG8_LDB(B0, 0, 0); PG8_LDB(B1, 0, 1); PG8_SCHED; PG8_LDA(At, 0, 0); PG8_STAGE(PG8_SA(1, 1), a1 + hstep, voffA);
            PG8_WAIT_V(8); PG8_WAIT_L(0); PG8_BAR; PG8_MMA(0, 0, At, B0); PG8_MMA(0, 1, At, B1); PG8_BAR; PG8_SCHED;
            PG8_LDA(At, 0, 1); PG8_STAGE(PG8_SB(0, 0), b2, voffB); PG8_STAGE(PG8_SB(0, 1), b2 + hstep, voffB); PG8_STAGE(PG8_SA(0, 0), a2, voffA);
            PG8_WAIT_V(8); PG8_WAIT_L(0); PG8_BAR; PG8_MMA(1, 0, At, B0); PG8_MMA(1, 1, At, B1); PG8_BAR; PG8_SCHED;
            PG8_LDB(B0, 1, 0); PG8_LDB(B1, 1, 1); PG8_SCHED; PG8_LDA(At, 1, 0); PG8_STAGE(PG8_SA(0, 1), a2 + hstep, voffA);
            PG8_WAIT_V(8); PG8_WAIT_L(0); PG8_BAR; PG8_MMA(0, 0, At, B0); PG8_MMA(0, 1, At, B1); PG8_BAR; PG8_SCHED;
            PG8_LDA(At, 1, 1); PG8_STAGE(PG8_SB(1, 0), b3, voffB); PG8_STAGE(PG8_SB(1, 1), b3 + hstep, voffB); PG8_STAGE(PG8_SA(1, 0), a3, voffA);
            PG8_WAIT_V(8); PG8_WAIT_L(0); PG8_BAR; PG8_MMA(1, 0, At, B0); PG8_MMA(1, 1, At, B1); PG8_BAR; PG8_SCHED;
        }
        if (wr == 0) PG8_BAR;
        E(acc, cur, wr, wc, fr, fq);
        if (!has_next) break;
#pragma unroll
        for (int a = 0; a < 2; ++a)
#pragma unroll
            for (int b = 0; b < 2; ++b)
#pragma unroll
                for (int m = 0; m < 4; ++m)
#pragma unroll
                    for (int n = 0; n < 2; ++n) acc[a][b][m][n] = (f32x4){0.f, 0.f, 0.f, 0.f};
        cur = nxt; cA = nA; cB = nB; ++ui;
        if (wr == 1) PG8_BAR;
    }
    PG8_WAIT_V(0);
    PG8_BAR;
#undef PG8_SA
#undef PG8_SB
#undef PG8_STAGE
#undef PG8_LDA
#undef PG8_LDB
#undef PG8_MMA
#undef PG8_WAIT_V
#undef PG8_WAIT_L
#undef PG8_BAR
#undef PG8_SCHED
}

typedef const f32x4 (&AccRef)[2][2][4][2];

struct EpiPlain {
    h16* O; int ldc;
    __device__ __forceinline__ void operator()(AccRef acc, const Unit& u, int wr, int wc, int fr, int fq) const {
        const int row0 = u.pm * BM + wr * 64 + fr, col0 = u.pn * BM + wc * 32 + 8 * fq;
#pragma unroll
        for (int ai = 0; ai < 2; ++ai)
#pragma unroll
            for (int m = 0; m < 4; ++m) { h16* rowp = O + (size_t)(row0 + ai * HALF + m * 16) * ldc + col0;
#pragma unroll
                for (int bj = 0; bj < 2; ++bj) { const f32x4 v0 = acc[ai][bj][m][0], v1 = acc[ai][bj][m][1];
                    u32x4 w; w.x = pkh(v0[0], v0[1]); w.y = pkh(v0[2], v0[3]); w.z = pkh(v1[0], v1[1]); w.w = pkh(v1[2], v1[3]);
                    *(u32x4*)(rowp + bj * HALF) = w; } }
    }
};

struct EpiInProj {
    const float* rs0; const float* rope; const float* gidx;
    h16 *QA, *KA, *VA, *QI, *KI, *QB, *KB, *VB; float* WI; float* kmp;
    __device__ __forceinline__ void operator()(AccRef acc, const Unit& u, int wr, int wc, int fr_in, int fq_in) const {
        int fr = fr_in, fq = fq_in; asm volatile("" : "+v"(fr), "+v"(fq));
        const int pn = u.pn;
        int type = 0; h16* dst = VA; int pitch = 64, cb = 0; float scl = 1.f; bool iskb = false;
        if (pn < 2) { type = 1; dst = QA; pitch = 512; cb = 256 * pn + 64 * wc; scl = C2; }
        else if (pn == 2) { if (wc == 0) { type = 1; dst = KA; } else if (wc == 1) { type = 0; dst = VA; } else if (wc == 2) { type = 2; dst = KI; } else { type = 3; } }
        else if (pn == 3) { type = 1; dst = QI; pitch = 256; cb = 64 * wc; }
        else if (pn < 6) { type = 1; dst = QB; pitch = 512; cb = 256 * (pn - 4) + 64 * wc; scl = C2; }
        else if (pn < 8) { type = 1; dst = KB; pitch = 512; cb = 256 * (pn - 6) + 64 * wc; iskb = true; }
        else { type = 0; dst = VB; pitch = 512; cb = 256 * (pn - 8) + 64 * wc; }
        float ks[2][2][4];
#pragma unroll
        for (int bj = 0; bj < 2; ++bj)
#pragma unroll
            for (int n = 0; n < 2; ++n)
#pragma unroll
                for (int e = 0; e < 4; ++e) ks[bj][n][e] = 0.f;
        float gl[2][2][4];
        if (type == 2) {
#pragma unroll
            for (int bj = 0; bj < 2; ++bj)
#pragma unroll
                for (int n = 0; n < 2; ++n)
#pragma unroll
                    for (int e = 0; e < 4; ++e) gl[bj][n][e] = gidx[32 * bj + 8 * fq + 4 * n + e];
        }
#pragma unroll
        for (int ai = 0; ai < 2; ++ai)
#pragma unroll
            for (int m = 0; m < 4; ++m) {
                const int row = u.pm * BM + ai * HALF + wr * 64 + m * 16 + fr;
                const float s = rs0[row];
                float v[2][2][4];
#pragma unroll
                for (int bj = 0; bj < 2; ++bj)
#pragma unroll
                    for (int n = 0; n < 2; ++n)
#pragma unroll
                        for (int e = 0; e < 4; ++e) v[bj][n][e] = acc[ai][bj][m][n][e] * s;
                if (type == 3) {
                    if (fq == 0) *(f32x4*)(WI + (size_t)row * 4) = (f32x4){v[0][0][0] * 0.0625f, v[0][0][1] * 0.0625f, v[0][0][2] * 0.0625f, v[0][0][3] * 0.0625f};
                    continue;
                }
                if (type == 2) {
                    float sum = 0.f;
#pragma unroll
                    for (int bj = 0; bj < 2; ++bj)
#pragma unroll
                        for (int n = 0; n < 2; ++n)
#pragma unroll
                            for (int e = 0; e < 4; ++e) sum += v[bj][n][e];
                    sum += __shfl_xor(sum, 16); sum += __shfl_xor(sum, 32);
                    const float mean = sum * (1.f / 64.f); float q = 0.f;
#pragma unroll
                    for (int bj = 0; bj < 2; ++bj)
#pragma unroll
                        for (int n = 0; n < 2; ++n)
#pragma unroll
                            for (int e = 0; e < 4; ++e) { v[bj][n][e] -= mean; q += v[bj][n][e] * v[bj][n][e]; }
                    q += __shfl_xor(q, 16); q += __shfl_xor(q, 32);
                    const float rstd = 1.0f / sqrtf(q * (1.f / 64.f) + EPS);
#pragma unroll
                    for (int bj = 0; bj < 2; ++bj)
#pragma unroll
                        for (int n = 0; n < 2; ++n)
#pragma unroll
                            for (int e = 0; e < 4; ++e) v[bj][n][e] = v[bj][n][e] * rstd * gl[bj][n][e];
                }
                if (type >= 1) {
                    const int pos = row & (SEQ - 1);
                    const f32x4* cs = (const f32x4*)(rope + ((size_t)pos * 32 + 8 * fq) * 2);
#pragma unroll
                    for (int n = 0; n < 2; ++n) { const f32x4 c01 = cs[2 * n], c23 = cs[2 * n + 1];
                        const float cc[4] = {c01[0], c01[2], c23[0], c23[2]}, sn[4] = {c01[1], c01[3], c23[1], c23[3]};
#pragma unroll
                        for (int e = 0; e < 4; ++e) { const float lo = v[0][n][e], hi = v[1][n][e]; v[0][n][e] = lo * cc[e] - hi * sn[e]; v[1][n][e] = hi * cc[e] + lo * sn[e]; } }
                }
#pragma unroll
                for (int bj = 0; bj < 2; ++bj) {
#pragma unroll
                    for (int n = 0; n < 2; ++n)
#pragma unroll
                        for (int e = 0; e < 4; ++e) { v[bj][n][e] *= scl; ks[bj][n][e] += v[bj][n][e]; }
                    u32x4 w; w.x = pkh(v[bj][0][0], v[bj][0][1]); w.y = pkh(v[bj][0][2], v[bj][0][3]); w.z = pkh(v[bj][1][0], v[bj][1][1]); w.w = pkh(v[bj][1][2], v[bj][1][3]);
                    *(u32x4*)(dst + (size_t)row * pitch + cb + 32 * bj + 8 * fq) = w;
                }
                __builtin_amdgcn_sched_barrier(0);
            }
        if (iskb) {
#pragma unroll
            for (int bj = 0; bj < 2; ++bj)
#pragma unroll
                for (int n = 0; n < 2; ++n)
#pragma unroll
                    for (int e = 0; e < 4; ++e) { float t = ks[bj][n][e]; t += __shfl_xor(t, 1); t += __shfl_xor(t, 2); t += __shfl_xor(t, 4); t += __shfl_xor(t, 8); ks[bj][n][e] = t; }
            if (fr == 0) { const int head = 4 * (pn - 6) + wc; float* o = kmp + (((size_t)u.pm * 2 + wr) * 8 + head) * 64;
#pragma unroll
                for (int bj = 0; bj < 2; ++bj)
#pragma unroll
                    for (int n = 0; n < 2; ++n) *(f32x4*)(o + 32 * bj + 8 * fq + 4 * n) = (f32x4){ks[bj][n][0], ks[bj][n][1], ks[bj][n][2], ks[bj][n][3]}; }
        }
    }
};

template <bool BASE_F32> struct EpiRes {
    const void* base; h16* out; float* ssp;
    __device__ __forceinline__ void operator()(AccRef acc, const Unit& u, int wr, int wc, int fr, int fq) const {
        const int col0 = u.pn * BM + wc * 32 + 8 * fq;
#pragma unroll
        for (int ai = 0; ai < 2; ++ai)
#pragma unroll
            for (int m = 0; m < 4; ++m) { const int row = u.pm * BM + ai * HALF + wr * 64 + m * 16 + fr; float ss = 0.f;
#pragma unroll
                for (int bj = 0; bj < 2; ++bj) { const size_t off = (size_t)row * DM + col0 + bj * HALF; float b[8];
                    if (BASE_F32) { const f32x4 b0 = *(const f32x4*)((const float*)base + off), b1 = *(const f32x4*)((const float*)base + off + 4);
                        b[0] = b0[0]; b[1] = b0[1]; b[2] = b0[2]; b[3] = b0[3]; b[4] = b1[0]; b[5] = b1[1]; b[6] = b1[2]; b[7] = b1[3]; }
                    else { const h16x8 hb = *(const h16x8*)((const h16*)base + off);
#pragma unroll
                        for (int e = 0; e < 8; ++e) b[e] = (float)hb[e]; }
                    float v[8];
#pragma unroll
                    for (int e = 0; e < 8; ++e) { v[e] = b[e] + acc[ai][bj][m][e >> 2][e & 3]; ss += v[e] * v[e]; }
                    u32x4 w; w.x = pkh(v[0], v[1]); w.y = pkh(v[2], v[3]); w.z = pkh(v[4], v[5]); w.w = pkh(v[6], v[7]);
                    *(u32x4*)(out + off) = w; }
                ss += __shfl_xor(ss, 16); ss += __shfl_xor(ss, 32);
                if (fq == 0) ssp[(size_t)row * 16 + u.pn * 4 + wc] = ss; }
    }
};
__device__ __forceinline__ float row_rstd(const float* ssp, int row) {
    const f32x4* p = (const f32x4*)(ssp + (size_t)row * 16); const f32x4 a = p[0], b = p[1], c = p[2], d = p[3];
    const float s = ((a[0] + a[1]) + (a[2] + a[3])) + ((b[0] + b[1]) + (b[2] + b[3])) + ((c[0] + c[1]) + (c[2] + c[3])) + ((d[0] + d[1]) + (d[2] + d[3]));
    return 1.0f / sqrtf(s * (1.0f / DM) + EPS);
}
struct EpiSwiGLU {
    const float* ssp; h16* act;
    __device__ __forceinline__ void operator()(AccRef acc, const Unit& u, int wr, int wc, int fr, int fq) const {
        const int col0 = u.pn * HALF + wc * 32 + 8 * fq;
#pragma unroll
        for (int ai = 0; ai < 2; ++ai)
#pragma unroll
            for (int m = 0; m < 4; ++m) { const int row = u.pm * BM + ai * HALF + wr * 64 + m * 16 + fr; const float s = row_rstd(ssp, row); float v[8];
#pragma unroll
                for (int e = 0; e < 8; ++e) { const float gt = acc[ai][0][m][e >> 2][e & 3] * s, up = acc[ai][1][m][e >> 2][e & 3] * s; v[e] = gt * fast_sigmoid(gt) * up; }
                u32x4 w; w.x = pkh(v[0], v[1]); w.y = pkh(v[2], v[3]); w.z = pkh(v[4], v[5]); w.w = pkh(v[6], v[7]);
                *(u32x4*)(act + (size_t)row * DFF + col0) = w; }
    }
};
struct EpiPLE {
    const float* ssp2; const h16* h2; const h16* pp; h16* out; float* ssp3;
    __device__ __forceinline__ void operator()(AccRef acc, const Unit& u, int wr, int wc, int fr, int fq) const {
        const int col0 = u.pn * BM + wc * 32 + 8 * fq;
#pragma unroll
        for (int ai = 0; ai < 2; ++ai)
#pragma unroll
            for (int m = 0; m < 4; ++m) { const int row = u.pm * BM + ai * HALF + wr * 64 + m * 16 + fr; const float s = row_rstd(ssp2, row); float ss = 0.f;
#pragma unroll
                for (int bj = 0; bj < 2; ++bj) { const size_t off = (size_t)row * DM + col0 + bj * HALF;
                    const h16x8 hb = *(const h16x8*)(h2 + off), pb = *(const h16x8*)(pp + off); float v[8];
#pragma unroll
                    for (int e = 0; e < 8; ++e) { v[e] = (float)hb[e] + fast_sigmoid(acc[ai][bj][m][e >> 2][e & 3] * s) * (float)pb[e]; ss += v[e] * v[e]; }
                    u32x4 w; w.x = pkh(v[0], v[1]); w.y = pkh(v[2], v[3]); w.z = pkh(v[4], v[5]); w.w = pkh(v[6], v[7]); *(u32x4*)(out + off) = w; }
                ss += __shfl_xor(ss, 16); ss += __shfl_xor(ss, 32);
                if (fq == 0) ssp3[(size_t)row * 16 + u.pn * 4 + wc] = ss; }
    }
};
}

template <class ColMap>
__device__ __forceinline__ void transpose_items(int K, int Nsrc, h16* WT, int Nrows, ColMap cm, const float* __restrict__ kscale, LAS float* scr, int gw, int NGW, int lane) {
    const int nblk = Nrows / 32, items = (K / 64) * nblk;
    for (int it = gw; it < items; it += NGW) {
        const int kb = it / nblk, nb = it % nblk, k0 = 64 * kb, n0 = 32 * nb;
        const float* src = cm(n0 + 4 * (lane & 7));
        f32x4 v[8];
#pragma unroll
        for (int i = 0; i < 8; ++i) { v[i] = (f32x4){0.f, 0.f, 0.f, 0.f}; if (src) v[i] = __builtin_nontemporal_load((const f32x4*)(src + (size_t)(k0 + 8 * i + (lane >> 3)) * Nsrc)); }
        const int c = lane & 7;
        f32x4 sc0 = {1.f, 1.f, 1.f, 1.f}, sc1 = {1.f, 1.f, 1.f, 1.f};
        if (kscale) { sc0 = *(const f32x4*)(kscale + k0 + 8 * c); sc1 = *(const f32x4*)(kscale + k0 + 8 * c + 4); }
#pragma unroll
        for (int i = 0; i < 8; ++i) { LAS float* d = scr + (8 * i + (lane >> 3)) * 33 + 4 * (lane & 7); d[0] = v[i][0]; d[1] = v[i][1]; d[2] = v[i][2]; d[3] = v[i][3]; }
        asm volatile("s_waitcnt lgkmcnt(0)" ::: "memory");
#pragma unroll
        for (int j = 0; j < 4; ++j) { const int n = (lane >> 3) + 8 * j; const LAS float* s = scr + (8 * c) * 33 + n;
            u32x4 o; o.x = pkh(s[0 * 33] * sc0[0], s[1 * 33] * sc0[1]); o.y = pkh(s[2 * 33] * sc0[2], s[3 * 33] * sc0[3]); o.z = pkh(s[4 * 33] * sc1[0], s[5 * 33] * sc1[1]); o.w = pkh(s[6 * 33] * sc1[2], s[7 * 33] * sc1[3]);
            *(u32x4*)(WT + (size_t)(n0 + n) * K + k0 + 8 * c) = o; }
        asm volatile("s_waitcnt lgkmcnt(0)" ::: "memory");
    }
}
__device__ __forceinline__ int win_colmap(int np) {
    const int pn = np >> 8, p = np & 255, bj = p >> 7, wc = (p >> 5) & 3, r = p & 31;
    const int LC = 256 * pn + 64 * wc + 32 * bj + r;
    if (LC < 512) return LC;
    if (LC < 576) return LC;
    if (LC < 640) return LC;
    if (LC < 704) return 896 + (LC - 640);
    if (LC < 708) return 960 + (LC - 704);
    if (LC < 768) return -1;
    if (LC < 1024) return 640 + (LC - 768);
    if (LC < 1536) return 964 + (LC - 1024);
    if (LC < 2048) return 1476 + (LC - 1536);
    return 1988 + (LC - 2048);
}

constexpr int DSA_LDS_RED = 0  , DSA_LDS_FRED = 1024  , DSA_LDS_META = 2048  , DSA_LDS_LIST = 2304  , DSA_LDS_VBUF = 10496  ,
              DSA_LDS_QF = 84224  , DSA_LDS_BUF = 92416  , DSA_LDS_CANDB = 133376  , DSA_LDS_TRASH = 137472  ;
constexpr int DSA_CAP = 64, DSA_BUFN = 320;
constexpr float ZEPS = 0x1p-120f;
constexpr int VROW = 144;

struct AttnPtrs { const h16 *QA, *KA, *VA, *QI, *KI, *QB, *KB, *VB; const float* WI; const float* kmp; h16* Y; };

__device__ __forceinline__ void cnt_ge(int& c, float s, float tau) { asm volatile("v_cmp_ge_f32 vcc, %1, %2\n\tv_addc_co_u32 %0, vcc, 0, %0, vcc" : "+v"(c) : "v"(s), "v"(tau) : "vcc"); }
__device__ __forceinline__ void cnt_gt(int& c, float s, float tau) { asm volatile("v_cmp_gt_f32 vcc, %1, %2\n\tv_addc_co_u32 %0, vcc, 0, %0, vcc" : "+v"(c) : "v"(s), "v"(tau) : "vcc"); }
__device__ __forceinline__ void cnt_tie(int& c, float s, float t3, int key, int im) { unsigned long long tmp;
    asm volatile("v_cmp_eq_f32 vcc, %2, %3\n\tv_cmp_le_i32 %1, %4, %5\n\ts_and_b64 vcc, vcc, %1\n\tv_addc_co_u32 %0, vcc, 0, %0, vcc" : "+v"(c), "=&s"(tmp) : "v"(s), "v"(t3), "v"(key), "v"(im) : "vcc"); }
__device__ __forceinline__ int dsa_count_ge(const f32x4 (&S)[8][4], int nch, float tau) {
    int c = 0;
#pragma unroll
    for (int ch = 0; ch < 8; ++ch) if (ch < nch) {
#pragma unroll
        for (int tt = 0; tt < 4; ++tt)
#pragma unroll
            for (int i = 0; i < 4; ++i) cnt_ge(c, S[ch][tt][i], tau);
    }
    return c;
}
__device__ __forceinline__ int dsa_total(int c, LAS unsigned* red, int par, int wid, int q16, int g) {
    c += __shfl_xor(c, 16); c += __shfl_xor(c, 32);
    if (g == 0) red[(par * 8 + wid) * 16 + q16] = (unsigned)c;
    __syncthreads();
    int t = 0;
#pragma unroll
    for (int w = 0; w < 8; ++w) t += (int)red[(par * 8 + w) * 16 + q16];
    return t;
}

__device__ __forceinline__ void dsa_unit(LAS unsigned char* lds, const AttnPtrs& P, int b, int qt, const int wid) {
    const int lane = lane_id_fresh(), tid = wid * 64 + lane, q16 = lane & 15, g = lane >> 4;
    LAS unsigned* red = (LAS unsigned*)(lds + DSA_LDS_RED); LAS float* fred = (LAS float*)(lds + DSA_LDS_FRED);
    LAS unsigned short* list = (LAS unsigned short*)(lds + DSA_LDS_LIST);
    const int t0 = qt * 16, myq = t0 + q16; const size_t brow = (size_t)b * SEQ;
    const int nch = (t0 + 15) / 512 + 1;
    f32x4 S[8][4];
#pragma unroll
    for (int ch = 0; ch < 8; ++ch)
#pragma unroll
        for (int tt = 0; tt < 4; ++tt) S[ch][tt] = (f32x4){NEG_INF, NEG_INF, NEG_INF, NEG_INF};
    float smax = NEG_INF, smin = -NEG_INF; int nvl = 0;
    {
        h16x8 qf[4][2];
#pragma unroll
        for (int h = 0; h < 4; ++h)
#pragma unroll
            for (int ks = 0; ks < 2; ++ks) qf[h][ks] = *(const h16x8*)(P.QI + (brow + myq) * 256 + h * 64 + ks * 32 + g * 8);
        const f32x4 wv = *(const f32x4*)(P.WI + (brow + myq) * 4);
        h16x8 pa[2][2];
#pragma unroll
        for (int u = 0; u < 2; ++u) { pa[u][0] = *(const h16x8*)(P.KI + (brow + 64 * wid + 16 * u + q16) * 64 + g * 8); pa[u][1] = *(const h16x8*)(P.KI + (brow + 64 * wid + 16 * u + q16) * 64 + 32 + g * 8); }
#pragma unroll
        for (int ch = 0; ch < 8; ++ch) if (ch < nch) {
#pragma unroll
            for (int tp = 0; tp < 2; ++tp) {
                h16x8 a[2][2];
#pragma unroll
                for (int u = 0; u < 2; ++u) { a[u][0] = pa[u][0]; a[u][1] = pa[u][1]; }
                { const int nidx = ch * 2 + tp + 1; int kn = 512 * (nidx >> 1) + 64 * wid + 32 * (nidx & 1); kn = kn < SEQ - 32 ? kn : SEQ - 32;
#pragma unroll
                  for (int u = 0; u < 2; ++u) { pa[u][0] = *(const h16x8*)(P.KI + (brow + kn + 16 * u + q16) * 64 + g * 8); pa[u][1] = *(const h16x8*)(P.KI + (brow + kn + 16 * u + q16) * 64 + 32 + g * 8); } }
#pragma unroll
                for (int u = 0; u < 2; ++u) {
                    const int tt = 2 * tp + u; const int kt = 512 * ch + 64 * wid + 16 * tt;
                    if (kt <= t0 + 15) {
                        f32x4 sc = {0.f, 0.f, 0.f, 0.f};
#pragma unroll
                        for (int h = 0; h < 4; ++h) { f32x4 acc = {0.f, 0.f, 0.f, 0.f};
                            acc = __builtin_amdgcn_mfma_f32_16x16x32_f16(a[u][0], qf[h][0], acc, 0, 0, 0);
                            acc = __builtin_amdgcn_mfma_f32_16x16x32_f16(a[u][1], qf[h][1], acc, 0, 0, 0);
#pragma unroll
                            for (int i = 0; i < 4; ++i) sc[i] += wv[h] * __builtin_fmaxf(acc[i], 0.f); }
                        const int key0 = kt + 4 * g;
                        const float zb = -(float)(key0 + 1) * ZEPS;
#pragma unroll
                        for (int i = 0; i < 4; ++i) { const bool ok = (key0 + i) <= myq; float v = sc[i]; v = (v == 0.f) ? (zb - (float)i * ZEPS) : v; v = ok ? v : NEG_INF; sc[i] = v;
                            smax = __builtin_fmaxf(smax, v); smin = __builtin_fminf(smin, ok ? v : -NEG_INF); nvl += ok ? 1 : 0; }
                        S[ch][tt] = sc;
                    }
                }
                __builtin_amdgcn_sched_barrier(0);
            }
        }
    }
    smax = __builtin_fmaxf(smax, __shfl_xor(smax, 16)); smax = __builtin_fmaxf(smax, __shfl_xor(smax, 32));
    smin = __builtin_fminf(smin, __shfl_xor(smin, 16)); smin = __builtin_fminf(smin, __shfl_xor(smin, 32));
    if (g == 0) { fred[(wid * 16 + q16) * 2] = smax; fred[(wid * 16 + q16) * 2 + 1] = smin; }
    __syncthreads();
#pragma unroll
    for (int w = 0; w < 8; ++w) { smax = __builtin_fmaxf(smax, fred[(w * 16 + q16) * 2]); smin = __builtin_fminf(smin, fred[(w * 16 + q16) * 2 + 1]); }
    const int nv = myq + 1; int par = 0;
    float lo, hi; int c_lo, c_hi, cl_lo, cl_hi; bool done, ovf;
    const float TZ = -4097.0f * ZEPS;
    for (int rep_b = 0; rep_b < REP_BIS; ++rep_b) {
    lo = smin; c_lo = nv; c_hi = 0; cl_lo = nvl; cl_hi = 0; done = false; ovf = false;
    { const unsigned mb = __float_as_uint(smax); hi = __uint_as_float(smax > 0.f ? mb + 1u : mb - 1u); }
    if (nv <= 256) { hi = lo; c_hi = c_lo; cl_hi = cl_lo; done = true; }
    auto pick = [&](float l, float h) -> float { if (l < 0.f && h > 0.f) return 0.f; if (l < TZ && h > TZ) return TZ; return l + (h - l) * 0.5f; };
    while (__any(!done)) {
        const float tau = done ? -NEG_INF : pick(lo, hi);
        const int clp = dsa_count_ge(S, nch, tau);
        const int c = dsa_total(clp, red, par, wid, q16, g); par ^= 1;
        if (!done) {
            if (c >= 256) { lo = tau; c_lo = c; cl_lo = clp; } else { hi = tau; c_hi = c; cl_hi = clp; }
            if (c_lo == 256) { hi = lo; c_hi = c_lo; cl_hi = cl_lo; done = true; }
            else if (c_lo - c_hi <= DSA_CAP) done = true;
            else { const float nt = pick(lo, hi); if (!(nt > lo && nt < hi)) { done = true; ovf = true; } }
        }
    }
    }
    const int kb0 = 64 * wid + 4 * g;
    int istar = 0x7fffffff;
    if (__any(ovf)) {
        const int R = 256 - c_hi; int ilo = -1, ihi = myq;
        while (__any(ovf && ihi - ilo > 1)) {
            const int im = ovf ? ((ilo + ihi) >> 1) : -1;
            int c = 0;
#pragma unroll
            for (int ch = 0; ch < 8; ++ch) if (ch < nch) {
#pragma unroll
                for (int tt = 0; tt < 4; ++tt)
#pragma unroll
                    for (int i = 0; i < 4; ++i) cnt_tie(c, S[ch][tt][i], lo, kb0, im - (512 * ch + 16 * tt + i));
            }
            c = dsa_total(c, red, par, wid, q16, g); par ^= 1;
            if (ovf && ihi - ilo > 1) { if (c >= R) ihi = im; else ilo = im; }
        }
        if (ovf) istar = ihi;
        int c = 0;
#pragma unroll
        for (int ch = 0; ch < 8; ++ch) if (ch < nch) {
#pragma unroll
            for (int tt = 0; tt < 4; ++tt)
#pragma unroll
                for (int i = 0; i < 4; ++i) { const float s = S[ch][tt][i]; const int key = kb0 + 512 * ch + 16 * tt + i; c += (s >= lo && (s >= hi || key <= istar)) ? 1 : 0; }
        }
        if (ovf) { cl_lo = c; c_lo = 256; c_hi = 256; hi = NEG_INF; }
    }
    unsigned nw;
    {
        const int p = cl_lo;
        const int u1 = __shfl_up(p, 16); const int s1 = p + (g >= 1 ? u1 : 0);
        const int u2 = __shfl_up(s1, 32); const int s2 = s1 + (g >= 2 ? u2 : 0);
        if (g == 3) red[(par * 8 + wid) * 16 + q16] = (unsigned)s2;
        __syncthreads();
        int bw = 0;
#pragma unroll
        for (int w = 0; w < 8; ++w) { const int t = (int)red[(par * 8 + w) * 16 + q16]; bw += (w < wid) ? t : 0; }
        par ^= 1;
        nw = (unsigned)(bw + s2 - p);
    }
    if (wid == 0 && g == 0) ((LAS u32x4*)(lds + DSA_LDS_META))[q16] = (u32x4){(unsigned)c_lo, (unsigned)c_hi, __float_as_uint(hi), 0u};
    {
        const unsigned bufq = (unsigned)(uintptr_t)(lds + DSA_LDS_BUF + q16 * (DSA_BUFN * 8)), trash = (unsigned)(uintptr_t)(lds + DSA_LDS_TRASH + tid * 8);
        if (!__any(ovf)) {
#pragma unroll
            for (int ch = 0; ch < 8; ++ch) if (ch < nch) {
#pragma unroll
                for (int tt = 0; tt < 4; ++tt)
#pragma unroll
                    for (int i = 0; i < 4; ++i) { const float s = S[ch][tt][i]; const int key = kb0 + 512 * ch + 16 * tt + i; unsigned a;
                        asm volatile("v_cmp_ge_f32 vcc, %2, %3\n\tv_lshl_add_u32 %0, %1, 3, %4\n\tv_cndmask_b32 %0, %5, %0, vcc\n\tv_addc_co_u32 %1, vcc, 0, %1, vcc\n\tds_write2_b32 %0, %2, %6 offset1:1"
                                     : "=&v"(a), "+v"(nw) : "v"(s), "v"(lo), "v"(bufq), "v"(trash), "v"(key) : "vcc", "memory"); }
            }
        } else {
#pragma unroll
            for (int ch = 0; ch < 8; ++ch) if (ch < nch) {
#pragma unroll
                for (int tt = 0; tt < 4; ++tt)
#pragma unroll
                    for (int i = 0; i < 4; ++i) { const float s = S[ch][tt][i]; const int key = kb0 + 512 * ch + 16 * tt + i;
                        const bool w = (s >= lo && (s >= hi || key <= istar));
                        const unsigned a = w ? (bufq + nw * 8u) : trash; nw += w ? 1u : 0u;
                        asm volatile("ds_write2_b32 %0, %1, %2 offset1:1" :: "v"(a), "v"(s), "v"(key) : "memory"); }
            }
        }
    }
    asm volatile("s_waitcnt lgkmcnt(0)" ::: "memory");
    __syncthreads();
#ifndef X_NOATT
    int lane_o = lane;
    {
    LAS unsigned char* vbuf = lds + DSA_LDS_VBUF + wid * (2 * 32 * VROW);
#pragma unroll 1
    for (int qq2 = 0; qq2 < 2 * REP_ATT; ++qq2) { const int qq = qq2 & 1;
        asm volatile("" : "+v"(lane_o));
        const int lane = lane_o, q16 = lane & 15, g = lane >> 4;
        const int ql = 2 * wid + qq; const int qpos = t0 + ql; const int n = (qpos + 1 < 256) ? qpos + 1 : 256;
        LAS unsigned short* ql_list = list + ql * 256;
        {
            const u32x4 mt = ((const LAS u32x4*)(lds + DSA_LDS_META))[ql];
            const int n_e = (int)mt.x, chi = (int)mt.y; const float hiv = __uint_as_float(mt.z); const int R = 256 - chi;
            const LAS u32x2* bq = (const LAS u32x2*)(lds + DSA_LDS_BUF) + ql * DSA_BUFN;
            LAS u32x2* cb = (LAS u32x2*)(lds + DSA_LDS_CANDB) + wid * 64;
            int base_s = 0, base_c = 0;
#pragma unroll
            for (int k = 0; k < 5; ++k) { const int e = lane + 64 * k; const bool valid = e < n_e; const u32x2 ent = bq[e];
                const float s = __uint_as_float(ent.x); const bool sure = valid && (s >= hiv), cand = valid && !(s >= hiv);
                const unsigned long long bs = __ballot(sure), bc = __ballot(cand);
                const int ps = base_s + (int)__builtin_amdgcn_mbcnt_hi((unsigned)(bs >> 32), __builtin_amdgcn_mbcnt_lo((unsigned)bs, 0u));
                const int pc = base_c + (int)__builtin_amdgcn_mbcnt_hi((unsigned)(bc >> 32), __builtin_amdgcn_mbcnt_lo((unsigned)bc, 0u));
                if (sure && ps < 256) ql_list[ps] = (unsigned short)ent.y;
                if (cand && pc < 64) cb[pc] = ent;
                base_s += __popcll(bs); base_c += __popcll(bc); }
            const int m = base_c < 64 ? base_c : 64;
            asm volatile("s_waitcnt lgkmcnt(0)" ::: "memory");
            u32x2 my = {0u, 0u}; if (lane < m) my = cb[lane];
            const float mys = __uint_as_float(my.x); int rank = 0;
#pragma unroll 4
            for (int jx = 0; jx < m; ++jx) { const u32x2 o = cb[jx]; const float os = __uint_as_float(o.x); rank += (os > mys || (os == mys && o.y < my.y)) ? 1 : 0; }
            if (lane < m && rank < R && chi + rank < 256) ql_list[chi + rank] = (unsigned short)my.y;
            asm volatile("s_waitcnt lgkmcnt(0)" ::: "memory");
        }
        const int head = q16 & 7;
        h16x8 qf[2];
#pragma unroll
        for (int ks = 0; ks < 2; ++ks) qf[ks] = *(const h16x8*)(P.QA + (brow + qpos) * 512 + head * 64 + ks * 32 + g * 8);
        f32x4 L[16];
        {
            h16x8 ka[2][4][2];
#pragma unroll
            for (int u = 0; u < 4; ++u) { const int e = 16 * u + q16; const int kraw = (int)ql_list[e]; const int key = (e < n) ? kraw : 0;
                ka[0][u][0] = *(const h16x8*)(P.KA + (brow + key) * 64 + g * 8); ka[0][u][1] = *(const h16x8*)(P.KA + (brow + key) * 64 + 32 + g * 8); }
#pragma unroll
            for (int gi = 0; gi < 4; ++gi) {
                if (gi < 3) {
#pragma unroll
                    for (int u = 0; u < 4; ++u) { const int e = 16 * (4 * (gi + 1) + u) + q16; const int kraw = (int)ql_list[e]; const int key = (e < n) ? kraw : 0;
                        ka[(gi + 1) & 1][u][0] = *(const h16x8*)(P.KA + (brow + key) * 64 + g * 8); ka[(gi + 1) & 1][u][1] = *(const h16x8*)(P.KA + (brow + key) * 64 + 32 + g * 8); }
                }
#pragma unroll
                for (int u = 0; u < 4; ++u) { const int T = 4 * gi + u;
                    f32x4 acc = {0.f, 0.f, 0.f, 0.f};
                    acc = __builtin_amdgcn_mfma_f32_16x16x32_f16(ka[gi & 1][u][0], qf[0], acc, 0, 0, 0);
                    acc = __builtin_amdgcn_mfma_f32_16x16x32_f16(ka[gi & 1][u][1], qf[1], acc, 0, 0, 0);
#pragma unroll
                    for (int i = 0; i < 4; ++i) if (16 * T + 4 * g + i >= n) acc[i] = NEG_INF;
                    L[T] = acc; }
                __builtin_amdgcn_sched_barrier(0);
            }
        }
        u32x4 vreg[2][4];
#pragma unroll
        for (int c2 = 0; c2 < 2; ++c2)
#pragma unroll
            for (int i = 0; i < 4; ++i) { const int j = lane >> 3; const int e = 16 * (2 * c2 + (j >> 2)) + 4 * i + (j & 3); const int kraw = (int)ql_list[e]; const int key = (e < n) ? kraw : 0;
                vreg[c2][i] = *(const u32x4*)(P.VA + (brow + key) * 64 + 8 * (lane & 7)); }
        __builtin_amdgcn_sched_barrier(0);
        float mx = NEG_INF;
#pragma unroll
        for (int T = 0; T < 16; ++T)
#pragma unroll
            for (int i = 0; i < 4; ++i) mx = __builtin_fmaxf(mx, L[T][i]);
        mx = __builtin_fmaxf(mx, __shfl_xor(mx, 16)); mx = __builtin_fmaxf(mx, __shfl_xor(mx, 32));
        float lsum = 0.f;
#pragma unroll
        for (int T = 0; T < 16; ++T)
#pragma unroll
            for (int i = 0; i < 4; ++i) { const float p = __builtin_amdgcn_exp2f(L[T][i] - mx); L[T][i] = p; lsum += p; }
        lsum += __shfl_xor(lsum, 16); lsum += __shfl_xor(lsum, 32);
        __builtin_amdgcn_sched_barrier(0);
        f32x4 O[4];
#pragma unroll
        for (int db = 0; db < 4; ++db) O[db] = (f32x4){0.f, 0.f, 0.f, 0.f};
#pragma unroll
        for (int cc = 0; cc < 8; ++cc) {
            LAS unsigned char* vb = vbuf + (cc & 1) * (32 * VROW);
#pragma unroll
            for (int i = 0; i < 4; ++i) *(LAS u32x4*)(vb + (8 * i + (lane >> 3)) * VROW + 16 * (lane & 7)) = vreg[cc & 1][i];
            if (cc < 6) {
#pragma unroll
                for (int i = 0; i < 4; ++i) { const int j = lane >> 3; const int e = 16 * (2 * (cc + 2) + (j >> 2)) + 4 * i + (j & 3); const int kraw = (int)ql_list[e]; const int key = (e < n) ? kraw : 0;
                    vreg[cc & 1][i] = *(const u32x4*)(P.VA + (brow + key) * 64 + 8 * (lane & 7)); }
            }
            asm volatile("s_waitcnt lgkmcnt(0)" ::: "memory");
            h16x8 pa;
#pragma unroll
            for (int i = 0; i < 4; ++i) { pa[i] = (h16)L[2 * cc][i]; pa[4 + i] = (h16)L[2 * cc + 1][i]; }
#pragma unroll
            for (int db = 0; db < 4; ++db) {
                const LAS unsigned char* pb = vb + (8 * g + ((lane & 15) >> 2)) * VROW + (16 * db + 4 * (lane & 3)) * 2;
                const s16x4 lo4 = __builtin_amdgcn_ds_read_tr16_b64_v4i16((LAS s16x4*)pb);
                const s16x4 hi4 = __builtin_amdgcn_ds_read_tr16_b64_v4i16((LAS s16x4*)(pb + 4 * VROW));
                const s16x8 bf = {lo4[0], lo4[1], lo4[2], lo4[3], hi4[0], hi4[1], hi4[2], hi4[3]};
                O[db] = __builtin_amdgcn_mfma_f32_16x16x32_f16(pa, __builtin_bit_cast(h16x8, bf), O[db], 0, 0, 0);
            }
            __builtin_amdgcn_sched_barrier(0);
        }
#pragma unroll
        for (int i = 0; i < 4; ++i) { const float lh = __shfl(lsum, (4 * g + i) & 7); const float rl = 1.0f / lh;
            if (g < 2) {
#pragma unroll
                for (int db = 0; db < 4; ++db) P.Y[(brow + qpos) * DM + (4 * g + i) * 64 + 16 * db + q16] = (h16)(O[db][i] * rl); } }
    }
    }
#endif
    __syncthreads();
}

constexpr int MB_LDS_KM = 0  , MB_LDS_KV = 4096  , MB_TILE = 64 * VROW;
__device__ __forceinline__ int crow(int r, int hi) { return (r & 3) + 8 * (r >> 2) + 4 * hi; }

__device__ __forceinline__ void moba_unit(LAS unsigned char* lds, const AttnPtrs& P, int b, int h, int j) {
    const int tid = threadIdx.x, lane = tid & 63, wid = __builtin_amdgcn_readfirstlane(tid >> 6), r32 = lane & 31, hi = lane >> 5;
    const size_t brow = (size_t)b * SEQ; const int q0 = 256 * j; const int qrel = 32 * wid + r32; const size_t qrow = brow + q0 + qrel;
    LAS float* km = (LAS float*)(lds + MB_LDS_KM);
    for (int i = tid; i < 16 * 64; i += 512) { const int n = i >> 6, d = i & 63; const size_t pm = (size_t)b * 16 + n;
        km[i] = (P.kmp[((pm * 2 + 0) * 8 + h) * 64 + d] + P.kmp[((pm * 2 + 1) * 8 + h) * 64 + d]) * (1.0f / 256.0f); }
    __syncthreads();
    h16x8 qf[4];
#pragma unroll
    for (int d0 = 0; d0 < 4; ++d0) qf[d0] = *(const h16x8*)(P.QB + qrow * 512 + h * 64 + d0 * 16 + hi * 8);
    unsigned selmask = 0u;
    {
        float gate[8];
#pragma unroll
        for (int nb = 0; nb < 8; ++nb) gate[nb] = 0.f;
#pragma unroll
        for (int c8 = 0; c8 < 8; ++c8) {
            const h16x8 qv = *(const h16x8*)(P.QB + qrow * 512 + h * 64 + c8 * 8);
#pragma unroll
            for (int nb = 0; nb < 8; ++nb) { const LAS float* kr = km + (8 * hi + nb) * 64 + c8 * 8;
#pragma unroll
                for (int e = 0; e < 8; ++e) gate[nb] += (float)qv[e] * kr[e]; }
        }
        float gall[16];
#pragma unroll
        for (int nb = 0; nb < 8; ++nb) { const float o = __shfl_xor(gate[nb], 32); gall[nb] = hi ? o : gate[nb]; gall[8 + nb] = hi ? gate[nb] : o; }
#pragma unroll
        for (int n = 0; n < 16; ++n) if (n >= j) gall[n] = NEG_INF;
#pragma unroll
        for (int pick = 0; pick < 3; ++pick) { float best = NEG_INF; int bi = -1;
#pragma unroll
            for (int n = 0; n < 16; ++n) if (gall[n] > best) { best = gall[n]; bi = n; }
            if (bi >= 0) { selmask |= 1u << bi;
#pragma unroll
                for (int n = 0; n < 16; ++n) if (n == bi) gall[n] = NEG_INF; } }
    }
    const int NT = 4 * (j + 1);
    const h16* Kg = P.KB + brow * 512 + h * 64; const h16* Vg = P.VB + brow * 512 + h * 64;
    const int lrow = tid >> 3, lch = tid & 7;
    auto tile_key0 = [&](int t) { return (t < 4) ? (q0 + 64 * t) : (64 * (t - 4)); };
    u32x4 kreg, vreg;
    { const int k0 = tile_key0(0); kreg = *(const u32x4*)(Kg + (size_t)(k0 + lrow) * 512 + lch * 8); vreg = *(const u32x4*)(Vg + (size_t)(k0 + lrow) * 512 + lch * 8); }
    { LAS unsigned char* kb = lds + MB_LDS_KV; *(LAS u32x4*)(kb + lrow * VROW + lch * 16) = kreg; *(LAS u32x4*)(kb + MB_TILE + lrow * VROW + lch * 16) = vreg; }
    __syncthreads();
    float mrun = NEG_INF, lrun = 0.f; f32x16 o[2]; o[0] = f32x16{}; o[1] = f32x16{};
#pragma unroll 1
    for (int t = 0; t < NT; ++t) {
        if (t + 1 < NT) { const int k0 = tile_key0(t + 1); kreg = *(const u32x4*)(Kg + (size_t)(k0 + lrow) * 512 + lch * 8); vreg = *(const u32x4*)(Vg + (size_t)(k0 + lrow) * 512 + lch * 8); }
        const LAS unsigned char* kb = lds + MB_LDS_KV + (t & 1) * (2 * MB_TILE); const LAS unsigned char* vb = kb + MB_TILE;
        bool active;
        if (t < 4) active = (64 * t) <= (32 * wid + 31);
        else active = __any((selmask >> ((t - 4) >> 2)) & 1u);
        if (active) {
            f32x16 p0 = f32x16{}, p1 = f32x16{};
#pragma unroll
            for (int d0 = 0; d0 < 4; ++d0) {
                const h16x8 k0f = *(const LAS h16x8*)(kb + r32 * VROW + (16 * d0 + 8 * hi) * 2);
                const h16x8 k1f = *(const LAS h16x8*)(kb + (32 + r32) * VROW + (16 * d0 + 8 * hi) * 2);
                p0 = __builtin_amdgcn_mfma_f32_32x32x16_f16(k0f, qf[d0], p0, 0, 0, 0);
                p1 = __builtin_amdgcn_mfma_f32_32x32x16_f16(k1f, qf[d0], p1, 0, 0, 0);
            }
            if (t < 4) {
#pragma unroll
                for (int r = 0; r < 16; ++r) { const int kv = 64 * t + crow(r, hi); if (kv > qrel) p0[r] = NEG_INF; if (kv + 32 > qrel) p1[r] = NEG_INF; }
            } else if (!((selmask >> ((t - 4) >> 2)) & 1u)) {
#pragma unroll
                for (int r = 0; r < 16; ++r) { p0[r] = NEG_INF; p1[r] = NEG_INF; }
            }
            float mt = NEG_INF;
#pragma unroll
            for (int r = 0; r < 16; ++r) mt = __builtin_fmaxf(mt, __builtin_fmaxf(p0[r], p1[r]));
            mt = __builtin_fmaxf(mt, __shfl_xor(mt, 32));
            const float mnew = __builtin_fmaxf(mrun, mt);
            const float alpha = (mnew == NEG_INF) ? 1.0f : __builtin_amdgcn_exp2f(mrun - mnew);
            const float msub = (mnew == NEG_INF) ? 0.f : mnew;
            float ps = 0.f;
#pragma unroll
            for (int r = 0; r < 16; ++r) { p0[r] = __builtin_amdgcn_exp2f(p0[r] - msub); p1[r] = __builtin_amdgcn_exp2f(p1[r] - msub); ps += p0[r] + p1[r]; }
            lrun = lrun * alpha + ps; mrun = mnew;
            if (__any(alpha != 1.0f)) {
#pragma unroll
                for (int r = 0; r < 16; ++r) { o[0][r] *= alpha; o[1][r] *= alpha; }
            }
#pragma unroll
            for (int kt = 0; kt < 2; ++kt)
#pragma unroll
                for (int s = 0; s < 2; ++s) {
                    h16x8 pb;
#pragma unroll
                    for (int e = 0; e < 8; ++e) pb[e] = (h16)(kt ? p1[8 * s + e] : p0[8 * s + e]);
#pragma unroll
                    for (int db = 0; db < 2; ++db) {
                        const LAS unsigned char* pa = vb + (32 * kt + 16 * s + 4 * hi + ((lane & 15) >> 2)) * VROW + (32 * db + 16 * ((lane >> 4) & 1) + 4 * (lane & 3)) * 2;
                        const s16x4 lo4 = __builtin_amdgcn_ds_read_tr16_b64_v4i16((LAS s16x4*)pa);
                        const s16x4 hi4 = __builtin_amdgcn_ds_read_tr16_b64_v4i16((LAS s16x4*)(pa + 8 * VROW));
                        const s16x8 af = {lo4[0], lo4[1], lo4[2], lo4[3], hi4[0], hi4[1], hi4[2], hi4[3]};
                        o[db] = __builtin_amdgcn_mfma_f32_32x32x16_f16(__builtin_bit_cast(h16x8, af), pb, o[db], 0, 0, 0);
                    }
                }
        }
        if (t + 1 < NT) { LAS unsigned char* nb = lds + MB_LDS_KV + ((t + 1) & 1) * (2 * MB_TILE); *(LAS u32x4*)(nb + lrow * VROW + lch * 16) = kreg; *(LAS u32x4*)(nb + MB_TILE + lrow * VROW + lch * 16) = vreg; }
        __syncthreads();
    }
    lrun += __shfl_xor(lrun, 32);
    const float rl = 1.0f / lrun;
    h16* yrow = P.Y + qrow * DM + 512 + h * 64;
#pragma unroll
    for (int db = 0; db < 2; ++db)
#pragma unroll
        for (int rg = 0; rg < 4; ++rg) { u32x2 w; w.x = pkh(o[db][4 * rg] * rl, o[db][4 * rg + 1] * rl); w.y = pkh(o[db][4 * rg + 2] * rl, o[db][4 * rg + 3] * rl);
            *(u32x2*)(yrow + 32 * db + 8 * rg + 4 * hi) = w; }
}


namespace moba_fast {
using bf16=_Float16;
using bf16x8=__attribute__((ext_vector_type(8)))short;
using s16x4=__attribute__((ext_vector_type(4)))short;
using f32x16=__attribute__((ext_vector_type(16)))float;
using u32x4=__attribute__((ext_vector_type(4)))unsigned;
constexpr int BATCH=8,NHEAD=8,SEQ=4096,D=64,DM=NHEAD*D,OPITCH=1024,OCOL=512;
constexpr int NW=8,QBLK=32,QB=QBLK*NW,KVBLK=64,NQB=SEQ/QB;
constexpr int ATTN_PITCH=DM, ATTN_UNIT_ROWS=QB;
__device__ __forceinline__ int crow(int r,int hi){return (r&3)+8*(r>>2)+4*hi;}
#define SBAR() __builtin_amdgcn_sched_barrier(0)
#define MFMAH(a,b,c) __builtin_amdgcn_mfma_f32_32x32x16_f16(__builtin_bit_cast(h16x8,(a)),__builtin_bit_cast(h16x8,(b)),(c),0,0,0)
__device__ __forceinline__ void cmask(f32x16&p0,f32x16&p1,int jb,int qrel,int hi){
  const float NEG=(-__builtin_huge_valf()); int kb=64*jb+4*hi;
  #pragma unroll
  for(int r=0;r<16;++r){int kv=kb+(r&3)+8*(r>>2); if(kv>qrel)p0[r]=NEG; if(kv+32>qrel)p1[r]=NEG;}
}

constexpr int NSLOT=3, SLOTB=8192;
constexpr int LDS_K=0, LDS_V=NSLOT*SLOTB, LDS_WS=2*NSLOT*SLOTB, LDS_OST=LDS_WS+NW*64*4, LDS_BYTES=LDS_OST+NW*4096;
constexpr float C2=0.125f*1.4426950408889634f;
__device__ __forceinline__ void glds16(const void*gsrc,unsigned lds_dst){unsigned keep;
  asm volatile("s_mov_b32 %0, m0\n\ts_mov_b32 m0, %2\n\ts_nop 0\n\tglobal_load_lds_dwordx4 %1, off\n\ts_mov_b32 m0, %0":"=&s"(keep):"v"(gsrc),"s"(lds_dst):"memory");}
__device__ __forceinline__ void glds16s(unsigned voff,const void*sbase,unsigned lds_dst){unsigned keep;
  asm volatile("s_mov_b32 %0, m0\n\ts_mov_b32 m0, %3\n\ts_nop 0\n\tglobal_load_lds_dwordx4 %1, %2\n\ts_mov_b32 m0, %0":"=&s"(keep):"v"(voff),"s"(sbase),"s"(lds_dst):"memory");}
__device__ __forceinline__ float max3f(float a,float b,float c){float r;asm("v_max3_f32 %0, %1, %2, %3":"=v"(r):"v"(a),"v"(b),"v"(c));return r;}
__device__ __forceinline__ float max2f(float a,float b){float r;asm("v_max_f32_e32 %0, %1, %2":"=v"(r):"v"(a),"v"(b));return r;}
__device__ __forceinline__ float fadd_s(float a,float b){float r;asm("v_add_f32_e32 %0, %1, %2":"=v"(r):"v"(a),"v"(b));return r;}
__device__ __forceinline__ float fsub_s(float a,float b){float r;asm("v_sub_f32_e32 %0, %1, %2":"=v"(r):"v"(a),"v"(b));return r;}
typedef float f32x2_t __attribute__((ext_vector_type(2))); typedef _Float16 bf16x2_t __attribute__((ext_vector_type(2)));
__device__ __forceinline__ unsigned cvtpk_s(float lo,float hi){f32x2_t v={lo,hi};bf16x2_t b=__builtin_convertvector(v,bf16x2_t);return __builtin_bit_cast(unsigned,b);}
#define WAIT_BAR(N) asm volatile("s_waitcnt vmcnt(" #N ") lgkmcnt(0)\n\ts_barrier":::"memory")

__device__ __forceinline__ void qkt(f32x16&p0,f32x16&p1,const char*Kslot,const bf16x8*qr,const f32x16&negm,int r32,int hi){
  const char*kb=Kslot+hi*1024+r32*16;
  #pragma unroll
  for(int d0=0;d0<4;++d0){
    const bf16x8 b0=*reinterpret_cast<const bf16x8*>(kb+d0*2048);
    const bf16x8 b1=*reinterpret_cast<const bf16x8*>(kb+d0*2048+512);
    if(d0==0){p0=MFMAH(b0,qr[0],negm);p1=MFMAH(b1,qr[0],negm);}
    else{p0=MFMAH(b0,qr[d0],p0);p1=MFMAH(b1,qr[d0],p1);}}
}
typedef __attribute__((address_space(3))) const char* lds_cptr;
typedef short v4i16_t __attribute__((ext_vector_type(4)));
__device__ __forceinline__ void kload8(bf16x8*kf,lds_cptr kp){
  kf[0]=*(const __attribute__((address_space(3))) bf16x8*)(kp);      kf[1]=*(const __attribute__((address_space(3))) bf16x8*)(kp+512);
  kf[2]=*(const __attribute__((address_space(3))) bf16x8*)(kp+2048); kf[3]=*(const __attribute__((address_space(3))) bf16x8*)(kp+2560);
  kf[4]=*(const __attribute__((address_space(3))) bf16x8*)(kp+4096); kf[5]=*(const __attribute__((address_space(3))) bf16x8*)(kp+4608);
  kf[6]=*(const __attribute__((address_space(3))) bf16x8*)(kp+6144); kf[7]=*(const __attribute__((address_space(3))) bf16x8*)(kp+6656);
}
__device__ __forceinline__ void kload2(bf16x8*kf,lds_cptr kp,int j){ kf[2*j]=*(const __attribute__((address_space(3))) bf16x8*)(kp+j*2048); kf[2*j+1]=*(const __attribute__((address_space(3))) bf16x8*)(kp+j*2048+512); }
__device__ __forceinline__ s16x4 vtr(lds_cptr p){ return __builtin_bit_cast(s16x4,__builtin_amdgcn_ds_read_tr16_b64_v4i16((__attribute__((address_space(3))) v4i16_t*)p)); }
__device__ __forceinline__ float rowmax(const f32x16&p0,const f32x16&p1){
  float a=max3f(p0[0],p0[1],p1[0]),b=max3f(p0[2],p0[3],p1[1]);a=max3f(a,p1[2],p1[3]);
  #pragma unroll
  for(int r=4;r<16;r+=4){a=max3f(a,p0[r],p0[r+1]);b=max3f(b,p0[r+2],p0[r+3]);a=max3f(a,p1[r],p1[r+1]);b=max3f(b,p1[r+2],p1[r+3]);}
  const float m=max2f(a,b);
  auto rr=__builtin_amdgcn_permlane32_swap(__float_as_uint(m),__float_as_uint(m),false,false);
  return max2f(__uint_as_float(rr[0]),__uint_as_float(rr[1]));
}
__device__ __forceinline__ void pv(f32x16*o,int vb,bf16x8 pa0,bf16x8 pa1,bf16x8 pa2,bf16x8 pa3){
  #pragma unroll
  for(int d0=0;d0<2;++d0){s16x4 lo[4],hi[4];
    #pragma unroll
    for(int ks=0;ks<4;++ks){
      asm volatile("ds_read_b64_tr_b16 %0,%1 offset:%c2":"=&v"(lo[ks]):"v"(vb),"i"(d0*4096+ks*1024):"memory");
      asm volatile("ds_read_b64_tr_b16 %0,%1 offset:%c2":"=&v"(hi[ks]):"v"(vb),"i"(d0*4096+ks*1024+512):"memory");}
    asm volatile("s_waitcnt lgkmcnt(0)":::"memory");SBAR();
    #define PK(k) (bf16x8){lo[k][0],lo[k][1],lo[k][2],lo[k][3],hi[k][0],hi[k][1],hi[k][2],hi[k][3]}
    o[d0]=MFMAH(pa0,PK(0),o[d0]);
    o[d0]=MFMAH(pa1,PK(1),o[d0]);
    o[d0]=MFMAH(pa2,PK(2),o[d0]);
    o[d0]=MFMAH(pa3,PK(3),o[d0]);
    #undef PK
  }
}

#ifndef ATTN_STORE16
#define ATTN_STORE16(p,v) (*(u32x4*)(p)=(v))
#endif
template<int THRL> __device__ __forceinline__ void attn_unit(int b,int h,int qb,const bf16*Q,const bf16*__restrict__ K,const bf16*__restrict__ V,bf16*O,char*shm,const unsigned selmask,const int wid_s){
  #define KT(t) (((t)<4)?(4*qb+(t)):((t)-4))
  const int lane=lane_id_fresh(),r32=lane&31,hi=lane>>5; const int wid=wid_s;
  const long rowbase=(long)b*SEQ; const int q0=qb*QB;
  const bf16*Qw=Q+(rowbase+q0+wid*QBLK)*DM+h*D;
  const bf16*Kh=K+rowbase*DM+h*D,*Vh=V+rowbase*DM+h*D;
  const unsigned lds0=(unsigned)(uintptr_t)shm;
  float*wsf=(float*)(shm+LDS_WS)+wid*64;
  const unsigned koff=(unsigned)((lane*DM+wid*8)*2);
  const unsigned voff=(unsigned)(((16*(wid&3)+(lane>>2))*DM+(wid>>2)*32+(lane&3)*8)*2);
  const unsigned kdst=lds0+LDS_K+wid*1024, vdst=lds0+LDS_V+wid*1024;
  #define DMA_K(t,slot) glds16s(koff,(const char*)Kh+(long)KT(t)*(KVBLK*DM*2),(unsigned)__builtin_amdgcn_readfirstlane(kdst+(slot)))
  #define DMA_V(t,slot) glds16s(voff,(const char*)Vh+(long)KT(t)*(KVBLK*DM*2),(unsigned)__builtin_amdgcn_readfirstlane(vdst+(slot)))
  const int vb0=(int)(lds0+LDS_V)+((lane>>4)&1)*32+(lane&3)*8+(4*hi+((lane&15)>>2))*64;
  const char*Kbase=shm+LDS_K; bf16x8 kf[8];
  const lds_cptr shm3=(lds_cptr)shm; const lds_cptr kp0=shm3+LDS_K+hi*1024+r32*16; const lds_cptr vp0=shm3+LDS_V+((lane>>4)&1)*32+(lane&3)*8+(4*hi+((lane&15)>>2))*64;
  const int NT=(q0+QB)/KVBLK;
  DMA_K(0,0);DMA_V(0,0);DMA_K(1,SLOTB);
  bf16x8 qr[4];
  #pragma unroll
  for(int d0=0;d0<4;++d0)qr[d0]=*reinterpret_cast<const bf16x8*>(&Qw[(long)r32*DM+d0*16+hi*8]);
  float mhat=0.f,l_reg=0.f;f32x16 o[2];o[0]=f32x16{};o[1]=f32x16{};const f32x16 negm=f32x16{}; float msub_=0.f;
  const int qrel=wid*QBLK+r32;
  #define CMASK(P0,P1,t) do{ if((t)<4)cmask(P0,P1,(t),qrel,hi); }while(0)
  bool resc=false;
  #define START(P0,P1) do{ const float rm=rowmax(P0,P1); resc=false; \
    { const float dl=rm; mhat=fadd_s(mhat,dl); \
      _Pragma("unroll") for(int r=0;r<16;++r){P0[r]=fsub_s(P0[r],dl);P1[r]=fsub_s(P1[r],dl);} \
      } \
    _Pragma("unroll") for(int r=0;r<16;++r)P0[r]=__builtin_amdgcn_exp2f(P0[r]); }while(0)
  #define RESC() do{ if(resc){ asm volatile("s_waitcnt lgkmcnt(0)":::"memory"); \
      _Pragma("unroll") for(int d_=0;d_<2;++d_) _Pragma("unroll") for(int r=0;r<16;++r)o[d_][r]*=wsf[crow(r,hi)]; } }while(0)
  f32x16 pA0,pA1,pB0,pB1;
  int sl_prev=0,sl_cur=0,sl_next=SLOTB;
  #define ROT() do{sl_prev=sl_cur;sl_cur=sl_next;sl_next=(sl_next==(NSLOT-1)*SLOTB)?0:sl_next+SLOTB;}while(0)
  DMA_K(2,2*SLOTB);
  WAIT_BAR(3);
  qkt(pA0,pA1,Kbase,qr,negm,r32,hi);asm volatile("s_nop 15\n\ts_nop 7":"+v"(pA0),"+v"(pA1));CMASK(pA0,pA1,0);
  START(pA0,pA1);
  _Pragma("unroll") for(int r=0;r<16;++r)pA1[r]=__builtin_amdgcn_exp2f(pA1[r]);
  WAIT_BAR(0);
  DMA_K(3,0);DMA_V(1,SLOTB);
  ROT();
  kload8(kf,kp0+sl_cur);
  WAIT_BAR(2);
  s16x4 vlo[8],vhi[8]; u32x4 pw0,pw1,pw2,pw3;
  #define PKW(P,B) cvtpk_s(P[B],P[B+1])
  #define PAF(k) __builtin_bit_cast(bf16x8,pw##k)
  #define VFR(i) (bf16x8){vlo[i][0],vlo[i][1],vlo[i][2],vlo[i][3],vhi[i][0],vhi[i][1],vhi[i][2],vhi[i][3]}
  #define PIN(x) asm volatile("":"+v"(x))
  #define MX3(a,b,c) __builtin_fmaxf(__builtin_fmaxf((a),(b)),(c))
  #define GAPA(MF,A0,A1,A2,A3,W0,W1,PW) do{ MF; sacc+=A0; sacc+=A1; sacc+=A2; sacc+=A3; PIN(sacc); W0; W1; PIN(PW); SBAR(); }while(0)
  #define EX(v) __builtin_amdgcn_exp2f((v)-msub_)
  #define GAPB(MF,X,B) do{ MF; X[B]=EX(X[B]); X[B+1]=EX(X[B+1]); X[B+2]=EX(X[B+2]); X[B+3]=EX(X[B+3]); PIN(X); SBAR(); }while(0)
  #define VRD(i) do{ vlo[i]=vtr(vp_+(((i)>>2)*4096+((i)&3)*1024)); vhi[i]=vtr(vp_+(((i)>>2)*4096+((i)&3)*1024+512)); }while(0)
  #define KRD(G,j) do{ if(G){ kload2(kf,kp0+sl_next,j); SBAR(); } }while(0)
  #define STEP(C0,C1,P0,P1,t,GK,GV,GL) do{ SBAR(); \
    const bool st_=((t)<4)||((selmask>>(((t)-4)>>2))&1u); \
    const lds_cptr vp_=vp0+sl_prev; \
    VRD(0); SBAR(); float sacc=(P0[0]+P0[1]); \
    GAPA(C0=MFMAH(kf[0],qr[0],(f32x16{})), P0[2],P0[3],P0[4],P0[5],     pw0[0]=PKW(P0,0), pw0[1]=PKW(P0,2), pw0); \
    VRD(4); SBAR(); GAPA(C1=MFMAH(kf[1],qr[0],(f32x16{})), P0[6],P0[7],P0[8],P0[9],     pw0[2]=PKW(P0,4), pw0[3]=PKW(P0,6), pw0); \
    VRD(1); SBAR(); GAPA(C0=MFMAH(kf[2],qr[1],C0),   P0[10],P0[11],P0[12],P0[13], pw1[0]=PKW(P0,8), pw1[1]=PKW(P0,10), pw1); \
    VRD(5); SBAR(); GAPA(C1=MFMAH(kf[3],qr[1],C1),   P0[14],P0[15],P1[0],P1[1],   pw1[2]=PKW(P0,12),pw1[3]=PKW(P0,14), pw1); \
    VRD(2); SBAR(); GAPA(C0=MFMAH(kf[4],qr[2],C0),   P1[2],P1[3],P1[4],P1[5],     pw2[0]=PKW(P1,0), pw2[1]=PKW(P1,2), pw2); \
    VRD(6); SBAR(); GAPA(C1=MFMAH(kf[5],qr[2],C1),   P1[6],P1[7],P1[8],P1[9],     pw2[2]=PKW(P1,4), pw2[3]=PKW(P1,6), pw2); \
    VRD(3); SBAR(); GAPA(C0=MFMAH(kf[6],qr[3],C0),   P1[10],P1[11],P1[12],P1[13], pw3[0]=PKW(P1,8), pw3[1]=PKW(P1,10), pw3); \
    VRD(7); SBAR(); GAPA(C1=MFMAH(kf[7],qr[3],C1),   P1[14],P1[15],0.f,0.f,       pw3[2]=PKW(P1,12),pw3[3]=PKW(P1,14), pw3); \
    l_reg+=sacc; \
    if(GK){DMA_K((t)+3,sl_cur);} if(GV){DMA_V((t)+1,sl_next);} \
    CMASK(C0,C1,t); \
    { float a=MX3(C0[0],C0[1],C1[0]),b=MX3(C0[2],C0[3],C1[1]); a=MX3(a,C1[2],C1[3]); \
      _Pragma("unroll") for(int r=4;r<16;r+=4){a=MX3(a,C0[r],C0[r+1]);b=MX3(b,C0[r+2],C0[r+3]);a=MX3(a,C1[r],C1[r+1]);b=MX3(b,C1[r+2],C1[r+3]);} \
      float rm=__builtin_fmaxf(a,b); { auto rr=__builtin_amdgcn_permlane32_swap(__float_as_uint(rm),__float_as_uint(rm),false,false); rm=__builtin_fmaxf(__uint_as_float(rr[0]),__uint_as_float(rr[1])); } \
      rm=st_?rm:(-__builtin_huge_valf()); const float rel_=rm-mhat; \
      resc=false; \
      if(__builtin_expect(__any(rel_>(float)THRL),0)){ const float dl=__builtin_fmaxf(rel_,0.f); mhat+=dl; \
        const float f=__builtin_amdgcn_exp2f(-dl); l_reg*=f; if(hi==0)wsf[r32]=f; resc=true; } } \
    msub_=st_?mhat:__builtin_huge_valf(); \
    SBAR(); \
    GAPB(o[0]=MFMAH(PAF(0),VFR(0),o[0]), C0,0); \
    GAPB(o[1]=MFMAH(PAF(0),VFR(4),o[1]), C0,4); \
    KRD(GL,0); GAPB(o[0]=MFMAH(PAF(1),VFR(1),o[0]), C0,8); \
    KRD(GL,1); GAPB(o[1]=MFMAH(PAF(1),VFR(5),o[1]), C0,12); \
    KRD(GL,2); GAPB(o[0]=MFMAH(PAF(2),VFR(2),o[0]), C1,0); \
    KRD(GL,3); GAPB(o[1]=MFMAH(PAF(2),VFR(6),o[1]), C1,4); \
    GAPB(o[0]=MFMAH(PAF(3),VFR(3),o[0]), C1,8); \
    GAPB(o[1]=MFMAH(PAF(3),VFR(7),o[1]), C1,12); \
    }while(0)
  int t=1;
  for(;t+5<NT;t+=2){
    STEP(pB0,pB1,pA0,pA1,t,true,true,true);     WAIT_BAR(2); RESC(); ROT();
    STEP(pA0,pA1,pB0,pB1,t+1,true,true,true);   WAIT_BAR(2); RESC(); ROT();
  }
  #define ENDW(tt) do{ if((tt)+3<NT){WAIT_BAR(2);} else if((tt)+2<NT){WAIT_BAR(1);} else {WAIT_BAR(0);} }while(0)
  for(;t+1<NT;t+=2){
    STEP(pB0,pB1,pA0,pA1,t,(t+3<NT),(t+1<NT),(t+1<NT));       ENDW(t);   RESC(); ROT();
    STEP(pA0,pA1,pB0,pB1,t+1,(t+4<NT),(t+2<NT),(t+2<NT));     ENDW(t+1); RESC(); ROT();
  }
  STEP(pB0,pB1,pA0,pA1,NT-1,false,false,false); RESC();
  { float sacc=pB0[0]+pB0[1]; _Pragma("unroll") for(int r=2;r<16;++r)sacc+=pB0[r]; _Pragma("unroll") for(int r=0;r<16;++r)sacc+=pB1[r]; l_reg+=sacc;
    pw0=(u32x4){PKW(pB0,0),PKW(pB0,2),PKW(pB0,4),PKW(pB0,6)};pw1=(u32x4){PKW(pB0,8),PKW(pB0,10),PKW(pB0,12),PKW(pB0,14)};pw2=(u32x4){PKW(pB1,0),PKW(pB1,2),PKW(pB1,4),PKW(pB1,6)};pw3=(u32x4){PKW(pB1,8),PKW(pB1,10),PKW(pB1,12),PKW(pB1,14)};
    SBAR(); pv(o,vb0+sl_cur,PAF(0),PAF(1),PAF(2),PAF(3)); }
  #undef PKW
  #undef PAF
  #undef VFR
  #undef PIN
  #undef MX3
  #undef GAPA
  #undef GAPB
  #undef EX
  #undef VRD
  #undef KRD
  #undef STEP
  #undef ENDW
  {auto rr=__builtin_amdgcn_permlane32_swap(__float_as_uint(l_reg),__float_as_uint(l_reg),false,false);l_reg=__uint_as_float(rr[0])+__uint_as_float(rr[1]);}
  if(hi==0)wsf[32+r32]=l_reg;asm volatile("s_waitcnt lgkmcnt(0)":::"memory");
  float rli[16];
  #pragma unroll
  for(int r=0;r<16;++r)rli[r]=__builtin_amdgcn_rcpf(wsf[32+crow(r,hi)]);
  bf16*Ow=O+(rowbase+q0+wid*QBLK)*OPITCH+OCOL+h*D;
  { bf16*stg=(bf16*)(shm+LDS_OST)+wid*2048;
    #pragma unroll
    for(int r=0;r<16;++r){const int orow=crow(r,hi);
      #pragma unroll
      for(int d0=0;d0<2;++d0)stg[orow*64+d0*32+r32]=(bf16)(o[d0][r]*rli[r]);}
    asm volatile("s_waitcnt lgkmcnt(0)":::"memory");
    #pragma unroll
    for(int i=0;i<4;++i){const int row=i*8+(lane>>3),ch=lane&7; const u32x4 v=*(const u32x4*)(stg+row*64+ch*8); ATTN_STORE16(Ow+(long)row*OPITCH+ch*8,v);} }
  asm volatile("s_waitcnt lgkmcnt(0)\n\ts_barrier":::"memory");
  #undef DMA_K
  #undef DMA_V
  #undef CMASK
  #undef START
  #undef RESC
  #undef ROT
}
constexpr int ATTN_LDS_BYTES=LDS_BYTES;
#undef KT
#undef MFMAH
#undef SBAR
#undef WAIT_BAR
}


constexpr int MBF_KM = 86016;
__device__ __forceinline__ void moba_unit_fast(char* lds_gen, LAS unsigned char* lds, const AttnPtrs& P, int b, int h, int j, const int wid) {
    const int lane = lane_id_fresh(), tid = wid * 64 + lane, r32 = lane & 31, hi = lane >> 5;
    const size_t qrow = (size_t)b * SEQ + 256 * j + 32 * wid + r32;
    LAS float* km = (LAS float*)(lds + MBF_KM);
    for (int i = tid; i < 16 * 64; i += 512) { const int n = i >> 6, d = i & 63; const size_t pm = (size_t)b * 16 + n;
        km[i] = (P.kmp[((pm * 2 + 0) * 8 + h) * 64 + d] + P.kmp[((pm * 2 + 1) * 8 + h) * 64 + d]) * (1.0f / 256.0f); }
    __syncthreads();
    unsigned selmask = 0u;
    {
        float gate[8];
#pragma unroll
        for (int nb = 0; nb < 8; ++nb) gate[nb] = 0.f;
#pragma unroll
        for (int c8 = 0; c8 < 8; ++c8) {
            const h16x8 qv = *(const h16x8*)(P.QB + qrow * 512 + h * 64 + c8 * 8);
#pragma unroll
            for (int nb = 0; nb < 8; ++nb) { const LAS float* kr = km + (8 * hi + nb) * 64 + c8 * 8;
#pragma unroll
                for (int e = 0; e < 8; ++e) gate[nb] += (float)qv[e] * kr[e]; }
        }
        float gall[16];
#pragma unroll
        for (int nb = 0; nb < 8; ++nb) { const float o = __shfl_xor(gate[nb], 32); gall[nb] = hi ? o : gate[nb]; gall[8 + nb] = hi ? gate[nb] : o; }
#pragma unroll
        for (int n = 0; n < 16; ++n) if (n >= j) gall[n] = NEG_INF;
#pragma unroll
        for (int pick = 0; pick < 3; ++pick) { float best = NEG_INF; int bi = -1;
#pragma unroll
            for (int n = 0; n < 16; ++n) if (gall[n] > best) { best = gall[n]; bi = n; }
            if (bi >= 0) { selmask |= 1u << bi;
#pragma unroll
                for (int n = 0; n < 16; ++n) if (n == bi) gall[n] = NEG_INF; } }
    }
    moba_fast::attn_unit<8>(b, h, j, (const _Float16*)P.QB, (const _Float16*)P.KB, (const _Float16*)P.VB, (_Float16*)P.Y, lds_gen, selmask, wid);
}

#define XB_TMO      128
#define XB_XCNT(j)  (256  + 64 * (j))
#define XB_XSUB(j)  (1280 + 64 * (j))
#define XB_XGEN(j)  (2304 + 64 * (j))
#define XB_TOP      3328
#define XB_TOPGEN   3392
#define XCD_BAR_WORDS 3456
#define XB_SPIN_CAP (1u << 22)
__device__ __forceinline__ unsigned xb_ld(unsigned* p)              { return __hip_atomic_load(p, __ATOMIC_RELAXED, __HIP_MEMORY_SCOPE_AGENT); }
__device__ __forceinline__ unsigned xb_add(unsigned* p, unsigned v) { return __hip_atomic_fetch_add(p, v, __ATOMIC_RELAXED, __HIP_MEMORY_SCOPE_AGENT); }
__device__ __forceinline__ unsigned xb_xcc_id() { return (unsigned)__builtin_amdgcn_s_getreg((3 << 11) | 20) & 0xFu; }
#define XB_SPIN(cond, bar) do { unsigned _sp = 0; while (cond) { __builtin_amdgcn_s_sleep(1); \
    if ((++_sp & 255u) == 0u) { if (xb_ld(&(bar)[XB_TMO])) break; if (_sp > XB_SPIN_CAP) { atomicAdd(&(bar)[XB_TMO], 1u); break; } } } } while (0)
struct XcdBarrier { unsigned* bar; unsigned x; volatile LAS unsigned* st; };
__device__ __forceinline__ XcdBarrier xcd_barrier_post(unsigned* bar, volatile LAS unsigned* st) {
    XcdBarrier b; b.bar = bar; b.x = xb_xcc_id(); b.st = st;
    if (threadIdx.x == 0) (void)xb_add(&bar[XB_XCNT(b.x)], 1u);
    return b;
}
__device__ __forceinline__ void xcd_barrier_complete(unsigned* bar, unsigned x, unsigned& nloc, unsigned& nx) {
    const unsigned G = gridDim.x * gridDim.y * gridDim.z;
    unsigned sum, cnt, mine, sp = 0u;
    for (;;) {
        sum = 0u; cnt = 0u; mine = 0u;
#pragma unroll
        for (unsigned j = 0; j < 16; ++j) { const unsigned c = xb_ld(&bar[XB_XCNT(j)]); sum += c; cnt += (c > 0u) ? 1u : 0u; mine = (j == x) ? c : mine; }
        if (sum == G) break;
        __builtin_amdgcn_s_sleep(1);
        if ((++sp & 255u) == 0u) { if (xb_ld(&bar[XB_TMO])) break; if (sp > XB_SPIN_CAP) { atomicAdd(&bar[XB_TMO], 1u); break; } }
    }
    nloc = mine > 0u ? mine : 1u; nx = cnt > 0u ? cnt : 1u;
}
__device__ __forceinline__ void xcd_barrier(const XcdBarrier& b) {
    asm volatile("s_waitcnt vmcnt(0)" ::: "memory");
    __syncthreads();
    if (threadIdx.x == 0) {
        unsigned* bar = b.bar;
        __builtin_amdgcn_s_waitcnt(0);
        unsigned nloc = b.st[0], nx = b.st[1];
        if (nloc == 0u) { xcd_barrier_complete(bar, b.x, nloc, nx); b.st[0] = nloc; b.st[1] = nx; }
        const unsigned old = xb_add(&bar[XB_XSUB(b.x)], 1u);
        const unsigned gen = old / nloc;
        if (old + 1u == (gen + 1u) * nloc) {
            __builtin_amdgcn_fence(__ATOMIC_RELEASE, "agent");
            asm volatile("s_waitcnt vmcnt(0)" ::: "memory");
            const unsigned og = xb_add(&bar[XB_TOP], 1u);
            const unsigned tg = og / nx;
            if (og + 1u == (tg + 1u) * nx) xb_add(&bar[XB_TOPGEN], 1u);
            else XB_SPIN(xb_ld(&bar[XB_TOPGEN]) == tg, bar);
            __builtin_amdgcn_fence(__ATOMIC_ACQUIRE, "agent");
            xb_add(&bar[XB_XGEN(b.x)], 1u);
            asm volatile("s_waitcnt vmcnt(0)" ::: "memory");
        } else {
            XB_SPIN(xb_ld(&bar[XB_XGEN(b.x)]) == gen, bar);
            __builtin_amdgcn_fence(__ATOMIC_ACQUIRE, "agent");
            asm volatile("s_waitcnt vmcnt(0)" ::: "memory");
        }
    }
    __syncthreads();
}

constexpr int LDS_BYTES = 147456;
struct Args { const float* in[14]; float* out; unsigned char* ws; int ph_lo, ph_hi; };

__global__ void __launch_bounds__(512, 2) hymba_fwd(Args args) {
    extern __shared__ __attribute__((aligned(16))) unsigned char lds_raw[];
    LAS unsigned char* lds = (LAS unsigned char*)lds_raw;
    cg::grid_group grid = cg::this_grid();
    const int tid = threadIdx.x, lane = tid & 63, wave = __builtin_amdgcn_readfirstlane(tid >> 6);
    const int G = gridDim.x, bx = blockIdx.x;
    unsigned char* ws = args.ws;
    const float* x = args.in[0]; const float* p_in = args.in[1]; const float* g_attn = args.in[2]; const float* w_in = args.in[3]; const float* g_idx = args.in[4];
    const float* w_out = args.in[5]; const float* g_ffn = args.in[6]; const float* w_gate = args.in[7]; const float* w_up = args.in[8]; const float* w_down = args.in[9];
    const float* g_ple = args.in[10]; const float* w_pg = args.in[11]; const float* w_pp = args.in[12]; const float* g_final = args.in[13];
    h16* Wt_in = (h16*)(ws + WS_WIN); h16* Wt_out = (h16*)(ws + WS_WOUT); h16* Wt_gu = (h16*)(ws + WS_WGU); h16* Wt_dn = (h16*)(ws + WS_WDN); h16* Wt_pg = (h16*)(ws + WS_WPG); h16* Wt_pp = (h16*)(ws + WS_WPP);
    float* rope = (float*)(ws + WS_ROPE); float* rs0 = (float*)(ws + WS_RS0); float* ssp1 = (float*)(ws + WS_SSP1); float* ssp2 = (float*)(ws + WS_SSP2); float* ssp3 = (float*)(ws + WS_SSP3);
    float* kmp = (float*)(ws + WS_KMP); float* WI = (float*)(ws + WS_WI);
    h16* PH = (h16*)(ws + WS_PH); h16* PP = (h16*)(ws + WS_PP); h16* XH = (h16*)(ws + WS_XH); h16* H1 = XH; h16* H3 = XH; h16* Y = (h16*)(ws + WS_Y); h16* H2 = Y;
    h16* QA = (h16*)(ws + WS_QA); h16* KA = (h16*)(ws + WS_KA); h16* VA = (h16*)(ws + WS_VA); h16* QI = (h16*)(ws + WS_QI); h16* KI = (h16*)(ws + WS_KI);
    h16* QB = (h16*)(ws + WS_QB); h16* KB = (h16*)(ws + WS_KB); h16* VB = (h16*)(ws + WS_VB); h16* ACT = (h16*)(ws + WS_ACT);
    const int lo = args.ph_lo, hi_ph = args.ph_hi;
#ifndef PH_MASK
#define PH_MASK 0xff
#endif
#define IN(k) (((PH_MASK >> (k)) & 1) && lo <= (k) && (k) < hi_ph)
    volatile LAS unsigned* MISC = (volatile LAS unsigned*)(lds + LDS_BYTES - 256);
    unsigned* barw = (unsigned*)(ws + 0);
    XcdBarrier xbar; xbar.bar = barw; xbar.x = 0; xbar.st = MISC;
#define SEAM(k) do { if (IN(k) && IN((k) + 1)) xcd_barrier(xbar); } while (0)
    if (args.ph_lo < 0) grid.sync();
    if (tid == 0) { MISC[0] = 0u; MISC[1] = 0u; }
    __syncthreads();
    xbar = xcd_barrier_post(barw, MISC);
#ifdef PROBE_PH
    unsigned long long pr_t0 = 0ull, pr_dt = 0ull;
#define PR_BEGIN(k) do { if ((k) == PROBE_PH) pr_t0 = __builtin_amdgcn_s_memrealtime(); } while (0)
#define PR_END(k) do { if ((k) == PROBE_PH) pr_dt = __builtin_amdgcn_s_memrealtime() - pr_t0; } while (0)
#else
#define PR_BEGIN(k) do {} while (0)
#define PR_END(k) do {} while (0)
#endif
    PR_BEGIN(0);
    if (IN(0)) for (int rep_ph = 0; rep_ph < 1 + (REPMASK & 1); ++rep_ph) {
        LAS float* scr = (LAS float*)(lds + wave * 16384);
        const int gw = bx * 8 + wave, NGW = G * 8;
        transpose_items(DM, NIN_SRC, Wt_in, NIN, [=](int np) -> const float* { const int c = win_colmap(np); return c >= 0 ? w_in + c : nullptr; }, g_attn, scr, gw, NGW, lane);
        transpose_items(DM, DM, Wt_out, DM, [=](int np) -> const float* { return w_out + np; }, nullptr, scr, gw, NGW, lane);
        transpose_items(DM, DFF, Wt_gu, 2 * DFF, [=](int np) -> const float* { const int p = np & 255, t = np >> 8; return (p < 128) ? (w_gate + t * 128 + p) : (w_up + t * 128 + p - 128); }, g_ffn, scr, gw, NGW, lane);
        transpose_items(DFF, DM, Wt_dn, DM, [=](int np) -> const float* { return w_down + np; }, nullptr, scr, gw, NGW, lane);
        transpose_items(DM, DM, Wt_pg, DM, [=](int np) -> const float* { return w_pg + np; }, g_ple, scr, gw, NGW, lane);
        transpose_items(DPLE, DM, Wt_pp, DM, [=](int np) -> const float* { return w_pp + np; }, nullptr, scr, gw, NGW, lane);
        for (int m0 = 2 * gw; m0 < NTOK; m0 += 2 * NGW) {
            f32x4 v[2][4]; float s[2];
#pragma unroll
            for (int r2 = 0; r2 < 2; ++r2) { const f32x4* xr = (const f32x4*)(x + (size_t)(m0 + r2) * DM) + lane;
#pragma unroll
                for (int jj = 0; jj < 4; ++jj) v[r2][jj] = __builtin_nontemporal_load(xr + 64 * jj); }
#pragma unroll
            for (int r2 = 0; r2 < 2; ++r2) { float t = 0.f;
#pragma unroll
                for (int jj = 0; jj < 4; ++jj) t += (v[r2][jj].x * v[r2][jj].x + v[r2][jj].y * v[r2][jj].y) + (v[r2][jj].z * v[r2][jj].z + v[r2][jj].w * v[r2][jj].w);
                s[r2] = wave_sum(t); }
#pragma unroll
            for (int r2 = 0; r2 < 2; ++r2) {
                if (lane == 0) rs0[m0 + r2] = 1.0f / sqrtf(s[r2] * (1.0f / DM) + EPS);
                u32x2* o8 = (u32x2*)(XH + (size_t)(m0 + r2) * DM) + lane;
#pragma unroll
                for (int jj = 0; jj < 4; ++jj) { u32x2 w; w.x = pkh(v[r2][jj].x, v[r2][jj].y); w.y = pkh(v[r2][jj].z, v[r2][jj].w); o8[64 * jj] = w; } }
        }
        for (int m0 = 4 * gw; m0 < NTOK; m0 += 4 * NGW) {
            f32x4 v[4];
#pragma unroll
            for (int r4 = 0; r4 < 4; ++r4) v[r4] = __builtin_nontemporal_load((const f32x4*)(p_in + (size_t)(m0 + r4) * DPLE) + lane);
#pragma unroll
            for (int r4 = 0; r4 < 4; ++r4) { u32x2 w; w.x = pkh(v[r4].x, v[r4].y); w.y = pkh(v[r4].z, v[r4].w); *((u32x2*)(PH + (size_t)(m0 + r4) * DPLE) + lane) = w; }
        }
        for (int i = bx * 512 + tid; i < SEQ * 32; i += G * 512) {
            const int pos = i >> 5, jx = i & 31;
            const float inv = ROPE_INV[jx];
            const float ang = (float)pos * inv;
            const double a = (double)ang; const double kq = __builtin_rint(a * 0.15915494309189535);
            double r = __builtin_fma(-kq, 6.283185307179586, a); r = __builtin_fma(-kq, 2.4492935982947064e-16, r);
            const double r2 = r * r; double sn = 0.0, cs = 0.0;
            double ts = 1.0, tc = 1.0;
#pragma unroll
            for (int n = 13; n >= 1; --n) { ts = 1.0 - ts * r2 / (double)((2 * n) * (2 * n + 1)); tc = 1.0 - tc * r2 / (double)((2 * n - 1) * (2 * n)); }
            sn = r * ts; cs = tc;
            rope[(size_t)i * 2] = (float)cs; rope[(size_t)i * 2 + 1] = (float)sn;
        }
    }
    SEAM(0);
    PR_END(0);
    PR_BEGIN(1);
    if (IN(1)) for (int rep_ph = 0; rep_ph < 1 + ((REPMASK >> 1) & 1); ++rep_ph) {
        { pg8::Gemm g{XH, Wt_in, NTOK, NIN, DM}; pg8::StaticOrder S; S.init(NTOK, NIN, G, bx);
          pg8::EpiInProj E{rs0, rope, g_idx, QA, KA, VA, QI, KI, QB, KB, VB, WI, kmp};
          pg8::gemm_phase(lds, g, S, E); }
        { pg8::Gemm g{PH, Wt_pp, NTOK, DM, DPLE}; pg8::StaticOrder S; S.init(NTOK, DM, G, bx);
          pg8::EpiPlain E{PP, DM};
          pg8::gemm_phase(lds, g, S, E); }
    }
    SEAM(1);
    PR_END(1);
    PR_BEGIN(2);
    if (IN(2)) {
        AttnPtrs P{QA, KA, VA, QI, KI, QB, KB, VB, WI, kmp, Y};
        const int b = bx & 7, r = bx >> 3;
        const int nr = G >> 3;
#ifndef NO_DSA
        for (int rep = 0; rep < REP_DSA; ++rep)
        for (int s = r; s < 128; s += nr) { dsa_unit(lds, P, b, s, wave); dsa_unit(lds, P, b, 255 - s, wave); }
#endif
#ifndef NO_MOBA
        for (int rep = 0; rep < REP_MOBA; ++rep)
        for (int uu = r; uu < 64; uu += nr) { const int h = uu >> 3, s = uu & 7; moba_unit_fast((char*)lds_raw, lds, P, b, h, s, wave); moba_unit_fast((char*)lds_raw, lds, P, b, h, 15 - s, wave); }
#endif
    }
    SEAM(2);
    PR_END(2);
    PR_BEGIN(3);
    if (IN(3)) for (int rep_ph = 0; rep_ph < 1 + ((REPMASK >> 3) & 1); ++rep_ph) {
        pg8::Gemm g{Y, Wt_out, NTOK, DM, DM}; pg8::StaticOrder S; S.init(NTOK, DM, G, bx);
        pg8::EpiRes<false> E{XH, H1, ssp1};
        pg8::gemm_phase(lds, g, S, E);
    }
    SEAM(3);
    PR_END(3);
    PR_BEGIN(4);
    if (IN(4)) for (int rep_ph = 0; rep_ph < 1 + ((REPMASK >> 4) & 1); ++rep_ph) {
        pg8::Gemm g{H1, Wt_gu, NTOK, 2 * DFF, DM}; pg8::StaticOrder S; S.init(NTOK, 2 * DFF, G, bx);
        pg8::EpiSwiGLU E{ssp1, ACT};
        pg8::gemm_phase(lds, g, S, E);
    }
    SEAM(4);
    PR_END(4);
    PR_BEGIN(5);
    if (IN(5)) for (int rep_ph = 0; rep_ph < 1 + ((REPMASK >> 5) & 1); ++rep_ph) {
        pg8::Gemm g{ACT, Wt_dn, NTOK, DM, DFF}; pg8::StaticOrder S; S.init(NTOK, DM, G, bx);
        pg8::EpiRes<false> E{H1, H2, ssp2};
        pg8::gemm_phase(lds, g, S, E);
    }
    SEAM(5);
    PR_END(5);
    PR_BEGIN(6);
    if (IN(6)) for (int rep_ph = 0; rep_ph < 1 + ((REPMASK >> 6) & 1); ++rep_ph) {
        pg8::Gemm g{H2, Wt_pg, NTOK, DM, DM}; pg8::StaticOrder S; S.init(NTOK, DM, G, bx);
        pg8::EpiPLE E{ssp2, H2, PP, H3, ssp3};
        pg8::gemm_phase(lds, g, S, E);
    }
    SEAM(6);
    PR_END(6);
    PR_BEGIN(7);
    if (IN(7)) {
        const int gw = bx * 8 + wave, NGW = G * 8;
        f32x4 gf[2][2];
#pragma unroll
        for (int hh = 0; hh < 2; ++hh) { gf[hh][0] = *(const f32x4*)(g_final + 512 * hh + 8 * lane); gf[hh][1] = *(const f32x4*)(g_final + 512 * hh + 8 * lane + 4); }
        for (int m = gw; m < NTOK; m += NGW) {
            const float s = pg8::row_rstd(ssp3, m);
#pragma unroll
            for (int hh = 0; hh < 2; ++hh) {
                const h16x8 hv = *(const h16x8*)(H3 + (size_t)m * DM + 512 * hh + 8 * lane);
                float* o = args.out + (size_t)m * DM + 512 * hh + 8 * lane;
                f32x4 v0 = {(float)hv[0], (float)hv[1], (float)hv[2], (float)hv[3]}, v1 = {(float)hv[4], (float)hv[5], (float)hv[6], (float)hv[7]};
                v0 = v0 * s * gf[hh][0]; v1 = v1 * s * gf[hh][1];
                *(f32x4*)o = v0; *(f32x4*)(o + 4) = v1;
            }
        }
    }
    PR_END(7);
#ifdef PROBE_PH
    if (bx == 0 && wave == 0) { const unsigned long long te = __builtin_amdgcn_s_memrealtime(); while (__builtin_amdgcn_s_memrealtime() - te < (unsigned long long)PROBE_MULT * pr_dt) __builtin_amdgcn_s_sleep(8); }
#endif
#undef IN
#undef SEAM
}

extern "C" void kernel_launch(void* const* d_in, const int* in_sizes, int n_in, void* d_out, int out_size, void* d_ws, size_t ws_size, hipStream_t stream) {
    static int grid = 0;
    if (grid == 0) {
        if (n_in != 14 || out_size != NTOK * DM || ws_size < WS_END) { fprintf(stderr, "kernel_launch: unexpected shapes (n_in %d out %d ws %zu)\n", n_in, out_size, ws_size); grid = -1; return; }
        int dev = 0, cus = 0, per_cu = 0;
        (void)hipGetDevice(&dev);
        (void)hipDeviceGetAttribute(&cus, hipDeviceAttributeMultiprocessorCount, dev);
        (void)hipFuncSetAttribute((const void*)hymba_fwd, hipFuncAttributeMaxDynamicSharedMemorySize, LDS_BYTES);
        (void)hipOccupancyMaxActiveBlocksPerMultiprocessor(&per_cu, (const void*)hymba_fwd, 512, LDS_BYTES);
        if (per_cu < 1) { fprintf(stderr, "kernel_launch: occupancy query says %d blocks/CU\n", per_cu); }
        grid = cus;
        if (grid % 8 != 0 || grid > 256) grid = (grid / 8) * 8 > 256 ? 256 : (grid / 8) * 8;
    }
    if (grid <= 0) return;
    (void)hipMemsetAsync(d_ws, 0, 16384, stream);
    Args a{};
    for (int i = 0; i < 14; ++i) a.in[i] = (const float*)d_in[i];
    a.out = (float*)d_out; a.ws = (unsigned char*)d_ws;
#if MK_COOP
    a.ph_lo = 0; a.ph_hi = 8;
    void* kargs[] = {&a};
    hipError_t e = hipLaunchCooperativeKernel((const void*)hymba_fwd, dim3(grid), dim3(512), kargs, LDS_BYTES, stream);
    if (e != hipSuccess) fprintf(stderr, "cooperative launch failed: %s (grid %d)\n", hipGetErrorString(e), grid);
#else
    for (int ph = 0; ph < 8; ++ph) { a.ph_lo = ph; a.ph_hi = ph + 1; hipLaunchKernelGGL(hymba_fwd, dim3(grid), dim3(512), LDS_BYTES, stream, a); }
#endif
}
```

```cpp
#include <hip/hip_runtime.h>
#include <hip/hip_cooperative_groups.h>
#include <cstdio>
#include <cstdint>
#include <cmath>
namespace cg = cooperative_groups;

#ifndef REP_DSA
#define REP_DSA 1
#endif
#ifndef REP_MOBA
#define REP_MOBA 1
#endif
#ifndef REP_ATT
#define REP_ATT 1
#endif
#ifndef REP_SC
#define REP_SC 1
#endif
#ifndef REP_SEL
#define REP_SEL 1
#endif
#ifndef REP_EM
#define REP_EM 1
#endif
#ifndef REPMASK
#define REPMASK 0
#endif
#ifndef REP_BIS
#define REP_BIS 1
#endif
#ifndef PROBE_MULT
#define PROBE_MULT 4
#endif
#ifndef MK_COOP
#define MK_COOP 1
#endif

#define LAS __attribute__((address_space(3)))
typedef _Float16 h16;
typedef _Float16 h16x8 __attribute__((ext_vector_type(8)));
typedef _Float16 h16x4 __attribute__((ext_vector_type(4)));
typedef _Float16 h16x2 __attribute__((ext_vector_type(2)));
typedef short s16x8 __attribute__((ext_vector_type(8)));
typedef short s16x4 __attribute__((ext_vector_type(4)));
typedef float f32x2 __attribute__((ext_vector_type(2)));
typedef float f32x4 __attribute__((ext_vector_type(4)));
typedef float f32x16 __attribute__((ext_vector_type(16)));
typedef unsigned u32x2 __attribute__((ext_vector_type(2)));
typedef unsigned u32x4 __attribute__((ext_vector_type(4)));

constexpr int BATCH = 8, SEQ = 4096, DM = 1024, NTOK = BATCH * SEQ, NIN = 2560, NIN_SRC = 2500, DFF = 2816, DPLE = 256;
constexpr float EPS = 1e-6f;
constexpr float C2 = 0.125f * 1.4426950408889634f;
constexpr float NEG_INF = -__builtin_huge_valf();

constexpr size_t MiB = 1u << 20;
constexpr size_t WS_WIN = 1 * MiB, WS_WOUT = 6 * MiB, WS_WGU = 8 * MiB, WS_WDN = 19 * MiB, WS_WPG = 25 * MiB, WS_WPP = 27 * MiB;
constexpr size_t WS_ROPE = 28 * MiB, WS_RS0 = 29 * MiB, WS_SSP1 = 30 * MiB, WS_SSP2 = 32 * MiB, WS_SSP3 = 34 * MiB, WS_KMP = 36 * MiB, WS_WI = 37 * MiB;
constexpr size_t WS_PH = 38 * MiB, WS_PP = 54 * MiB, WS_XH = 118 * MiB  , WS_Y = 182 * MiB  ;
constexpr size_t WS_QA = 246 * MiB, WS_KA = 278 * MiB, WS_VA = 282 * MiB, WS_QI = 286 * MiB, WS_KI = 302 * MiB, WS_QB = 306 * MiB, WS_KB = 338 * MiB, WS_VB = 370 * MiB;
constexpr size_t WS_ACT = 246 * MiB  , WS_END = 422 * MiB;

__constant__ float ROPE_INV[32] = {0x1.0000000000000p+0f, 0x1.7ff2220000000p-1f, 0x1.1feb340000000p-1f, 0x1.afd1360000000p-2f, 0x1.43d1360000000p-2f, 0x1.e5a8480000000p-3f, 0x1.6c310e0000000p-3f, 0x1.111aee0000000p-3f,
    0x1.99999a0000000p-4f, 0x1.33281c0000000p-4f, 0x1.ccab860000000p-5f, 0x1.59742a0000000p-5f, 0x1.030dc40000000p-5f, 0x1.8486a00000000p-6f, 0x1.235a720000000p-6f, 0x1.b4f7e20000000p-7f,
    0x1.47ae140000000p-7f, 0x1.eb73600000000p-8f, 0x1.7089380000000p-8f, 0x1.145cee0000000p-8f, 0x1.9e7c6e0000000p-9f, 0x1.36d21a0000000p-9f, 0x1.d22a500000000p-10f, 0x1.5d931c0000000p-10f,
    0x1.0624de0000000p-10f, 0x1.8929180000000p-11f, 0x1.26d42c0000000p-11f, 0x1.ba2e4c0000000p-12f, 0x1.4b96be0000000p-12f, 0x1.f150280000000p-13f, 0x1.74eea60000000p-13f, 0x1.17a8e40000000p-13f};
__device__ __forceinline__ int lane_id_fresh() { int l; asm volatile("v_mbcnt_lo_u32_b32 %0, -1, 0\n\tv_mbcnt_hi_u32_b32 %0, -1, %0" : "=v"(l)); return l; }
__device__ __forceinline__ unsigned pkh(float lo, float hi) { h16x2 v = {(h16)lo, (h16)hi}; return __builtin_bit_cast(unsigned, v); }
__device__ __forceinline__ float wave_sum(float v) {
#pragma unroll
    for (int o = 1; o < 64; o <<= 1) v += __shfl_xor(v, o);
    return v;
}
__device__ __forceinline__ float fast_sigmoid(float x) { return __builtin_amdgcn_rcpf(1.0f + __builtin_amdgcn_exp2f(-1.4426950408889634f * x)); }

namespace pg8 {
constexpr int BM = 256, BK = 64, HALF = 128, HTB = HALF * BK * 2, STAGE_BYTES = 8 * HTB, NXCD = 8, WGM = 8;
__host__ __device__ __forceinline__ int lds_byte(int r, int c) { const int st = (r >> 4) * 2 + (c >> 5), rr = r & 15, cc = c & 31, ob = rr * 64 + cc * 2; return st * 1024 + (ob ^ (((ob >> 9) & 1) << 5)); }
__host__ __device__ __forceinline__ void stage_rc(int b, int& R, int& C) { const int st = b / 1024, sb = b % 1024, swz = sb ^ (((sb >> 9) & 1) << 5); R = (st >> 1) * 16 + swz / 64; C = (st & 1) * 32 + (swz % 64) / 2; }
__host__ __device__ __forceinline__ int perm32(int rho) { const int n = rho >> 4, i = rho & 15; return 8 * (i >> 2) + 4 * n + (i & 3); }
struct Unit { int pm, pn; };
struct Gemm { const h16* A; const h16* Bt; int M, N, K; };
struct StaticOrder {
    int nM, nN, nwg, G, c;
    __host__ __device__ void init(int M, int N, int G_, int c_) { nM = M / BM; nN = N / BM; nwg = nM * nN; G = G_; c = c_; }
    __host__ __device__ bool next(int i, Unit& u) const {
        const long L = (long)i * G + c; if (L >= nwg) return false;
        int wgid = (int)L; { const int q = nwg / NXCD, r = nwg % NXCD, xcd = wgid % NXCD, off = wgid / NXCD; wgid = (xcd < r ? xcd * (q + 1) : r * (q + 1) + (xcd - r) * q) + off; }
        const int nig = WGM * nN, gid = wgid / nig, fm = gid * WGM, gsz = (nM - fm) < WGM ? (nM - fm) : WGM;
        u.pm = fm + ((wgid % nig) % gsz); u.pn = (wgid % nig) / gsz; return true;
    }
};
template <class Epi>
__device__ __forceinline__ void gemm_phase(LAS unsigned char* lds, const Gemm g, const StaticOrder& S, const Epi& E) {
    const int tid = threadIdx.x, wid = __builtin_amdgcn_readfirstlane(tid >> 6), lane = tid & 63, wr = wid >> 2, wc = wid & 3, fr = lane & 15, fq = lane >> 4;
    const int K = g.K, nt = K / BK;
    unsigned voffA[2], voffB[2];
#pragma unroll
    for (int i = 0; i < 2; ++i) { int R, C; stage_rc(tid * 16 + i * 8192, R, C); const int Rb = (R & ~31) + perm32(R & 31);
        voffA[i] = (unsigned)(R * K + C) * 2u; voffB[i] = (unsigned)(Rb * K + C) * 2u; }
    const size_t kstep = (size_t)(BK * 2);
    const size_t hstep = (size_t)HALF * K * 2;
    const size_t tstep = 2 * hstep;
    const unsigned ldsw = (unsigned)wid * 1024u;
    const int aoff = lds_byte(wr * 64 + fr, fq * 8), boff = lds_byte(wc * 32 + fr, fq * 8);
#define PG8_SA(b, h) (((b) * 2 + (h)) * HTB)
#define PG8_SB(b, h) ((4 + (b) * 2 + (h)) * HTB)
#define PG8_STAGE(bufoff, gbase, voff) do { _Pragma("unroll") for (int _i = 0; _i < 2; ++_i) \
        __builtin_amdgcn_global_load_lds((const unsigned*)((const char*)(gbase) + (voff)[_i]), (LAS unsigned*)(lds + (bufoff) + ldsw + _i * 8192), 16, 0, 0); } while (0)
#define PG8_LDA(dst, b, h) do { _Pragma("unroll") for (int m = 0; m < 4; ++m) _Pragma("unroll") for (int k = 0; k < 2; ++k) dst[m][k] = *(const LAS s16x8*)(lds + PG8_SA(b, h) + aoff + m * 2048 + k * 1024); } while (0)
#define PG8_LDB(dst, b, h) do { _Pragma("unroll") for (int n = 0; n < 2; ++n) _Pragma("unroll") for (int k = 0; k < 2; ++k) dst[n][k] = *(const LAS s16x8*)(lds + PG8_SB(b, h) + boff + n * 2048 + k * 1024); } while (0)
#define PG8_MMA(ai, bj, At, Bt) do { __builtin_amdgcn_s_setprio(1); _Pragma("unroll") for (int m = 0; m < 4; ++m) _Pragma("unroll") for (int n = 0; n < 2; ++n) _Pragma("unroll") for (int k = 0; k < 2; ++k) \
        acc[ai][bj][m][n] = __builtin_amdgcn_mfma_f32_16x16x32_f16(__builtin_bit_cast(h16x8, Bt[n][k]), __builtin_bit_cast(h16x8, At[m][k]), acc[ai][bj][m][n], 0, 0, 0); __builtin_amdgcn_s_setprio(0); } while (0)
#define PG8_WAIT_V(n) asm volatile("s_waitcnt vmcnt(" #n ")" ::: "memory")
#define PG8_WAIT_L(n) asm volatile("s_waitcnt lgkmcnt(" #n ")" ::: "memory")
#define PG8_BAR __builtin_amdgcn_s_barrier()
#define PG8_SCHED __builtin_amdgcn_sched_barrier(0)
    Unit cur, nxt; int ui = 0;
    if (!S.next(0, cur)) return;
    f32x4 acc[2][2][4][2];
#pragma unroll
    for (int a = 0; a < 2; ++a)
#pragma unroll
        for (int b = 0; b < 2; ++b)
#pragma unroll
            for (int m = 0; m < 4; ++m)
#pragma unroll
                for (int n = 0; n < 2; ++n) acc[a][b][m][n] = (f32x4){0.f, 0.f, 0.f, 0.f};
    s16x8 At[4][2], B0[2][2], B1[2][2];
    const char* cA = (const char*)g.A + (size_t)cur.pm * tstep; const char* cB = (const char*)g.Bt + (size_t)cur.pn * tstep;
    PG8_STAGE(PG8_SB(0, 0), cB, voffB); PG8_STAGE(PG8_SB(0, 1), cB + hstep, voffB); PG8_STAGE(PG8_SA(0, 0), cA, voffA); PG8_STAGE(PG8_SA(0, 1), cA + hstep, voffA);
    if (wr == 1) PG8_BAR;
    PG8_WAIT_V(2); PG8_BAR;
    PG8_STAGE(PG8_SB(1, 0), cB + kstep, voffB); PG8_STAGE(PG8_SA(1, 0), cA + kstep, voffA); PG8_STAGE(PG8_SB(1, 1), cB + hstep + kstep, voffB);
    PG8_WAIT_V(6); PG8_BAR;
    for (;;) {
        const bool has_next = S.next(ui + 1, nxt);
        const char* nA = has_next ? (const char*)g.A + (size_t)nxt.pm * tstep : cA; const char* nB = has_next ? (const char*)g.Bt + (size_t)nxt.pn * tstep : cB;
#pragma unroll 1
        for (int t = 0; t < nt; t += 2) {
            const bool last = (t == nt - 2);
            const char* a1 = cA + (size_t)(t + 1) * kstep;
            const char* a2 = last ? nA : cA + (size_t)(t + 2) * kstep; const char* b2 = last ? nB : cB + (size_t)(t + 2) * kstep;
            const char* a3 = a2 + kstep; const char* b3 = b2 + kstep;
            PG8_LDB(B0, 0, 0); PG8_LDB(B1, 0, 1); PG8_SCHED; PG8_LDA(At, 0, 0); PG8_STAGE(PG8_SA(1, 1), a1 + hstep, voffA);
            PG8_WAIT_V(8); PG8_WAIT_L(0); PG8_BAR; PG8_MMA(0, 0, At, B0); PG8_MMA(0, 1, At, B1); PG8_BAR; PG8_SCHED;
            PG8_LDA(At, 0, 1); PG8_STAGE(PG8_SB(0, 0), b2, voffB); PG8_STAGE(PG8_SB(0, 1), b2 + hstep, voffB); PG8_STAGE(PG8_SA(0, 0), a2, voffA);
            PG8_WAIT_V(8); PG8_WAIT_L(0); PG8_BAR; PG8_MMA(1, 0, At, B0); PG8_MMA(1, 1, At, B1); PG8_BAR; PG8_SCHED;
            PG8_LDB(B0, 1, 0); PG8_LDB(B1, 1, 1); PG8_SCHED; PG8_LDA(At, 1, 0); PG8_STAGE(PG8_SA(0, 1), a2 + hstep, voffA);
            PG8_WAIT_V(8); PG8_WAIT_L(0); PG8_BAR; PG8_MMA(0, 0, At, B0); PG8_MMA(0, 1, At, B1); PG8_BAR; PG8_SCHED;
            PG8_LDA(At, 1, 1); PG8_STAGE(PG8_SB(1, 0), b3, voffB); PG8_STAGE(PG8_SB(1, 1), b3 + hstep, voffB); PG8_STAGE(PG8_SA(1, 0), a3, voffA);
            PG8_WAIT_V(8); PG8_WAIT_L(0); PG8_BAR; PG8_MMA(1, 0, At, B0); PG8_MMA(1, 1, At, B1); PG8_BAR; PG8_SCHED;
        }
        if (wr == 0) PG8_BAR;
        E(acc, cur, wr, wc, fr, fq);
        if (!has_next) break;
#pragma unroll
        for (int a = 0; a < 2; ++a)
#pragma unroll
            for (int b = 0; b < 2; ++b)
#pragma unroll
                for (int m = 0; m < 4; ++m)
#pragma unroll
                    for (int n = 0; n < 2; ++n) acc[a][b][m][n] = (f32x4){0.f, 0.f, 0.f, 0.f};
        cur = nxt; cA = nA; cB = nB; ++ui;
        if (wr == 1) PG8_BAR;
    }
    PG8_WAIT_V(0);
    PG8_BAR;
#undef PG8_SA
#undef PG8_SB
#undef PG8_STAGE
#undef PG8_LDA
#undef PG8_LDB
#undef PG8_MMA
#undef PG8_WAIT_V
#undef PG8_WAIT_L
#undef PG8_BAR
#undef PG8_SCHED
}

typedef const f32x4 (&AccRef)[2][2][4][2];

struct EpiPlain {
    h16* O; int ldc;
    __device__ __forceinline__ void operator()(AccRef acc, const Unit& u, int wr, int wc, int fr, int fq) const {
        const int row0 = u.pm * BM + wr * 64 + fr, col0 = u.pn * BM + wc * 32 + 8 * fq;
#pragma unroll
        for (int ai = 0; ai < 2; ++ai)
#pragma unroll
            for (int m = 0; m < 4; ++m) { h16* rowp = O + (size_t)(row0 + ai * HALF + m * 16) * ldc + col0;
#pragma unroll
                for (int bj = 0; bj < 2; ++bj) { const f32x4 v0 = acc[ai][bj][m][0], v1 = acc[ai][bj][m][1];
                    u32x4 w; w.x = pkh(v0[0], v0[1]); w.y = pkh(v0[2], v0[3]); w.z = pkh(v1[0], v1[1]); w.w = pkh(v1[2], v1[3]);
                    *(u32x4*)(rowp + bj * HALF) = w; } }
    }
};

struct EpiInProj {
    const float* rs0; const float* rope; const float* gidx;
    h16 *QA, *KA, *VA, *QI, *KI, *QB, *KB, *VB; float* WI; float* kmp;
    __device__ __forceinline__ void operator()(AccRef acc, const Unit& u, int wr, int wc, int fr_in, int fq_in) const {
        int fr = fr_in, fq = fq_in; asm volatile("" : "+v"(fr), "+v"(fq));
        const int pn = u.pn;
        int type = 0; h16* dst = VA; int pitch = 64, cb = 0; float scl = 1.f; bool iskb = false;
        if (pn < 2) { type = 1; dst = QA; pitch = 512; cb = 256 * pn + 64 * wc; scl = C2; }
        else if (pn == 2) { if (wc == 0) { type = 1; dst = KA; } else if (wc == 1) { type = 0; dst = VA; } else if (wc == 2) { type = 2; dst = KI; } else { type = 3; } }
        else if (pn == 3) { type = 1; dst = QI; pitch = 256; cb = 64 * wc; }
        else if (pn < 6) { type = 1; dst = QB; pitch = 512; cb = 256 * (pn - 4) + 64 * wc; scl = C2; }
        else if (pn < 8) { type = 1; dst = KB; pitch = 512; cb = 256 * (pn - 6) + 64 * wc; iskb = true; }
        else { type = 0; dst = VB; pitch = 512; cb = 256 * (pn - 8) + 64 * wc; }
        float ks[2][2][4];
#pragma unroll
        for (int bj = 0; bj < 2; ++bj)
#pragma unroll
            for (int n = 0; n < 2; ++n)
#pragma unroll
                for (int e = 0; e < 4; ++e) ks[bj][n][e] = 0.f;
        float gl[2][2][4];
        if (type == 2) {
#pragma unroll
            for (int bj = 0; bj < 2; ++bj)
#pragma unroll
                for (int n = 0; n < 2; ++n)
#pragma unroll
                    for (int e = 0; e < 4; ++e) gl[bj][n][e] = gidx[32 * bj + 8 * fq + 4 * n + e];
        }
#pragma unroll
        for (int ai = 0; ai < 2; ++ai)
#pragma unroll
            for (int m = 0; m < 4; ++m) {
                const int row = u.pm * BM + ai * HALF + wr * 64 + m * 16 + fr;
                const float s = rs0[row];
                float v[2][2][4];
#pragma unroll
                for (int bj = 0; bj < 2; ++bj)
#pragma unroll
                    for (int n = 0; n < 2; ++n)
#pragma unroll
                        for (int e = 0; e < 4; ++e) v[bj][n][e] = acc[ai][bj][m][n][e] * s;
                if (type == 3) {
                    if (fq == 0) *(f32x4*)(WI + (size_t)row * 4) = (f32x4){v[0][0][0] * 0.0625f, v[0][0][1] * 0.0625f, v[0][0][2] * 0.0625f, v[0][0][3] * 0.0625f};
                    continue;
                }
                if (type == 2) {
                    float sum = 0.f;
#pragma unroll
                    for (int bj = 0; bj < 2; ++bj)
#pragma unroll
                        for (int n = 0; n < 2; ++n)
#pragma unroll
                            for (int e = 0; e < 4; ++e) sum += v[bj][n][e];
                    sum += __shfl_xor(sum, 16); sum += __shfl_xor(sum, 32);
                    const float mean = sum * (1.f / 64.f); float q = 0.f;
#pragma unroll
                    for (int bj = 0; bj < 2; ++bj)
#pragma unroll
                        for (int n = 0; n < 2; ++n)
#pragma unroll
                            for (int e = 0; e < 4; ++e) { v[bj][n][e] -= mean; q += v[bj][n][e] * v[bj][n][e]; }
                    q += __shfl_xor(q, 16); q += __shfl_xor(q, 32);
                    const float rstd = 1.0f / sqrtf(q * (1.f / 64.f) + EPS);
#pragma unroll
                    for (int bj = 0; bj < 2; ++bj)
#pragma unroll
                        for (int n = 0; n < 2; ++n)
#pragma unroll
                            for (int e = 0; e < 4; ++e) v[bj][n][e] = v[bj][n][e] * rstd * gl[bj][n][e];
                }
                if (type >= 1) {
                    const int pos = row & (SEQ - 1);
                    const f32x4* cs = (const f32x4*)(rope + ((size_t)pos * 32 + 8 * fq) * 2);
#pragma unroll
                    for (int n = 0; n < 2; ++n) { const f32x4 c01 = cs[2 * n], c23 = cs[2 * n + 1];
                        const float cc[4] = {c01[0], c01[2], c23[0], c23[2]}, sn[4] = {c01[1], c01[3], c23[1], c23[3]};
#pragma unroll
                        for (int e = 0; e < 4; ++e) { const float lo = v[0][n][e], hi = v[1][n][e]; v[0][n][e] = lo * cc[e] - hi * sn[e]; v[1][n][e] = hi * cc[e] + lo * sn[e]; } }
                }
#pragma unroll
                for (int bj = 0; bj < 2; ++bj) {
#pragma unroll
                    for (int n = 0; n < 2; ++n)
#pragma unroll
                        for (int e = 0; e < 4; ++e) { v[bj][n][e] *= scl; ks[bj][n][e] += v[bj][n][e]; }
                    u32x4 w; w.x = pkh(v[bj][0][0], v[bj][0][1]); w.y = pkh(v[bj][0][2], v[bj][0][3]); w.z = pkh(v[bj][1][0], v[bj][1][1]); w.w = pkh(v[bj][1][2], v[bj][1][3]);
                    *(u32x4*)(dst + (size_t)row * pitch + cb + 32 * bj + 8 * fq) = w;
                }
                __builtin_amdgcn_sched_barrier(0);
            }
        if (iskb) {
#pragma unroll
            for (int bj = 0; bj < 2; ++bj)
#pragma unroll
                for (int n = 0; n < 2; ++n)
#pragma unroll
                    for (int e = 0; e < 4; ++e) { float t = ks[bj][n][e]; t += __shfl_xor(t, 1); t += __shfl_xor(t, 2); t += __shfl_xor(t, 4); t += __shfl_xor(t, 8); ks[bj][n][e] = t; }
            if (fr == 0) { const int head = 4 * (pn - 6) + wc; float* o = kmp + (((size_t)u.pm * 2 + wr) * 8 + head) * 64;
#pragma unroll
                for (int bj = 0; bj < 2; ++bj)
#pragma unroll
                    for (int n = 0; n < 2; ++n) *(f32x4*)(o + 32 * bj + 8 * fq + 4 * n) = (f32x4){ks[bj][n][0], ks[bj][n][1], ks[bj][n][2], ks[bj][n][3]}; }
        }
    }
};

template <bool BASE_F32> struct EpiRes {
    const void* base; h16* out; float* ssp;
    __device__ __forceinline__ void operator()(AccRef acc, const Unit& u, int wr, int wc, int fr, int fq) const {
        const int col0 = u.pn * BM + wc * 32 + 8 * fq;
#pragma unroll
        for (int ai = 0; ai < 2; ++ai)
#pragma unroll
            for (int m = 0; m < 4; ++m) { const int row = u.pm * BM + ai * HALF + wr * 64 + m * 16 + fr; float ss = 0.f;
#pragma unroll
                for (int bj = 0; bj < 2; ++bj) { const size_t off = (size_t)row * DM + col0 + bj * HALF; float b[8];
                    if (BASE_F32) { const f32x4 b0 = *(const f32x4*)((const float*)base + off), b1 = *(const f32x4*)((const float*)base + off + 4);
                        b[0] = b0[0]; b[1] = b0[1]; b[2] = b0[2]; b[3] = b0[3]; b[4] = b1[0]; b[5] = b1[1]; b[6] = b1[2]; b[7] = b1[3]; }
                    else { const h16x8 hb = *(const h16x8*)((const h16*)base + off);
#pragma unroll
                        for (int e = 0; e < 8; ++e) b[e] = (float)hb[e]; }
                    float v[8];
#pragma unroll
                    for (int e = 0; e < 8; ++e) { v[e] = b[e] + acc[ai][bj][m][e >> 2][e & 3]; ss += v[e] * v[e]; }
                    u32x4 w; w.x = pkh(v[0], v[1]); w.y = pkh(v[2], v[3]); w.z = pkh(v[4], v[5]); w.w = pkh(v[6], v[7]);
                    *(u32x4*)(out + off) = w; }
                ss += __shfl_xor(ss, 16); ss += __shfl_xor(ss, 32);
                if (fq == 0) ssp[(size_t)row * 16 + u.pn * 4 + wc] = ss; }
    }
};
__device__ __forceinline__ float row_rstd(const float* ssp, int row) {
    const f32x4* p = (const f32x4*)(ssp + (size_t)row * 16); const f32x4 a = p[0], b = p[1], c = p[2], d = p[3];
    const float s = ((a[0] + a[1]) + (a[2] + a[3])) + ((b[0] + b[1]) + (b[2] + b[3])) + ((c[0] + c[1]) + (c[2] + c[3])) + ((d[0] + d[1]) + (d[2] + d[3]));
    return 1.0f / sqrtf(s * (1.0f / DM) + EPS);
}
struct EpiSwiGLU {
    const float* ssp; h16* act;
    __device__ __forceinline__ void operator()(AccRef acc, const Unit& u, int wr, int wc, int fr, int fq) const {
        const int col0 = u.pn * HALF + wc * 32 + 8 * fq;
#pragma unroll
        for (int ai = 0; ai < 2; ++ai)
#pragma unroll
            for (int m = 0; m < 4; ++m) { const int row = u.pm * BM + ai * HALF + wr * 64 + m * 16 + fr; const float s = row_rstd(ssp, row); float v[8];
#pragma unroll
                for (int e = 0; e < 8; ++e) { const float gt = acc[ai][0][m][e >> 2][e & 3] * s, up = acc[ai][1][m][e >> 2][e & 3] * s; v[e] = gt * fast_sigmoid(gt) * up; }
                u32x4 w; w.x = pkh(v[0], v[1]); w.y = pkh(v[2], v[3]); w.z = pkh(v[4], v[5]); w.w = pkh(v[6], v[7]);
                *(u32x4*)(act + (size_t)row * DFF + col0) = w; }
    }
};
struct EpiPLE {
    const float* ssp2; const h16* h2; const h16* pp; h16* out; float* ssp3;
    __device__ __forceinline__ void operator()(AccRef acc, const Unit& u, int wr, int wc, int fr, int fq) const {
        const int col0 = u.pn * BM + wc * 32 + 8 * fq;
#pragma unroll
        for (int ai = 0; ai < 2; ++ai)
#pragma unroll
            for (int m = 0; m < 4; ++m) { const int row = u.pm * BM + ai * HALF + wr * 64 + m * 16 + fr; const float s = row_rstd(ssp2, row); float ss = 0.f;
#pragma unroll
                for (int bj = 0; bj < 2; ++bj) { const size_t off = (size_t)row * DM + col0 + bj * HALF;
                    const h16x8 hb = *(const h16x8*)(h2 + off), pb = *(const h16x8*)(pp + off); float v[8];
#pragma unroll
                    for (int e = 0; e < 8; ++e) { v[e] = (float)hb[e] + fast_sigmoid(acc[ai][bj][m][e >> 2][e & 3] * s) * (float)pb[e]; ss += v[e] * v[e]; }
                    u32x4 w; w.x = pkh(v[0], v[1]); w.y = pkh(v[2], v[3]); w.z = pkh(v[4], v[5]); w.w = pkh(v[6], v[7]); *(u32x4*)(out + off) = w; }
                ss += __shfl_xor(ss, 16); ss += __shfl_xor(ss, 32);
                if (fq == 0) ssp3[(size_t)row * 16 + u.pn * 4 + wc] = ss; }
    }
};
}

template <class ColMap>
__device__ __forceinline__ void transpose_items(int K, int Nsrc, h16* WT, int Nrows, ColMap cm, const float* __restrict__ kscale, LAS float* scr, int gw, int NGW, int lane) {
    const int nblk = Nrows / 32, items = (K / 64) * nblk;
    for (int it = gw; it < items; it += NGW) {
        const int kb = it / nblk, nb = it % nblk, k0 = 64 * kb, n0 = 32 * nb;
        const float* src = cm(n0 + 4 * (lane & 7));
        f32x4 v[8];
#pragma unroll
        for (int i = 0; i < 8; ++i) { v[i] = (f32x4){0.f, 0.f, 0.f, 0.f}; if (src) v[i] = __builtin_nontemporal_load((const f32x4*)(src + (size_t)(k0 + 8 * i + (lane >> 3)) * Nsrc)); }
        const int c = lane & 7;
        f32x4 sc0 = {1.f, 1.f, 1.f, 1.f}, sc1 = {1.f, 1.f, 1.f, 1.f};
        if (kscale) { sc0 = *(const f32x4*)(kscale + k0 + 8 * c); sc1 = *(const f32x4*)(kscale + k0 + 8 * c + 4); }
#pragma unroll
        for (int i = 0; i < 8; ++i) { LAS float* d = scr + (8 * i + (lane >> 3)) * 33 + 4 * (lane & 7); d[0] = v[i][0]; d[1] = v[i][1]; d[2] = v[i][2]; d[3] = v[i][3]; }
        asm volatile("s_waitcnt lgkmcnt(0)" ::: "memory");
#pragma unroll
        for (int j = 0; j < 4; ++j) { const int n = (lane >> 3) + 8 * j; const LAS float* s = scr + (8 * c) * 33 + n;
            u32x4 o; o.x = pkh(s[0 * 33] * sc0[0], s[1 * 33] * sc0[1]); o.y = pkh(s[2 * 33] * sc0[2], s[3 * 33] * sc0[3]); o.z = pkh(s[4 * 33] * sc1[0], s[5 * 33] * sc1[1]); o.w = pkh(s[6 * 33] * sc1[2], s[7 * 33] * sc1[3]);
            *(u32x4*)(WT + (size_t)(n0 + n) * K + k0 + 8 * c) = o; }
        asm volatile("s_waitcnt lgkmcnt(0)" ::: "memory");
    }
}
__device__ __forceinline__ int win_colmap(int np) {
    const int pn = np >> 8, p = np & 255, bj = p >> 7, wc = (p >> 5) & 3, r = p & 31;
    const int LC = 256 * pn + 64 * wc + 32 * bj + r;
    if (LC < 512) return LC;
    if (LC < 576) return LC;
    if (LC < 640) return LC;
    if (LC < 704) return 896 + (LC - 640);
    if (LC < 708) return 960 + (LC - 704);
    if (LC < 768) return -1;
    if (LC < 1024) return 640 + (LC - 768);
    if (LC < 1536) return 964 + (LC - 1024);
    if (LC < 2048) return 1476 + (LC - 1536);
    return 1988 + (LC - 2048);
}

constexpr int DSA_LDS_RED = 0  , DSA_LDS_FRED = 1024  , DSA_LDS_META = 2048  , DSA_LDS_LIST = 2304  , DSA_LDS_VBUF = 10496  ,
              DSA_LDS_QF = 84224  , DSA_LDS_BUF = 92416  , DSA_LDS_CANDB = 133376  , DSA_LDS_TRASH = 137472  ;
constexpr int DSA_CAP = 64, DSA_BUFN = 320;
constexpr float ZEPS = 0x1p-120f;
constexpr int VROW = 144;

struct AttnPtrs { const h16 *QA, *KA, *VA, *QI, *KI, *QB, *KB, *VB; const float* WI; const float* kmp; h16* Y; };

__device__ __forceinline__ void cnt_ge(int& c, float s, float tau) { asm volatile("v_cmp_ge_f32 vcc, %1, %2\n\tv_addc_co_u32 %0, vcc, 0, %0, vcc" : "+v"(c) : "v"(s), "v"(tau) : "vcc"); }
__device__ __forceinline__ void cnt_gt(int& c, float s, float tau) { asm volatile("v_cmp_gt_f32 vcc, %1, %2\n\tv_addc_co_u32 %0, vcc, 0, %0, vcc" : "+v"(c) : "v"(s), "v"(tau) : "vcc"); }
__device__ __forceinline__ void cnt_tie(int& c, float s, float t3, int key, int im) { unsigned long long tmp;
    asm volatile("v_cmp_eq_f32 vcc, %2, %3\n\tv_cmp_le_i32 %1, %4, %5\n\ts_and_b64 vcc, vcc, %1\n\tv_addc_co_u32 %0, vcc, 0, %0, vcc" : "+v"(c), "=&s"(tmp) : "v"(s), "v"(t3), "v"(key), "v"(im) : "vcc"); }
__device__ __forceinline__ int dsa_count_ge(const f32x4 (&S)[8][4], int nch, float tau) {
    int c = 0;
#pragma unroll
    for (int ch = 0; ch < 8; ++ch) if (ch < nch) {
#pragma unroll
        for (int tt = 0; tt < 4; ++tt)
#pragma unroll
            for (int i = 0; i < 4; ++i) cnt_ge(c, S[ch][tt][i], tau);
    }
    return c;
}
__device__ __forceinline__ int dsa_total(int c, LAS unsigned* red, int par, int wid, int q16, int g) {
    c += __shfl_xor(c, 16); c += __shfl_xor(c, 32);
    if (g == 0) red[(par * 8 + wid) * 16 + q16] = (unsigned)c;
    __syncthreads();
    int t = 0;
#pragma unroll
    for (int w = 0; w < 8; ++w) t += (int)red[(par * 8 + w) * 16 + q16];
    return t;
}

__device__ __forceinline__ void dsa_unit(LAS unsigned char* lds, const AttnPtrs& P, int b, int qt, const int wid) {
    const int lane = lane_id_fresh(), tid = wid * 64 + lane, q16 = lane & 15, g = lane >> 4;
    LAS unsigned* red = (LAS unsigned*)(lds + DSA_LDS_RED); LAS float* fred = (LAS float*)(lds + DSA_LDS_FRED);
    LAS unsigned short* list = (LAS unsigned short*)(lds + DSA_LDS_LIST);
    const int t0 = qt * 16, myq = t0 + q16; const size_t brow = (size_t)b * SEQ;
    const int nch = (t0 + 15) / 512 + 1;
    f32x4 S[8][4];
#pragma unroll
    for (int ch = 0; ch < 8; ++ch)
#pragma unroll
        for (int tt = 0; tt < 4; ++tt) S[ch][tt] = (f32x4){NEG_INF, NEG_INF, NEG_INF, NEG_INF};
    float smax = NEG_INF, smin = -NEG_INF; int nvl = 0;
    {
        h16x8 qf[4][2];
#pragma unroll
        for (int h = 0; h < 4; ++h)
#pragma unroll
            for (int ks = 0; ks < 2; ++ks) qf[h][ks] = *(const h16x8*)(P.QI + (brow + myq) * 256 + h * 64 + ks * 32 + g * 8);
        const f32x4 wv = *(const f32x4*)(P.WI + (brow + myq) * 4);
        h16x8 pa[2][2];
#pragma unroll
        for (int u = 0; u < 2; ++u) { pa[u][0] = *(const h16x8*)(P.KI + (brow + 64 * wid + 16 * u + q16) * 64 + g * 8); pa[u][1] = *(const h16x8*)(P.KI + (brow + 64 * wid + 16 * u + q16) * 64 + 32 + g * 8); }
#pragma unroll
        for (int ch = 0; ch < 8; ++ch) if (ch < nch) {
#pragma unroll
            for (int tp = 0; tp < 2; ++tp) {
                h16x8 a[2][2];
#pragma unroll
                for (int u = 0; u < 2; ++u) { a[u][0] = pa[u][0]; a[u][1] = pa[u][1]; }
                { const int nidx = ch * 2 + tp + 1; int kn = 512 * (nidx >> 1) + 64 * wid + 32 * (nidx & 1); kn = kn < SEQ - 32 ? kn : SEQ - 32;
#pragma unroll
                  for (int u = 0; u < 2; ++u) { pa[u][0] = *(const h16x8*)(P.KI + (brow + kn + 16 * u + q16) * 64 + g * 8); pa[u][1] = *(const h16x8*)(P.KI + (brow + kn + 16 * u + q16) * 64 + 32 + g * 8); } }
#pragma unroll
                for (int u = 0; u < 2; ++u) {
                    const int tt = 2 * tp + u; const int kt = 512 * ch + 64 * wid + 16 * tt;
                    if (kt <= t0 + 15) {
                        f32x4 sc = {0.f, 0.f, 0.f, 0.f};
#pragma unroll
                        for (int h = 0; h < 4; ++h) { f32x4 acc = {0.f, 0.f, 0.f, 0.f};
                            acc = __builtin_amdgcn_mfma_f32_16x16x32_f16(a[u][0], qf[h][0], acc, 0, 0, 0);
                            acc = __builtin_amdgcn_mfma_f32_16x16x32_f16(a[u][1], qf[h][1], acc, 0, 0, 0);
#pragma unroll
                            for (int i = 0; i < 4; ++i) sc[i] += wv[h] * __builtin_fmaxf(acc[i], 0.f); }
                        const int key0 = kt + 4 * g;
                        const float zb = -(float)(key0 + 1) * ZEPS;
#pragma unroll
                        for (int i = 0; i < 4; ++i) { const bool ok = (key0 + i) <= myq; float v = sc[i]; v = (v == 0.f) ? (zb - (float)i * ZEPS) : v; v = ok ? v : NEG_INF; sc[i] = v;
                            smax = __builtin_fmaxf(smax, v); smin = __builtin_fminf(smin, ok ? v : -NEG_INF); nvl += ok ? 1 : 0; }
                        S[ch][tt] = sc;
                    }
                }
                __builtin_amdgcn_sched_barrier(0);
            }
        }
    }
    smax = __builtin_fmaxf(smax, __shfl_xor(smax, 16)); smax = __builtin_fmaxf(smax, __shfl_xor(smax, 32));
    smin = __builtin_fminf(smin, __shfl_xor(smin, 16)); smin = __builtin_fminf(smin, __shfl_xor(smin, 32));
    if (g == 0) { fred[(wid * 16 + q16) * 2] = smax; fred[(wid * 16 + q16) * 2 + 1] = smin; }
    __syncthreads();
#pragma unroll
    for (int w = 0; w < 8; ++w) { smax = __builtin_fmaxf(smax, fred[(w * 16 + q16) * 2]); smin = __builtin_fminf(smin, fred[(w * 16 + q16) * 2 + 1]); }
    const int nv = myq + 1; int par = 0;
    float lo, hi; int c_lo, c_hi, cl_lo, cl_hi; bool done, ovf;
    const float TZ = -4097.0f * ZEPS;
    for (int rep_b = 0; rep_b < REP_BIS; ++rep_b) {
    lo = smin; c_lo = nv; c_hi = 0; cl_lo = nvl; cl_hi = 0; done = false; ovf = false;
    { const unsigned mb = __float_as_uint(smax); hi = __uint_as_float(smax > 0.f ? mb + 1u : mb - 1u); }
    if (nv <= 256) { hi = lo; c_hi = c_lo; cl_hi = cl_lo; done = true; }
    auto pick = [&](float l, float h) -> float { if (l < 0.f && h > 0.f) return 0.f; if (l < TZ && h > TZ) return TZ; return l + (h - l) * 0.5f; };
    while (__any(!done)) {
        const float tau = done ? -NEG_INF : pick(lo, hi);
        const int clp = dsa_count_ge(S, nch, tau);
        const int c = dsa_total(clp, red, par, wid, q16, g); par ^= 1;
        if (!done) {
            if (c >= 256) { lo = tau; c_lo = c; cl_lo = clp; } else { hi = tau; c_hi = c; cl_hi = clp; }
            if (c_lo == 256) { hi = lo; c_hi = c_lo; cl_hi = cl_lo; done = true; }
            else if (c_lo - c_hi <= DSA_CAP) done = true;
            else { const float nt = pick(lo, hi); if (!(nt > lo && nt < hi)) { done = true; ovf = true; } }
        }
    }
    }
    const int kb0 = 64 * wid + 4 * g;
    int istar = 0x7fffffff;
    if (__any(ovf)) {
        const int R = 256 - c_hi; int ilo = -1, ihi = myq;
        while (__any(ovf && ihi - ilo > 1)) {
            const int im = ovf ? ((ilo + ihi) >> 1) : -1;
            int c = 0;
#pragma unroll
            for (int ch = 0; ch < 8; ++ch) if (ch < nch) {
#pragma unroll
                for (int tt = 0; tt < 4; ++tt)
#pragma unroll
                    for (int i = 0; i < 4; ++i) cnt_tie(c, S[ch][tt][i], lo, kb0, im - (512 * ch + 16 * tt + i));
            }
            c = dsa_total(c, red, par, wid, q16, g); par ^= 1;
            if (ovf && ihi - ilo > 1) { if (c >= R) ihi = im; else ilo = im; }
        }
        if (ovf) istar = ihi;
        int c = 0;
#pragma unroll
        for (int ch = 0; ch < 8; ++ch) if (ch < nch) {
#pragma unroll
            for (int tt = 0; tt < 4; ++tt)
#pragma unroll
                for (int i = 0; i < 4; ++i) { const float s = S[ch][tt][i]; const int key = kb0 + 512 * ch + 16 * tt + i; c += (s >= lo && (s >= hi || key <= istar)) ? 1 : 0; }
        }
        if (ovf) { cl_lo = c; c_lo = 256; c_hi = 256; hi = NEG_INF; }
    }
    unsigned nw;
    {
        const int p = cl_lo;
        const int u1 = __shfl_up(p, 16); const int s1 = p + (g >= 1 ? u1 : 0);
        const int u2 = __shfl_up(s1, 32); const int s2 = s1 + (g >= 2 ? u2 : 0);
        if (g == 3) red[(par * 8 + wid) * 16 + q16] = (unsigned)s2;
        __syncthreads();
        int bw = 0;
#pragma unroll
        for (int w = 0; w < 8; ++w) { const int t = (int)red[(par * 8 + w) * 16 + q16]; bw += (w < wid) ? t : 0; }
        par ^= 1;
        nw = (unsigned)(bw + s2 - p);
    }
    if (wid == 0 && g == 0) ((LAS u32x4*)(lds + DSA_LDS_META))[q16] = (u32x4){(unsigned)c_lo, (unsigned)c_hi, __float_as_uint(hi), 0u};
    {
        const unsigned bufq = (unsigned)(uintptr_t)(lds + DSA_LDS_BUF + q16 * (DSA_BUFN * 8)), trash = (unsigned)(uintptr_t)(lds + DSA_LDS_TRASH + tid * 8);
        if (!__any(ovf)) {
#pragma unroll
            for (int ch = 0; ch < 8; ++ch) if (ch < nch) {
#pragma unroll
                for (int tt = 0; tt < 4; ++tt)
#pragma unroll
                    for (int i = 0; i < 4; ++i) { const float s = S[ch][tt][i]; const int key = kb0 + 512 * ch + 16 * tt + i; unsigned a;
                        asm volatile("v_cmp_ge_f32 vcc, %2, %3\n\tv_lshl_add_u32 %0, %1, 3, %4\n\tv_cndmask_b32 %0, %5, %0, vcc\n\tv_addc_co_u32 %1, vcc, 0, %1, vcc\n\tds_write2_b32 %0, %2, %6 offset1:1"
                                     : "=&v"(a), "+v"(nw) : "v"(s), "v"(lo), "v"(bufq), "v"(trash), "v"(key) : "vcc", "memory"); }
            }
        } else {
#pragma unroll
            for (int ch = 0; ch < 8; ++ch) if (ch < nch) {
#pragma unroll
                for (int tt = 0; tt < 4; ++tt)
#pragma unroll
                    for (int i = 0; i < 4; ++i) { const float s = S[ch][tt][i]; const int key = kb0 + 512 * ch + 16 * tt + i;
                        const bool w = (s >= lo && (s >= hi || key <= istar));
                        const unsigned a = w ? (bufq + nw * 8u) : trash; nw += w ? 1u : 0u;
                        asm volatile("ds_write2_b32 %0, %1, %2 offset1:1" :: "v"(a), "v"(s), "v"(key) : "memory"); }
            }
        }
    }
    asm volatile("s_waitcnt lgkmcnt(0)" ::: "memory");
    __syncthreads();
#ifndef X_NOATT
    int lane_o = lane;
    {
    LAS unsigned char* vbuf = lds + DSA_LDS_VBUF + wid * (2 * 32 * VROW);
#pragma unroll 1
    for (int qq2 = 0; qq2 < 2 * REP_ATT; ++qq2) { const int qq = qq2 & 1;
        asm volatile("" : "+v"(lane_o));
        const int lane = lane_o, q16 = lane & 15, g = lane >> 4;
        const int ql = 2 * wid + qq; const int qpos = t0 + ql; const int n = (qpos + 1 < 256) ? qpos + 1 : 256;
        LAS unsigned short* ql_list = list + ql * 256;
        {
            const u32x4 mt = ((const LAS u32x4*)(lds + DSA_LDS_META))[ql];
            const int n_e = (int)mt.x, chi = (int)mt.y; const float hiv = __uint_as_float(mt.z); const int R = 256 - chi;
            const LAS u32x2* bq = (const LAS u32x2*)(lds + DSA_LDS_BUF) + ql * DSA_BUFN;
            LAS u32x2* cb = (LAS u32x2*)(lds + DSA_LDS_CANDB) + wid * 64;
            int base_s = 0, base_c = 0;
#pragma unroll
            for (int k = 0; k < 5; ++k) { const int e = lane + 64 * k; const bool valid = e < n_e; const u32x2 ent = bq[e];
                const float s = __uint_as_float(ent.x); const bool sure = valid && (s >= hiv), cand = valid && !(s >= hiv);
                const unsigned long long bs = __ballot(sure), bc = __ballot(cand);
                const int ps = base_s + (int)__builtin_amdgcn_mbcnt_hi((unsigned)(bs >> 32), __builtin_amdgcn_mbcnt_lo((unsigned)bs, 0u));
                const int pc = base_c + (int)__builtin_amdgcn_mbcnt_hi((unsigned)(bc >> 32), __builtin_amdgcn_mbcnt_lo((unsigned)bc, 0u));
                if (sure && ps < 256) ql_list[ps] = (unsigned short)ent.y;
                if (cand && pc < 64) cb[pc] = ent;
                base_s += __popcll(bs); base_c += __popcll(bc); }
            const int m = base_c < 64 ? base_c : 64;
            asm volatile("s_waitcnt lgkmcnt(0)" ::: "memory");
            u32x2 my = {0u, 0u}; if (lane < m) my = cb[lane];
            const float mys = __uint_as_float(my.x); int rank = 0;
#pragma unroll 4
            for (int jx = 0; jx < m; ++jx) { const u32x2 o = cb[jx]; const float os = __uint_as_float(o.x); rank += (os > mys || (os == mys && o.y < my.y)) ? 1 : 0; }
            if (lane < m && rank < R && chi + rank < 256) ql_list[chi + rank] = (unsigned short)my.y;
            asm volatile("s_waitcnt lgkmcnt(0)" ::: "memory");
        }
        const int head = q16 & 7;
        h16x8 qf[2];
#pragma unroll
        for (int ks = 0; ks < 2; ++ks) qf[ks] = *(const h16x8*)(P.QA + (brow + qpos) * 512 + head * 64 + ks * 32 + g * 8);
        f32x4 L[16];
        {
            h16x8 ka[2][4][2];
#pragma unroll
            for (int u = 0; u < 4; ++u) { const int e = 16 * u + q16; const int kraw = (int)ql_list[e]; const int key = (e < n) ? kraw : 0;
                ka[0][u][0] = *(const h16x8*)(P.KA + (brow + key) * 64 + g * 8); ka[0][u][1] = *(const h16x8*)(P.KA + (brow + key) * 64 + 32 + g * 8); }
#pragma unroll
            for (int gi = 0; gi < 4; ++gi) {
                if (gi < 3) {
#pragma unroll
                    for (int u = 0; u < 4; ++u) { const int e = 16 * (4 * (gi + 1) + u) + q16; const int kraw = (int)ql_list[e]; const int key = (e < n) ? kraw : 0;
                        ka[(gi + 1) & 1][u][0] = *(const h16x8*)(P.KA + (brow + key) * 64 + g * 8); ka[(gi + 1) & 1][u][1] = *(const h16x8*)(P.KA + (brow + key) * 64 + 32 + g * 8); }
                }
#pragma unroll
                for (int u = 0; u < 4; ++u) { const int T = 4 * gi + u;
                    f32x4 acc = {0.f, 0.f, 0.f, 0.f};
                    acc = __builtin_amdgcn_mfma_f32_16x16x32_f16(ka[gi & 1][u][0], qf[0], acc, 0, 0, 0);
                    acc = __builtin_amdgcn_mfma_f32_16x16x32_f16(ka[gi & 1][u][1], qf[1], acc, 0, 0, 0);
#pragma unroll
                    for (int i = 0; i < 4; ++i) if (16 * T + 4 * g + i >= n) acc[i] = NEG_INF;
                    L[T] = acc; }
                __builtin_amdgcn_sched_barrier(0);
            }
        }
        u32x4 vreg[2][4];
#pragma unroll
        for (int c2 = 0; c2 < 2; ++c2)
#pragma unroll
            for (int i = 0; i < 4; ++i) { const int j = lane >> 3; const int e = 16 * (2 * c2 + (j >> 2)) + 4 * i + (j & 3); const int kraw = (int)ql_list[e]; const int key = (e < n) ? kraw : 0;
                vreg[c2][i] = *(const u32x4*)(P.VA + (brow + key) * 64 + 8 * (lane & 7)); }
        __builtin_amdgcn_sched_barrier(0);
        float mx = NEG_INF;
#pragma unroll
        for (int T = 0; T < 16; ++T)
#pragma unroll
            for (int i = 0; i < 4; ++i) mx = __builtin_fmaxf(mx, L[T][i]);
        mx = __builtin_fmaxf(mx, __shfl_xor(mx, 16)); mx = __builtin_fmaxf(mx, __shfl_xor(mx, 32));
        float lsum = 0.f;
#pragma unroll
        for (int T = 0; T < 16; ++T)
#pragma unroll
            for (int i = 0; i < 4; ++i) { const float p = __builtin_amdgcn_exp2f(L[T][i] - mx); L[T][i] = p; lsum += p; }
        lsum += __shfl_xor(lsum, 16); lsum += __shfl_xor(lsum, 32);
        __builtin_amdgcn_sched_barrier(0);
        f32x4 O[4];
#pragma unroll
        for (int db = 0; db < 4; ++db) O[db] = (f32x4){0.f, 0.f, 0.f, 0.f};
#pragma unroll
        for (int cc = 0; cc < 8; ++cc) {
            LAS unsigned char* vb = vbuf + (cc & 1) * (32 * VROW);
#pragma unroll
            for (int i = 0; i < 4; ++i) *(LAS u32x4*)(vb + (8 * i + (lane >> 3)) * VROW + 16 * (lane & 7)) = vreg[cc & 1][i];
            if (cc < 6) {
#pragma unroll
                for (int i = 0; i < 4; ++i) { const int j = lane >> 3; const int e = 16 * (2 * (cc + 2) + (j >> 2)) + 4 * i + (j & 3); const int kraw = (int)ql_list[e]; const int key = (e < n) ? kraw : 0;
                    vreg[cc & 1][i] = *(const u32x4*)(P.VA + (brow + key) * 64 + 8 * (lane & 7)); }
            }
            asm volatile("s_waitcnt lgkmcnt(0)" ::: "memory");
            h16x8 pa;
#pragma unroll
            for (int i = 0; i < 4; ++i) { pa[i] = (h16)L[2 * cc][i]; pa[4 + i] = (h16)L[2 * cc + 1][i]; }
#pragma unroll
            for (int db = 0; db < 4; ++db) {
                const LAS unsigned char* pb = vb + (8 * g + ((lane & 15) >> 2)) * VROW + (16 * db + 4 * (lane & 3)) * 2;
                const s16x4 lo4 = __builtin_amdgcn_ds_read_tr16_b64_v4i16((LAS s16x4*)pb);
                const s16x4 hi4 = __builtin_amdgcn_ds_read_tr16_b64_v4i16((LAS s16x4*)(pb + 4 * VROW));
                const s16x8 bf = {lo4[0], lo4[1], lo4[2], lo4[3], hi4[0], hi4[1], hi4[2], hi4[3]};
                O[db] = __builtin_amdgcn_mfma_f32_16x16x32_f16(pa, __builtin_bit_cast(h16x8, bf), O[db], 0, 0, 0);
            }
            __builtin_amdgcn_sched_barrier(0);
        }
#pragma unroll
        for (int i = 0; i < 4; ++i) { const float lh = __shfl(lsum, (4 * g + i) & 7); const float rl = 1.0f / lh;
            if (g < 2) {
#pragma unroll
                for (int db = 0; db < 4; ++db) P.Y[(brow + qpos) * DM + (4 * g + i) * 64 + 16 * db + q16] = (h16)(O[db][i] * rl); } }
    }
    }
#endif
    __syncthreads();
}


constexpr int DSA2_T = 10496  ,
              DSA2_WBUF = 92416  , DSA2_TROW = 516;
__device__ __forceinline__ void bcnt_ge(int& cnt, float s, float tau) { unsigned tmp;
    asm volatile("v_cmp_ge_f32 vcc, %2, %3\n\ts_bcnt1_i32_b64 %1, vcc\n\ts_add_u32 %0, %0, %1" : "+s"(cnt), "=&s"(tmp) : "v"(s), "v"(tau) : "vcc", "scc"); }
__device__ __forceinline__ void bcnt_tie(int& cnt, float s, float t3, int kb, int imoff) { unsigned tmp; unsigned long long m2;
    asm volatile("v_cmp_eq_f32 vcc, %3, %4\n\tv_cmp_le_i32 %2, %5, %6\n\ts_and_b64 vcc, vcc, %2\n\ts_bcnt1_i32_b64 %1, vcc\n\ts_add_u32 %0, %0, %1" : "+s"(cnt), "=&s"(tmp), "=&s"(m2) : "v"(s), "v"(t3), "v"(kb), "v"(imoff) : "vcc", "scc"); }
__device__ __forceinline__ void compact_ge(unsigned& saddr, float s, float lo, unsigned trash, int key) { unsigned a, tmp;
    asm volatile("v_cmp_ge_f32 vcc, %3, %4\n\ts_bcnt1_i32_b64 %2, vcc\n\ts_lshl_b32 %2, %2, 3\n\ts_nop 1\n\tv_mbcnt_lo_u32_b32 %0, vcc_lo, 0\n\tv_mbcnt_hi_u32_b32 %0, vcc_hi, %0\n\tv_lshl_add_u32 %0, %0, 3, %1\n\tv_cndmask_b32 %0, %5, %0, vcc\n\tds_write2_b32 %0, %3, %6 offset1:1\n\ts_add_u32 %1, %1, %2"
                 : "=&v"(a), "+s"(saddr), "=&s"(tmp) : "v"(s), "v"(lo), "v"(trash), "v"(key) : "vcc", "scc", "memory"); }

__device__ __forceinline__ void dsa_unit2(LAS unsigned char* lds, const AttnPtrs& P, int b, int qt, const int wid) {
    int lane_o = lane_id_fresh();
    const int t0 = qt * 16; const size_t brow = (size_t)b * SEQ;
    const int nch = (t0 + 15) / 512 + 1;
    LAS unsigned short* list = (LAS unsigned short*)(lds + DSA_LDS_LIST);
    float Sq[2][8][8];
    {
        const int lane = lane_o, q16 = lane & 15, g = lane >> 4, myq = t0 + q16;
        LAS float* Tb = (LAS float*)(lds + DSA2_T);
        h16x8 qf[4][2];
#pragma unroll
        for (int h = 0; h < 4; ++h)
#pragma unroll
            for (int ks = 0; ks < 2; ++ks) qf[h][ks] = *(const h16x8*)(P.QI + (brow + myq) * 256 + h * 64 + ks * 32 + g * 8);
        const f32x4 wv = *(const f32x4*)(P.WI + (brow + myq) * 4);
        h16x8 pa[2][2];
#pragma unroll
        for (int u = 0; u < 2; ++u) { pa[u][0] = *(const h16x8*)(P.KI + (brow + 64 * wid + 16 * u + q16) * 64 + g * 8); pa[u][1] = *(const h16x8*)(P.KI + (brow + 64 * wid + 16 * u + q16) * 64 + 32 + g * 8); }
#pragma unroll
        for (int ch = 0; ch < 8; ++ch) if (ch < nch) {
            LAS float* Tc = Tb + (ch & 1) * (16 * DSA2_TROW);
#pragma unroll
            for (int tp = 0; tp < 2; ++tp) {
                h16x8 a[2][2];
#pragma unroll
                for (int u = 0; u < 2; ++u) { a[u][0] = pa[u][0]; a[u][1] = pa[u][1]; }
                { const int nidx = ch * 2 + tp + 1; int kn = 512 * (nidx >> 1) + 64 * wid + 32 * (nidx & 1); kn = kn < SEQ - 32 ? kn : SEQ - 32;
#pragma unroll
                  for (int u = 0; u < 2; ++u) { pa[u][0] = *(const h16x8*)(P.KI + (brow + kn + 16 * u + q16) * 64 + g * 8); pa[u][1] = *(const h16x8*)(P.KI + (brow + kn + 16 * u + q16) * 64 + 32 + g * 8); } }
#pragma unroll
                for (int u = 0; u < 2; ++u) {
                    const int tt = 2 * tp + u; const int kt = 512 * ch + 64 * wid + 16 * tt;
                    if (kt <= t0 + 15) {
                        f32x4 sc = {0.f, 0.f, 0.f, 0.f};
#pragma unroll
                        for (int h = 0; h < 4; ++h) { f32x4 acc = {0.f, 0.f, 0.f, 0.f};
                            acc = __builtin_amdgcn_mfma_f32_16x16x32_f16(a[u][0], qf[h][0], acc, 0, 0, 0);
                            acc = __builtin_amdgcn_mfma_f32_16x16x32_f16(a[u][1], qf[h][1], acc, 0, 0, 0);
#pragma unroll
                            for (int i = 0; i < 4; ++i) sc[i] += wv[h] * __builtin_fmaxf(acc[i], 0.f); }
                        const int key0 = kt + 4 * g;
                        const float zb = -(float)(key0 + 1) * ZEPS;
#pragma unroll
                        for (int i = 0; i < 4; ++i) sc[i] = (sc[i] == 0.f) ? (zb - (float)i * ZEPS) : sc[i];
                        *(LAS f32x4*)(Tc + q16 * DSA2_TROW + 64 * wid + 16 * tt + 4 * g) = sc;
                    }
                }
                __builtin_amdgcn_sched_barrier(0);
            }
            asm volatile("s_waitcnt lgkmcnt(0)" ::: "memory");
            __syncthreads();
#pragma unroll
            for (int qq = 0; qq < 2; ++qq) { const LAS float* tr = Tc + (2 * wid + qq) * DSA2_TROW + 8 * lane;
                const f32x4 v0 = *(const LAS f32x4*)tr, v1 = *(const LAS f32x4*)(tr + 4);
                const int qpos = t0 + 2 * wid + qq, kb = 512 * ch + 8 * lane;
#pragma unroll
                for (int i = 0; i < 4; ++i) { Sq[qq][ch][i] = (kb + i <= qpos) ? v0[i] : NEG_INF; Sq[qq][ch][4 + i] = (kb + 4 + i <= qpos) ? v1[i] : NEG_INF; } }
        }
        asm volatile("s_waitcnt lgkmcnt(0)" ::: "memory");
        __syncthreads();
    }
#pragma unroll
    for (int qq = 0; qq < 2; ++qq) {
        asm volatile("" : "+v"(lane_o));
        const int lane = lane_o, q16 = lane & 15, g = lane >> 4;
        const int ql = 2 * wid + qq; const int qpos = t0 + ql; const int nv = qpos + 1; const int n = nv < 256 ? nv : 256;
        LAS unsigned short* ql_list = list + ql * 256;
        const unsigned wbuf = (unsigned)(uintptr_t)(lds + DSA2_WBUF + wid * (DSA_BUFN * 8)), trash = (unsigned)(uintptr_t)(lds + DSA_LDS_TRASH + (wid * 64 + lane) * 8);
        const int kb8 = 8 * lane;
        float lo, hi; int c_lo = nv, c_hi = 0; bool ovf = false;
        if (nv <= 256) { lo = -3.0e38f; hi = -3.0e38f; c_hi = nv; }
        else {
            float smax = NEG_INF;
#pragma unroll
            for (int ch = 0; ch < 8; ++ch) if (ch < nch) {
#pragma unroll
                for (int i = 0; i < 8; ++i) smax = __builtin_fmaxf(smax, Sq[qq][ch][i]); }
#pragma unroll
            for (int o = 1; o < 64; o <<= 1) smax = __builtin_fmaxf(smax, __shfl_xor(smax, o));
            { const unsigned mb = __float_as_uint(smax); hi = __uint_as_float(smax > 0.f ? mb + 1u : mb - 1u); }
            lo = -3.0e38f;
            const float TZ = -4097.0f * ZEPS; bool have_min = false;
            for (;;) {
                float tau;
                if (lo < 0.f && hi > 0.f) tau = 0.f; else if (lo < TZ && hi > TZ) tau = TZ;
                else {
                    if (!have_min && lo < TZ) {
                        float smin = -NEG_INF;
#pragma unroll
                        for (int ch = 0; ch < 8; ++ch) if (ch < nch) {
#pragma unroll
                            for (int i = 0; i < 8; ++i) { const float v = Sq[qq][ch][i]; smin = __builtin_fminf(smin, v == NEG_INF ? -NEG_INF : v); } }
#pragma unroll
                        for (int o = 1; o < 64; o <<= 1) smin = __builtin_fminf(smin, __shfl_xor(smin, o));
                        lo = smin; have_min = true;
                    }
                    tau = lo + (hi - lo) * 0.5f;
                    if (!(tau > lo && tau < hi)) { ovf = true; break; }
                }
                int c = 0;
#pragma unroll
                for (int ch = 0; ch < 8; ++ch) if (ch < nch) {
#pragma unroll
                    for (int i = 0; i < 8; ++i) bcnt_ge(c, Sq[qq][ch][i], tau); }
                if (c >= 256) { lo = tau; c_lo = c; } else { hi = tau; c_hi = c; }
                if (c_lo == 256) { hi = lo; c_hi = 256; break; }
                if (c_lo - c_hi <= DSA_CAP) break;
            }
        }
        int n_e; float hiv = hi;
        if (!ovf) {
            unsigned saddr = wbuf;
#pragma unroll
            for (int ch = 0; ch < 8; ++ch) if (ch < nch) {
#pragma unroll
                for (int i = 0; i < 8; ++i) compact_ge(saddr, Sq[qq][ch][i], lo, trash, kb8 + 512 * ch + i); }
            n_e = (int)((saddr - wbuf) >> 3);
        } else {
            const int R = 256 - c_hi; int ilo = -1, ihi = qpos;
            while (ihi - ilo > 1) { const int im = (ilo + ihi) >> 1; int c = 0;
#pragma unroll
                for (int ch = 0; ch < 8; ++ch) if (ch < nch) {
#pragma unroll
                    for (int i = 0; i < 8; ++i) bcnt_tie(c, Sq[qq][ch][i], lo, kb8, im - (512 * ch + i)); }
                if (c >= R) ihi = im; else ilo = im; }
            unsigned saddr = wbuf;
#pragma unroll
            for (int ch = 0; ch < 8; ++ch) if (ch < nch) {
#pragma unroll
                for (int i = 0; i < 8; ++i) { const float s = Sq[qq][ch][i]; const int key = kb8 + 512 * ch + i;
                    const float sv = (s >= hi || (s == lo && key <= ihi)) ? s : NEG_INF;
                    compact_ge(saddr, sv, lo, trash, key); } }
            n_e = (int)((saddr - wbuf) >> 3); hiv = NEG_INF; c_hi = n_e;
        }
        asm volatile("s_waitcnt lgkmcnt(0)" ::: "memory");
        {
            const int R = 256 - c_hi;
            const LAS u32x2* bq = (const LAS u32x2*)(lds + DSA2_WBUF) + wid * DSA_BUFN;
            int base_s = 0, base_c = 0; u32x2 my = {0u, 0u};
#pragma unroll
            for (int k = 0; k < 5; ++k) { const int e = lane + 64 * k; const bool valid = e < n_e; const u32x2 ent = bq[e];
                const float s = __uint_as_float(ent.x); const bool sure = valid && (s >= hiv), cand = valid && !(s >= hiv);
                const unsigned long long bs = __ballot(sure), bc = __ballot(cand);
                const int ps = base_s + (int)__builtin_amdgcn_mbcnt_hi((unsigned)(bs >> 32), __builtin_amdgcn_mbcnt_lo((unsigned)bs, 0u));
                if (sure && ps < 256) ql_list[ps] = (unsigned short)ent.y;
                base_s += __popcll(bs);
                const int pc = base_c + (int)__builtin_amdgcn_mbcnt_hi((unsigned)(bc >> 32), __builtin_amdgcn_mbcnt_lo((unsigned)bc, 0u));
                if (cand && pc < 64) ((LAS u32x2*)(lds + DSA_LDS_CANDB) + wid * 64)[pc] = ent;
                base_c += __popcll(bc); }
            const int m = base_c < 64 ? base_c : 64;
            asm volatile("s_waitcnt lgkmcnt(0)" ::: "memory");
            my = ((const LAS u32x2*)(lds + DSA_LDS_CANDB) + wid * 64)[lane];
            const float mys = __uint_as_float(my.x); int rank = 0;
            for (int jx = 0; jx < m; ++jx) { const float os = __uint_as_float((unsigned)__builtin_amdgcn_readlane((int)my.x, jx)); const unsigned oi = (unsigned)__builtin_amdgcn_readlane((int)my.y, jx);
                rank += (os > mys || (os == mys && oi < my.y)) ? 1 : 0; }
            if (lane < m && rank < R && c_hi + rank < 256) ql_list[c_hi + rank] = (unsigned short)my.y;
            asm volatile("s_waitcnt lgkmcnt(0)" ::: "memory");
        }
        LAS unsigned char* vbuf = lds + DSA_LDS_VBUF + wid * (2 * 32 * VROW);
        const int head = q16 & 7;
        h16x8 qf[2];
#pragma unroll
        for (int ks = 0; ks < 2; ++ks) qf[ks] = *(const h16x8*)(P.QA + (brow + qpos) * 512 + head * 64 + ks * 32 + g * 8);
        f32x4 L[16];
        {
            h16x8 ka[2][4][2];
#pragma unroll
            for (int u = 0; u < 4; ++u) { const int e = 16 * u + q16; const int kraw = (int)ql_list[e]; const int key = (e < n) ? kraw : 0;
                ka[0][u][0] = *(const h16x8*)(P.KA + (brow + key) * 64 + g * 8); ka[0][u][1] = *(const h16x8*)(P.KA + (brow + key) * 64 + 32 + g * 8); }
#pragma unroll
            for (int gi = 0; gi < 4; ++gi) {
                if (gi < 3) {
#pragma unroll
                    for (int u = 0; u < 4; ++u) { const int e = 16 * (4 * (gi + 1) + u) + q16; const int kraw = (int)ql_list[e]; const int key = (e < n) ? kraw : 0;
                        ka[(gi + 1) & 1][u][0] = *(const h16x8*)(P.KA + (brow + key) * 64 + g * 8); ka[(gi + 1) & 1][u][1] = *(const h16x8*)(P.KA + (brow + key) * 64 + 32 + g * 8); }
                }
#pragma unroll
                for (int u = 0; u < 4; ++u) { const int T = 4 * gi + u;
                    f32x4 acc = {0.f, 0.f, 0.f, 0.f};
                    acc = __builtin_amdgcn_mfma_f32_16x16x32_f16(ka[gi & 1][u][0], qf[0], acc, 0, 0, 0);
                    acc = __builtin_amdgcn_mfma_f32_16x16x32_f16(ka[gi & 1][u][1], qf[1], acc, 0, 0, 0);
#pragma unroll
                    for (int i = 0; i < 4; ++i) if (16 * T + 4 * g + i >= n) acc[i] = NEG_INF;
                    L[T] = acc; }
                __builtin_amdgcn_sched_barrier(0);
            }
        }
        u32x4 vreg[2][4];
#pragma unroll
        for (int c2 = 0; c2 < 2; ++c2)
#pragma unroll
            for (int i = 0; i < 4; ++i) { const int j = lane >> 3; const int e = 16 * (2 * c2 + (j >> 2)) + 4 * i + (j & 3); const int kraw = (int)ql_list[e]; const int key = (e < n) ? kraw : 0;
                vreg[c2][i] = *(const u32x4*)(P.VA + (brow + key) * 64 + 8 * (lane & 7)); }
        __builtin_amdgcn_sched_barrier(0);
        float mx = NEG_INF;
#pragma unroll
        for (int T = 0; T < 16; ++T)
#pragma unroll
            for (int i = 0; i < 4; ++i) mx = __builtin_fmaxf(mx, L[T][i]);
        mx = __builtin_fmaxf(mx, __shfl_xor(mx, 16)); mx = __builtin_fmaxf(mx, __shfl_xor(mx, 32));
        float lsum = 0.f;
#pragma unroll
        for (int T = 0; T < 16; ++T)
#pragma unroll
            for (int i = 0; i < 4; ++i) { const float p = __builtin_amdgcn_exp2f(L[T][i] - mx); L[T][i] = p; lsum += p; }
        lsum += __shfl_xor(lsum, 16); lsum += __shfl_xor(lsum, 32);
        __builtin_amdgcn_sched_barrier(0);
        f32x4 O[4];
#pragma unroll
        for (int db = 0; db < 4; ++db) O[db] = (f32x4){0.f, 0.f, 0.f, 0.f};
#pragma unroll
        for (int cc = 0; cc < 8; ++cc) {
            LAS unsigned char* vb = vbuf + (cc & 1) * (32 * VROW);
#pragma unroll
            for (int i = 0; i < 4; ++i) *(LAS u32x4*)(vb + (8 * i + (lane >> 3)) * VROW + 16 * (lane & 7)) = vreg[cc & 1][i];
            if (cc < 6) {
#pragma unroll
                for (int i = 0; i < 4; ++i) { const int j = lane >> 3; const int e = 16 * (2 * (cc + 2) + (j >> 2)) + 4 * i + (j & 3); const int kraw = (int)ql_list[e]; const int key = (e < n) ? kraw : 0;
                    vreg[cc & 1][i] = *(const u32x4*)(P.VA + (brow + key) * 64 + 8 * (lane & 7)); }
            }
            asm volatile("s_waitcnt lgkmcnt(0)" ::: "memory");
            h16x8 pa;
#pragma unroll
            for (int i = 0; i < 4; ++i) { pa[i] = (h16)L[2 * cc][i]; pa[4 + i] = (h16)L[2 * cc + 1][i]; }
#pragma unroll
            for (int db = 0; db < 4; ++db) {
                const LAS unsigned char* pb = vb + (8 * g + ((lane & 15) >> 2)) * VROW + (16 * db + 4 * (lane & 3)) * 2;
                const s16x4 lo4 = __builtin_amdgcn_ds_read_tr16_b64_v4i16((LAS s16x4*)pb);
                const s16x4 hi4 = __builtin_amdgcn_ds_read_tr16_b64_v4i16((LAS s16x4*)(pb + 4 * VROW));
                const s16x8 bf = {lo4[0], lo4[1], lo4[2], lo4[3], hi4[0], hi4[1], hi4[2], hi4[3]};
                O[db] = __builtin_amdgcn_mfma_f32_16x16x32_f16(pa, __builtin_bit_cast(h16x8, bf), O[db], 0, 0, 0);
            }
            __builtin_amdgcn_sched_barrier(0);
        }
#pragma unroll
        for (int i = 0; i < 4; ++i) { const float lh = __shfl(lsum, (4 * g + i) & 7); const float rl = 1.0f / lh;
            if (g < 2) {
#pragma unroll
                for (int db = 0; db < 4; ++db) P.Y[(brow + qpos) * DM + (4 * g + i) * 64 + 16 * db + q16] = (h16)(O[db][i] * rl); } }
    }
    __syncthreads();
}

constexpr int MB_LDS_KM = 0  , MB_LDS_KV = 4096  , MB_TILE = 64 * VROW;
__device__ __forceinline__ int crow(int r, int hi) { return (r & 3) + 8 * (r >> 2) + 4 * hi; }

__device__ __forceinline__ void moba_unit(LAS unsigned char* lds, const AttnPtrs& P, int b, int h, int j) {
    const int tid = threadIdx.x, lane = tid & 63, wid = __builtin_amdgcn_readfirstlane(tid >> 6), r32 = lane & 31, hi = lane >> 5;
    const size_t brow = (size_t)b * SEQ; const int q0 = 256 * j; const int qrel = 32 * wid + r32; const size_t qrow = brow + q0 + qrel;
    LAS float* km = (LAS float*)(lds + MB_LDS_KM);
    for (int i = tid; i < 16 * 64; i += 512) { const int n = i >> 6, d = i & 63; const size_t pm = (size_t)b * 16 + n;
        km[i] = (P.kmp[((pm * 2 + 0) * 8 + h) * 64 + d] + P.kmp[((pm * 2 + 1) * 8 + h) * 64 + d]) * (1.0f / 256.0f); }
    __syncthreads();
    h16x8 qf[4];
#pragma unroll
    for (int d0 = 0; d0 < 4; ++d0) qf[d0] = *(const h16x8*)(P.QB + qrow * 512 + h * 64 + d0 * 16 + hi * 8);
    unsigned selmask = 0u;
    {
        float gate[8];
#pragma unroll
        for (int nb = 0; nb < 8; ++nb) gate[nb] = 0.f;
#pragma unroll
        for (int c8 = 0; c8 < 8; ++c8) {
            const h16x8 qv = *(const h16x8*)(P.QB + qrow * 512 + h * 64 + c8 * 8);
#pragma unroll
            for (int nb = 0; nb < 8; ++nb) { const LAS float* kr = km + (8 * hi + nb) * 64 + c8 * 8;
#pragma unroll
                for (int e = 0; e < 8; ++e) gate[nb] += (float)qv[e] * kr[e]; }
        }
        float gall[16];
#pragma unroll
        for (int nb = 0; nb < 8; ++nb) { const float o = __shfl_xor(gate[nb], 32); gall[nb] = hi ? o : gate[nb]; gall[8 + nb] = hi ? gate[nb] : o; }
#pragma unroll
        for (int n = 0; n < 16; ++n) if (n >= j) gall[n] = NEG_INF;
#pragma unroll
        for (int pick = 0; pick < 3; ++pick) { float best = NEG_INF; int bi = -1;
#pragma unroll
            for (int n = 0; n < 16; ++n) if (gall[n] > best) { best = gall[n]; bi = n; }
            if (bi >= 0) { selmask |= 1u << bi;
#pragma unroll
                for (int n = 0; n < 16; ++n) if (n == bi) gall[n] = NEG_INF; } }
    }
    const int NT = 4 * (j + 1);
    const h16* Kg = P.KB + brow * 512 + h * 64; const h16* Vg = P.VB + brow * 512 + h * 64;
    const int lrow = tid >> 3, lch = tid & 7;
    auto tile_key0 = [&](int t) { return (t < 4) ? (q0 + 64 * t) : (64 * (t - 4)); };
    u32x4 kreg, vreg;
    { const int k0 = tile_key0(0); kreg = *(const u32x4*)(Kg + (size_t)(k0 + lrow) * 512 + lch * 8); vreg = *(const u32x4*)(Vg + (size_t)(k0 + lrow) * 512 + lch * 8); }
    { LAS unsigned char* kb = lds + MB_LDS_KV; *(LAS u32x4*)(kb + lrow * VROW + lch * 16) = kreg; *(LAS u32x4*)(kb + MB_TILE + lrow * VROW + lch * 16) = vreg; }
    __syncthreads();
    float mrun = NEG_INF, lrun = 0.f; f32x16 o[2]; o[0] = f32x16{}; o[1] = f32x16{};
#pragma unroll 1
    for (int t = 0; t < NT; ++t) {
        if (t + 1 < NT) { const int k0 = tile_key0(t + 1); kreg = *(const u32x4*)(Kg + (size_t)(k0 + lrow) * 512 + lch * 8); vreg = *(const u32x4*)(Vg + (size_t)(k0 + lrow) * 512 + lch * 8); }
        const LAS unsigned char* kb = lds + MB_LDS_KV + (t & 1) * (2 * MB_TILE); const LAS unsigned char* vb = kb + MB_TILE;
        bool active;
        if (t < 4) active = (64 * t) <= (32 * wid + 31);
        else active = __any((selmask >> ((t - 4) >> 2)) & 1u);
        if (active) {
            f32x16 p0 = f32x16{}, p1 = f32x16{};
#pragma unroll
            for (int d0 = 0; d0 < 4; ++d0) {
                const h16x8 k0f = *(const LAS h16x8*)(kb + r32 * VROW + (16 * d0 + 8 * hi) * 2);
                const h16x8 k1f = *(const LAS h16x8*)(kb + (32 + r32) * VROW + (16 * d0 + 8 * hi) * 2);
                p0 = __builtin_amdgcn_mfma_f32_32x32x16_f16(k0f, qf[d0], p0, 0, 0, 0);
                p1 = __builtin_amdgcn_mfma_f32_32x32x16_f16(k1f, qf[d0], p1, 0, 0, 0);
            }
            if (t < 4) {
#pragma unroll
                for (int r = 0; r < 16; ++r) { const int kv = 64 * t + crow(r, hi); if (kv > qrel) p0[r] = NEG_INF; if (kv + 32 > qrel) p1[r] = NEG_INF; }
            } else if (!((selmask >> ((t - 4) >> 2)) & 1u)) {
#pragma unroll
                for (int r = 0; r < 16; ++r) { p0[r] = NEG_INF; p1[r] = NEG_INF; }
            }
            float mt = NEG_INF;
#pragma unroll
            for (int r = 0; r < 16; ++r) mt = __builtin_fmaxf(mt, __builtin_fmaxf(p0[r], p1[r]));
            mt = __builtin_fmaxf(mt, __shfl_xor(mt, 32));
            const float mnew = __builtin_fmaxf(mrun, mt);
            const float alpha = (mnew == NEG_INF) ? 1.0f : __builtin_amdgcn_exp2f(mrun - mnew);
            const float msub = (mnew == NEG_INF) ? 0.f : mnew;
            float ps = 0.f;
#pragma unroll
            for (int r = 0; r < 16; ++r) { p0[r] = __builtin_amdgcn_exp2f(p0[r] - msub); p1[r] = __builtin_amdgcn_exp2f(p1[r] - msub); ps += p0[r] + p1[r]; }
            lrun = lrun * alpha + ps; mrun = mnew;
            if (__any(alpha != 1.0f)) {
#pragma unroll
                for (int r = 0; r < 16; ++r) { o[0][r] *= alpha; o[1][r] *= alpha; }
            }
#pragma unroll
            for (int kt = 0; kt < 2; ++kt)
#pragma unroll
                for (int s = 0; s < 2; ++s) {
                    h16x8 pb;
#pragma unroll
                    for (int e = 0; e < 8; ++e) pb[e] = (h16)(kt ? p1[8 * s + e] : p0[8 * s + e]);
#pragma unroll
                    for (int db = 0; db < 2; ++db) {
                        const LAS unsigned char* pa = vb + (32 * kt + 16 * s + 4 * hi + ((lane & 15) >> 2)) * VROW + (32 * db + 16 * ((lane >> 4) & 1) + 4 * (lane & 3)) * 2;
                        const s16x4 lo4 = __builtin_amdgcn_ds_read_tr16_b64_v4i16((LAS s16x4*)pa);
                        const s16x4 hi4 = __builtin_amdgcn_ds_read_tr16_b64_v4i16((LAS s16x4*)(pa + 8 * VROW));
                        const s16x8 af = {lo4[0], lo4[1], lo4[2], lo4[3], hi4[0], hi4[1], hi4[2], hi4[3]};
                        o[db] = __builtin_amdgcn_mfma_f32_32x32x16_f16(__builtin_bit_cast(h16x8, af), pb, o[db], 0, 0, 0);
                    }
                }
        }
        if (t + 1 < NT) { LAS unsigned char* nb = lds + MB_LDS_KV + ((t + 1) & 1) * (2 * MB_TILE); *(LAS u32x4*)(nb + lrow * VROW + lch * 16) = kreg; *(LAS u32x4*)(nb + MB_TILE + lrow * VROW + lch * 16) = vreg; }
        __syncthreads();
    }
    lrun += __shfl_xor(lrun, 32);
    const float rl = 1.0f / lrun;
    h16* yrow = P.Y + qrow * DM + 512 + h * 64;
#pragma unroll
    for (int db = 0; db < 2; ++db)
#pragma unroll
        for (int rg = 0; rg < 4; ++rg) { u32x2 w; w.x = pkh(o[db][4 * rg] * rl, o[db][4 * rg + 1] * rl); w.y = pkh(o[db][4 * rg + 2] * rl, o[db][4 * rg + 3] * rl);
            *(u32x2*)(yrow + 32 * db + 8 * rg + 4 * hi) = w; }
}


namespace moba_fast {
using bf16=_Float16;
using bf16x8=__attribute__((ext_vector_type(8)))short;
using s16x4=__attribute__((ext_vector_type(4)))short;
using f32x16=__attribute__((ext_vector_type(16)))float;
using u32x4=__attribute__((ext_vector_type(4)))unsigned;
constexpr int BATCH=8,NHEAD=8,SEQ=4096,D=64,DM=NHEAD*D,OPITCH=1024,OCOL=512;
constexpr int NW=8,QBLK=32,QB=QBLK*NW,KVBLK=64,NQB=SEQ/QB;
constexpr int ATTN_PITCH=DM, ATTN_UNIT_ROWS=QB;
__device__ __forceinline__ int crow(int r,int hi){return (r&3)+8*(r>>2)+4*hi;}
#define SBAR() __builtin_amdgcn_sched_barrier(0)
#define MFMAH(a,b,c) __builtin_amdgcn_mfma_f32_32x32x16_f16(__builtin_bit_cast(h16x8,(a)),__builtin_bit_cast(h16x8,(b)),(c),0,0,0)
__device__ __forceinline__ void cmask(f32x16&p0,f32x16&p1,int jb,int qrel,int hi){
  const float NEG=(-__builtin_huge_valf()); int kb=64*jb+4*hi;
  #pragma unroll
  for(int r=0;r<16;++r){int kv=kb+(r&3)+8*(r>>2); if(kv>qrel)p0[r]=NEG; if(kv+32>qrel)p1[r]=NEG;}
}

constexpr int NSLOT=3, SLOTB=8192;
constexpr int LDS_K=0, LDS_V=NSLOT*SLOTB, LDS_WS=2*NSLOT*SLOTB, LDS_OST=LDS_WS+NW*64*4, LDS_BYTES=LDS_OST+NW*4096;
constexpr float C2=0.125f*1.4426950408889634f;
__device__ __forceinline__ void glds16(const void*gsrc,unsigned lds_dst){unsigned keep;
  asm volatile("s_mov_b32 %0, m0\n\ts_mov_b32 m0, %2\n\ts_nop 0\n\tglobal_load_lds_dwordx4 %1, off\n\ts_mov_b32 m0, %0":"=&s"(keep):"v"(gsrc),"s"(lds_dst):"memory");}
__device__ __forceinline__ void glds16s(unsigned voff,const void*sbase,unsigned lds_dst){unsigned keep;
  asm volatile("s_mov_b32 %0, m0\n\ts_mov_b32 m0, %3\n\ts_nop 0\n\tglobal_load_lds_dwordx4 %1, %2\n\ts_mov_b32 m0, %0":"=&s"(keep):"v"(voff),"s"(sbase),"s"(lds_dst):"memory");}
__device__ __forceinline__ float max3f(float a,float b,float c){float r;asm("v_max3_f32 %0, %1, %2, %3":"=v"(r):"v"(a),"v"(b),"v"(c));return r;}
__device__ __forceinline__ float max2f(float a,float b){float r;asm("v_max_f32_e32 %0, %1, %2":"=v"(r):"v"(a),"v"(b));return r;}
__device__ __forceinline__ float fadd_s(float a,float b){float r;asm("v_add_f32_e32 %0, %1, %2":"=v"(r):"v"(a),"v"(b));return r;}
__device__ __forceinline__ float fsub_s(float a,float b){float r;asm("v_sub_f32_e32 %0, %1, %2":"=v"(r):"v"(a),"v"(b));return r;}
typedef float f32x2_t __attribute__((ext_vector_type(2))); typedef _Float16 bf16x2_t __attribute__((ext_vector_type(2)));
__device__ __forceinline__ unsigned cvtpk_s(float lo,float hi){f32x2_t v={lo,hi};bf16x2_t b=__builtin_convertvector(v,bf16x2_t);return __builtin_bit_cast(unsigned,b);}
#define WAIT_BAR(N) asm volatile("s_waitcnt vmcnt(" #N ") lgkmcnt(0)\n\ts_barrier":::"memory")

__device__ __forceinline__ void qkt(f32x16&p0,f32x16&p1,const char*Kslot,const bf16x8*qr,const f32x16&negm,int r32,int hi){
  const char*kb=Kslot+hi*1024+r32*16;
  #pragma unroll
  for(int d0=0;d0<4;++d0){
    const bf16x8 b0=*reinterpret_cast<const bf16x8*>(kb+d0*2048);
    const bf16x8 b1=*reinterpret_cast<const bf16x8*>(kb+d0*2048+512);
    if(d0==0){p0=MFMAH(b0,qr[0],negm);p1=MFMAH(b1,qr[0],negm);}
    else{p0=MFMAH(b0,qr[d0],p0);p1=MFMAH(b1,qr[d0],p1);}}
}
typedef __attribute__((address_space(3))) const char* lds_cptr;
typedef short v4i16_t __attribute__((ext_vector_type(4)));
__device__ __forceinline__ void kload8(bf16x8*kf,lds_cptr kp){
  kf[0]=*(const __attribute__((address_space(3))) bf16x8*)(kp);      kf[1]=*(const __attribute__((address_space(3))) bf16x8*)(kp+512);
  kf[2]=*(const __attribute__((address_space(3))) bf16x8*)(kp+2048); kf[3]=*(const __attribute__((address_space(3))) bf16x8*)(kp+2560);
  kf[4]=*(const __attribute__((address_space(3))) bf16x8*)(kp+4096); kf[5]=*(const __attribute__((address_space(3))) bf16x8*)(kp+4608);
  kf[6]=*(const __attribute__((address_space(3))) bf16x8*)(kp+6144); kf[7]=*(const __attribute__((address_space(3))) bf16x8*)(kp+6656);
}
__device__ __forceinline__ void kload2(bf16x8*kf,lds_cptr kp,int j){ kf[2*j]=*(const __attribute__((address_space(3))) bf16x8*)(kp+j*2048); kf[2*j+1]=*(const __attribute__((address_space(3))) bf16x8*)(kp+j*2048+512); }
__device__ __forceinline__ s16x4 vtr(lds_cptr p){ return __builtin_bit_cast(s16x4,__builtin_amdgcn_ds_read_tr16_b64_v4i16((__attribute__((address_space(3))) v4i16_t*)p)); }
__device__ __forceinline__ float rowmax(const f32x16&p0,const f32x16&p1){
  float a=max3f(p0[0],p0[1],p1[0]),b=max3f(p0[2],p0[3],p1[1]);a=max3f(a,p1[2],p1[3]);
  #pragma unroll
  for(int r=4;r<16;r+=4){a=max3f(a,p0[r],p0[r+1]);b=max3f(b,p0[r+2],p0[r+3]);a=max3f(a,p1[r],p1[r+1]);b=max3f(b,p1[r+2],p1[r+3]);}
  const float m=max2f(a,b);
  auto rr=__builtin_amdgcn_permlane32_swap(__float_as_uint(m),__float_as_uint(m),false,false);
  return max2f(__uint_as_float(rr[0]),__uint_as_float(rr[1]));
}
__device__ __forceinline__ void pv(f32x16*o,int vb,bf16x8 pa0,bf16x8 pa1,bf16x8 pa2,bf16x8 pa3){
  #pragma unroll
  for(int d0=0;d0<2;++d0){s16x4 lo[4],hi[4];
    #pragma unroll
    for(int ks=0;ks<4;++ks){
      asm volatile("ds_read_b64_tr_b16 %0,%1 offset:%c2":"=&v"(lo[ks]):"v"(vb),"i"(d0*4096+ks*1024):"memory");
      asm volatile("ds_read_b64_tr_b16 %0,%1 offset:%c2":"=&v"(hi[ks]):"v"(vb),"i"(d0*4096+ks*1024+512):"memory");}
    asm volatile("s_waitcnt lgkmcnt(0)":::"memory");SBAR();
    #define PK(k) (bf16x8){lo[k][0],lo[k][1],lo[k][2],lo[k][3],hi[k][0],hi[k][1],hi[k][2],hi[k][3]}
    o[d0]=MFMAH(pa0,PK(0),o[d0]);
    o[d0]=MFMAH(pa1,PK(1),o[d0]);
    o[d0]=MFMAH(pa2,PK(2),o[d0]);
    o[d0]=MFMAH(pa3,PK(3),o[d0]);
    #undef PK
  }
}

#ifndef ATTN_STORE16
#define ATTN_STORE16(p,v) (*(u32x4*)(p)=(v))
#endif
template<int THRL> __device__ __forceinline__ void attn_unit(int b,int h,int qb,const bf16*Q,const bf16*__restrict__ K,const bf16*__restrict__ V,bf16*O,char*shm,const unsigned selmask,const int wid_s){
  #define KT(t) (((t)<4)?(4*qb+(t)):((t)-4))
  const int lane=lane_id_fresh(),r32=lane&31,hi=lane>>5; const int wid=wid_s;
  const long rowbase=(long)b*SEQ; const int q0=qb*QB;
  const bf16*Qw=Q+(rowbase+q0+wid*QBLK)*DM+h*D;
  const bf16*Kh=K+rowbase*DM+h*D,*Vh=V+rowbase*DM+h*D;
  const unsigned lds0=(unsigned)(uintptr_t)shm;
  float*wsf=(float*)(shm+LDS_WS)+wid*64;
  const unsigned koff=(unsigned)((lane*DM+wid*8)*2);
  const unsigned voff=(unsigned)(((16*(wid&3)+(lane>>2))*DM+(wid>>2)*32+(lane&3)*8)*2);
  const unsigned kdst=lds0+LDS_K+wid*1024, vdst=lds0+LDS_V+wid*1024;
  #define DMA_K(t,slot) glds16s(koff,(const char*)Kh+(long)KT(t)*(KVBLK*DM*2),(unsigned)__builtin_amdgcn_readfirstlane(kdst+(slot)))
  #define DMA_V(t,slot) glds16s(voff,(const char*)Vh+(long)KT(t)*(KVBLK*DM*2),(unsigned)__builtin_amdgcn_readfirstlane(vdst+(slot)))
  const int vb0=(int)(lds0+LDS_V)+((lane>>4)&1)*32+(lane&3)*8+(4*hi+((lane&15)>>2))*64;
  const char*Kbase=shm+LDS_K; bf16x8 kf[8];
  const lds_cptr shm3=(lds_cptr)shm; const lds_cptr kp0=shm3+LDS_K+hi*1024+r32*16; const lds_cptr vp0=shm3+LDS_V+((lane>>4)&1)*32+(lane&3)*8+(4*hi+((lane&15)>>2))*64;
  const int NT=(q0+QB)/KVBLK;
  DMA_K(0,0);DMA_V(0,0);DMA_K(1,SLOTB);
  bf16x8 qr[4];
  #pragma unroll
  for(int d0=0;d0<4;++d0)qr[d0]=*reinterpret_cast<const bf16x8*>(&Qw[(long)r32*DM+d0*16+hi*8]);
  float mhat=0.f,l_reg=0.f;f32x16 o[2];o[0]=f32x16{};o[1]=f32x16{};const f32x16 negm=f32x16{}; float msub_=0.f;
  const int qrel=wid*QBLK+r32;
  #define CMASK(P0,P1,t) do{ if((t)<4)cmask(P0,P1,(t),qrel,hi); }while(0)
  bool resc=false;
  #define START(P0,P1) do{ const float rm=rowmax(P0,P1); resc=false; \
    { const float dl=rm; mhat=fadd_s(mhat,dl); \
      _Pragma("unroll") for(int r=0;r<16;++r){P0[r]=fsub_s(P0[r],dl);P1[r]=fsub_s(P1[r],dl);} \
      } \
    _Pragma("unroll") for(int r=0;r<16;++r)P0[r]=__builtin_amdgcn_exp2f(P0[r]); }while(0)
  #define RESC() do{ if(resc){ asm volatile("s_waitcnt lgkmcnt(0)":::"memory"); \
      _Pragma("unroll") for(int d_=0;d_<2;++d_) _Pragma("unroll") for(int r=0;r<16;++r)o[d_][r]*=wsf[crow(r,hi)]; } }while(0)
  f32x16 pA0,pA1,pB0,pB1;
  int sl_prev=0,sl_cur=0,sl_next=SLOTB;
  #define ROT() do{sl_prev=sl_cur;sl_cur=sl_next;sl_next=(sl_next==(NSLOT-1)*SLOTB)?0:sl_next+SLOTB;}while(0)
  DMA_K(2,2*SLOTB);
  WAIT_BAR(3);
  qkt(pA0,pA1,Kbase,qr,negm,r32,hi);asm volatile("s_nop 15\n\ts_nop 7":"+v"(pA0),"+v"(pA1));CMASK(pA0,pA1,0);
  START(pA0,pA1);
  _Pragma("unroll") for(int r=0;r<16;++r)pA1[r]=__builtin_amdgcn_exp2f(pA1[r]);
  WAIT_BAR(0);
  DMA_K(3,0);DMA_V(1,SLOTB);
  ROT();
  kload8(kf,kp0+sl_cur);
  WAIT_BAR(2);
  s16x4 vlo[8],vhi[8]; u32x4 pw0,pw1,pw2,pw3;
  #define PKW(P,B) cvtpk_s(P[B],P[B+1])
  #define PAF(k) __builtin_bit_cast(bf16x8,pw##k)
  #define VFR(i) (bf16x8){vlo[i][0],vlo[i][1],vlo[i][2],vlo[i][3],vhi[i][0],vhi[i][1],vhi[i][2],vhi[i][3]}
  #define PIN(x) asm volatile("":"+v"(x))
  #define MX3(a,b,c) __builtin_fmaxf(__builtin_fmaxf((a),(b)),(c))
  #define GAPA(MF,A0,A1,A2,A3,W0,W1,PW) do{ MF; sacc+=A0; sacc+=A1; sacc+=A2; sacc+=A3; PIN(sacc); W0; W1; PIN(PW); SBAR(); }while(0)
  #define EX(v) __builtin_amdgcn_exp2f((v)-msub_)
  #define GAPB(MF,X,B) do{ MF; X[B]=EX(X[B]); X[B+1]=EX(X[B+1]); X[B+2]=EX(X[B+2]); X[B+3]=EX(X[B+3]); PIN(X); SBAR(); }while(0)
  #define VRD(i) do{ vlo[i]=vtr(vp_+(((i)>>2)*4096+((i)&3)*1024)); vhi[i]=vtr(vp_+(((i)>>2)*4096+((i)&3)*1024+512)); }while(0)
  #define KRD(G,j) do{ if(G){ kload2(kf,kp0+sl_next,j); SBAR(); } }while(0)
  #define STEP(C0,C1,P0,P1,t,GK,GV,GL) do{ SBAR(); \
    const bool st_=((t)<4)||((selmask>>(((t)-4)>>2))&1u); \
    const lds_cptr vp_=vp0+sl_prev; \
    VRD(0); SBAR(); float sacc=(P0[0]+P0[1]); \
    GAPA(C0=MFMAH(kf[0],qr[0],(f32x16{})), P0[2],P0[3],P0[4],P0[5],     pw0[0]=PKW(P0,0), pw0[1]=PKW(P0,2), pw0); \
    VRD(4); SBAR(); GAPA(C1=MFMAH(kf[1],qr[0],(f32x16{})), P0[6],P0[7],P0[8],P0[9],     pw0[2]=PKW(P0,4), pw0[3]=PKW(P0,6), pw0); \
    VRD(1); SBAR(); GAPA(C0=MFMAH(kf[2],qr[1],C0),   P0[10],P0[11],P0[12],P0[13], pw1[0]=PKW(P0,8), pw1[1]=PKW(P0,10), pw1); \
    VRD(5); SBAR(); GAPA(C1=MFMAH(kf[3],qr[1],C1),   P0[14],P0[15],P1[0],P1[1],   pw1[2]=PKW(P0,12),pw1[3]=PKW(P0,14), pw1); \
    VRD(2); SBAR(); GAPA(C0=MFMAH(kf[4],qr[2],C0),   P1[2],P1[3],P1[4],P1[5],     pw2[0]=PKW(P1,0), pw2[1]=PKW(P1,2), pw2); \
    VRD(6); SBAR(); GAPA(C1=MFMAH(kf[5],qr[2],C1),   P1[6],P1[7],P1[8],P1[9],     pw2[2]=PKW(P1,4), pw2[3]=PKW(P1,6), pw2); \
    VRD(3); SBAR(); GAPA(C0=MFMAH(kf[6],qr[3],C0),   P1[10],P1[11],P1[12],P1[13], pw3[0]=PKW(P1,8), pw3[1]=PKW(P1,10), pw3); \
    VRD(7); SBAR(); GAPA(C1=MFMAH(kf[7],qr[3],C1),   P1[14],P1[15],0.f,0.f,       pw3[2]=PKW(P1,12),pw3[3]=PKW(P1,14), pw3); \
    l_reg+=sacc; \
    if(GK){DMA_K((t)+3,sl_cur);} if(GV){DMA_V((t)+1,sl_next);} \
    CMASK(C0,C1,t); \
    { float a=MX3(C0[0],C0[1],C1[0]),b=MX3(C0[2],C0[3],C1[1]); a=MX3(a,C1[2],C1[3]); \
      _Pragma("unroll") for(int r=4;r<16;r+=4){a=MX3(a,C0[r],C0[r+1]);b=MX3(b,C0[r+2],C0[r+3]);a=MX3(a,C1[r],C1[r+1]);b=MX3(b,C1[r+2],C1[r+3]);} \
      float rm=__builtin_fmaxf(a,b); { auto rr=__builtin_amdgcn_permlane32_swap(__float_as_uint(rm),__float_as_uint(rm),false,false); rm=__builtin_fmaxf(__uint_as_float(rr[0]),__uint_as_float(rr[1])); } \
      rm=st_?rm:(-__builtin_huge_valf()); const float rel_=rm-mhat; \
      resc=false; \
      if(__builtin_expect(__any(rel_>(float)THRL),0)){ const float dl=__builtin_fmaxf(rel_,0.f); mhat+=dl; \
        const float f=__builtin_amdgcn_exp2f(-dl); l_reg*=f; if(hi==0)wsf[r32]=f; resc=true; } } \
    msub_=st_?mhat:__builtin_huge_valf(); \
    SBAR(); \
    GAPB(o[0]=MFMAH(PAF(0),VFR(0),o[0]), C0,0); \
    GAPB(o[1]=MFMAH(PAF(0),VFR(4),o[1]), C0,4); \
    KRD(GL,0); GAPB(o[0]=MFMAH(PAF(1),VFR(1),o[0]), C0,8); \
    KRD(GL,1); GAPB(o[1]=MFMAH(PAF(1),VFR(5),o[1]), C0,12); \
    KRD(GL,2); GAPB(o[0]=MFMAH(PAF(2),VFR(2),o[0]), C1,0); \
    KRD(GL,3); GAPB(o[1]=MFMAH(PAF(2),VFR(6),o[1]), C1,4); \
    GAPB(o[0]=MFMAH(PAF(3),VFR(3),o[0]), C1,8); \
    GAPB(o[1]=MFMAH(PAF(3),VFR(7),o[1]), C1,12); \
    }while(0)
  int t=1;
  for(;t+5<NT;t+=2){
    STEP(pB0,pB1,pA0,pA1,t,true,true,true);     WAIT_BAR(2); RESC(); ROT();
    STEP(pA0,pA1,pB0,pB1,t+1,true,true,true);   WAIT_BAR(2); RESC(); ROT();
  }
  #define ENDW(tt) do{ if((tt)+3<NT){WAIT_BAR(2);} else if((tt)+2<NT){WAIT_BAR(1);} else {WAIT_BAR(0);} }while(0)
  for(;t+1<NT;t+=2){
    STEP(pB0,pB1,pA0,pA1,t,(t+3<NT),(t+1<NT),(t+1<NT));       ENDW(t);   RESC(); ROT();
    STEP(pA0,pA1,pB0,pB1,t+1,(t+4<NT),(t+2<NT),(t+2<NT));     ENDW(t+1); RESC(); ROT();
  }
  STEP(pB0,pB1,pA0,pA1,NT-1,false,false,false); RESC();
  { float sacc=pB0[0]+pB0[1]; _Pragma("unroll") for(int r=2;r<16;++r)sacc+=pB0[r]; _Pragma("unroll") for(int r=0;r<16;++r)sacc+=pB1[r]; l_reg+=sacc;
    pw0=(u32x4){PKW(pB0,0),PKW(pB0,2),PKW(pB0,4),PKW(pB0,6)};pw1=(u32x4){PKW(pB0,8),PKW(pB0,10),PKW(pB0,12),PKW(pB0,14)};pw2=(u32x4){PKW(pB1,0),PKW(pB1,2),PKW(pB1,4),PKW(pB1,6)};pw3=(u32x4){PKW(pB1,8),PKW(pB1,10),PKW(pB1,12),PKW(pB1,14)};
    SBAR(); pv(o,vb0+sl_cur,PAF(0),PAF(1),PAF(2),PAF(3)); }
  #undef PKW
  #undef PAF
  #undef VFR
  #undef PIN
  #undef MX3
  #undef GAPA
  #undef GAPB
  #undef EX
  #undef VRD
  #undef KRD
  #undef STEP
  #undef ENDW
  {auto rr=__builtin_amdgcn_permlane32_swap(__float_as_uint(l_reg),__float_as_uint(l_reg),false,false);l_reg=__uint_as_float(rr[0])+__uint_as_float(rr[1]);}
  if(hi==0)wsf[32+r32]=l_reg;asm volatile("s_waitcnt lgkmcnt(0)":::"memory");
  float rli[16];
  #pragma unroll
  for(int r=0;r<16;++r)rli[r]=__builtin_amdgcn_rcpf(wsf[32+crow(r,hi)]);
  bf16*Ow=O+(rowbase+q0+wid*QBLK)*OPITCH+OCOL+h*D;
  { bf16*stg=(bf16*)(shm+LDS_OST)+wid*2048;
    #pragma unroll
    for(int r=0;r<16;++r){const int orow=crow(r,hi);
      #pragma unroll
      for(int d0=0;d0<2;++d0)stg[orow*64+d0*32+r32]=(bf16)(o[d0][r]*rli[r]);}
    asm volatile("s_waitcnt lgkmcnt(0)":::"memory");
    #pragma unroll
    for(int i=0;i<4;++i){const int row=i*8+(lane>>3),ch=lane&7; const u32x4 v=*(const u32x4*)(stg+row*64+ch*8); ATTN_STORE16(Ow+(long)row*OPITCH+ch*8,v);} }
  asm volatile("s_waitcnt lgkmcnt(0)\n\ts_barrier":::"memory");
  #undef DMA_K
  #undef DMA_V
  #undef CMASK
  #undef START
  #undef RESC
  #undef ROT
}
constexpr int ATTN_LDS_BYTES=LDS_BYTES;
#undef KT
#undef MFMAH
#undef SBAR
#undef WAIT_BAR
}


constexpr int MBF_KM = 86016;
__device__ __forceinline__ void moba_unit_fast(char* lds_gen, LAS unsigned char* lds, const AttnPtrs& P, int b, int h, int j, const int wid) {
    const int lane = lane_id_fresh(), tid = wid * 64 + lane, r32 = lane & 31, hi = lane >> 5;
    const size_t qrow = (size_t)b * SEQ + 256 * j + 32 * wid + r32;
    LAS float* km = (LAS float*)(lds + MBF_KM);
    for (int i = tid; i < 16 * 64; i += 512) { const int n = i >> 6, d = i & 63; const size_t pm = (size_t)b * 16 + n;
        km[i] = (P.kmp[((pm * 2 + 0) * 8 + h) * 64 + d] + P.kmp[((pm * 2 + 1) * 8 + h) * 64 + d]) * (1.0f / 256.0f); }
    __syncthreads();
    unsigned selmask = 0u;
    {
        float gate[8];
#pragma unroll
        for (int nb = 0; nb < 8; ++nb) gate[nb] = 0.f;
#pragma unroll
        for (int c8 = 0; c8 < 8; ++c8) {
            const h16x8 qv = *(const h16x8*)(P.QB + qrow * 512 + h * 64 + c8 * 8);
#pragma unroll
            for (int nb = 0; nb < 8; ++nb) { const LAS float* kr = km + (8 * hi + nb) * 64 + c8 * 8;
#pragma unroll
                for (int e = 0; e < 8; ++e) gate[nb] += (float)qv[e] * kr[e]; }
        }
        float gall[16];
#pragma unroll
        for (int nb = 0; nb < 8; ++nb) { const float o = __shfl_xor(gate[nb], 32); gall[nb] = hi ? o : gate[nb]; gall[8 + nb] = hi ? gate[nb] : o; }
#pragma unroll
        for (int n = 0; n < 16; ++n) if (n >= j) gall[n] = NEG_INF;
#pragma unroll
        for (int pick = 0; pick < 3; ++pick) { float best = NEG_INF; int bi = -1;
#pragma unroll
            for (int n = 0; n < 16; ++n) if (gall[n] > best) { best = gall[n]; bi = n; }
            if (bi >= 0) { selmask |= 1u << bi;
#pragma unroll
                for (int n = 0; n < 16; ++n) if (n == bi) gall[n] = NEG_INF; } }
    }
    moba_fast::attn_unit<8>(b, h, j, (const _Float16*)P.QB, (const _Float16*)P.KB, (const _Float16*)P.VB, (_Float16*)P.Y, lds_gen, selmask, wid);
}

#define XB_TMO      128
#define XB_XCNT(j)  (256  + 64 * (j))
#define XB_XSUB(j)  (1280 + 64 * (j))
#define XB_XGEN(j)  (2304 + 64 * (j))
#define XB_TOP      3328
#define XB_TOPGEN   3392
#define XCD_BAR_WORDS 3456
#define XB_SPIN_CAP (1u << 22)
__device__ __forceinline__ unsigned xb_ld(unsigned* p)              { return __hip_atomic_load(p, __ATOMIC_RELAXED, __HIP_MEMORY_SCOPE_AGENT); }
__device__ __forceinline__ unsigned xb_add(unsigned* p, unsigned v) { return __hip_atomic_fetch_add(p, v, __ATOMIC_RELAXED, __HIP_MEMORY_SCOPE_AGENT); }
__device__ __forceinline__ unsigned xb_xcc_id() { return (unsigned)__builtin_amdgcn_s_getreg((3 << 11) | 20) & 0xFu; }
#define XB_SPIN(cond, bar) do { unsigned _sp = 0; while (cond) { __builtin_amdgcn_s_sleep(1); \
    if ((++_sp & 255u) == 0u) { if (xb_ld(&(bar)[XB_TMO])) break; if (_sp > XB_SPIN_CAP) { atomicAdd(&(bar)[XB_TMO], 1u); break; } } } } while (0)
struct XcdBarrier { unsigned* bar; unsigned x; volatile LAS unsigned* st; };
__device__ __forceinline__ XcdBarrier xcd_barrier_post(unsigned* bar, volatile LAS unsigned* st) {
    XcdBarrier b; b.bar = bar; b.x = xb_xcc_id(); b.st = st;
    if (threadIdx.x == 0) (void)xb_add(&bar[XB_XCNT(b.x)], 1u);
    return b;
}
__device__ __forceinline__ void xcd_barrier_complete(unsigned* bar, unsigned x, unsigned& nloc, unsigned& nx) {
    const unsigned G = gridDim.x * gridDim.y * gridDim.z;
    unsigned sum, cnt, mine, sp = 0u;
    for (;;) {
        sum = 0u; cnt = 0u; mine = 0u;
#pragma unroll
        for (unsigned j = 0; j < 16; ++j) { const unsigned c = xb_ld(&bar[XB_XCNT(j)]); sum += c; cnt += (c > 0u) ? 1u : 0u; mine = (j == x) ? c : mine; }
        if (sum == G) break;
        __builtin_amdgcn_s_sleep(1);
        if ((++sp & 255u) == 0u) { if (xb_ld(&bar[XB_TMO])) break; if (sp > XB_SPIN_CAP) { atomicAdd(&bar[XB_TMO], 1u); break; } }
    }
    nloc = mine > 0u ? mine : 1u; nx = cnt > 0u ? cnt : 1u;
}
__device__ __forceinline__ void xcd_barrier(const XcdBarrier& b) {
    asm volatile("s_waitcnt vmcnt(0)" ::: "memory");
    __syncthreads();
    if (threadIdx.x == 0) {
        unsigned* bar = b.bar;
        __builtin_amdgcn_s_waitcnt(0);
        unsigned nloc = b.st[0], nx = b.st[1];
        if (nloc == 0u) { xcd_barrier_complete(bar, b.x, nloc, nx); b.st[0] = nloc; b.st[1] = nx; }
        const unsigned old = xb_add(&bar[XB_XSUB(b.x)], 1u);
        const unsigned gen = old / nloc;
        if (old + 1u == (gen + 1u) * nloc) {
            __builtin_amdgcn_fence(__ATOMIC_RELEASE, "agent");
            asm volatile("s_waitcnt vmcnt(0)" ::: "memory");
            const unsigned og = xb_add(&bar[XB_TOP], 1u);
            const unsigned tg = og / nx;
            if (og + 1u == (tg + 1u) * nx) xb_add(&bar[XB_TOPGEN], 1u);
            else XB_SPIN(xb_ld(&bar[XB_TOPGEN]) == tg, bar);
            __builtin_amdgcn_fence(__ATOMIC_ACQUIRE, "agent");
            xb_add(&bar[XB_XGEN(b.x)], 1u);
            asm volatile("s_waitcnt vmcnt(0)" ::: "memory");
        } else {
            XB_SPIN(xb_ld(&bar[XB_XGEN(b.x)]) == gen, bar);
            __builtin_amdgcn_fence(__ATOMIC_ACQUIRE, "agent");
            asm volatile("s_waitcnt vmcnt(0)" ::: "memory");
        }
    }
    __syncthreads();
}

constexpr int LDS_BYTES = 147456;
struct Args { const float* in[14]; float* out; unsigned char* ws; int ph_lo, ph_hi; };

__global__ void __launch_bounds__(512, 2) hymba_fwd(Args args) {
    extern __shared__ __attribute__((aligned(16))) unsigned char lds_raw[];
    LAS unsigned char* lds = (LAS unsigned char*)lds_raw;
    cg::grid_group grid = cg::this_grid();
    const int tid = threadIdx.x, lane = tid & 63, wave = __builtin_amdgcn_readfirstlane(tid >> 6);
    const int G = gridDim.x, bx = blockIdx.x;
    unsigned char* ws = args.ws;
    const float* x = args.in[0]; const float* p_in = args.in[1]; const float* g_attn = args.in[2]; const float* w_in = args.in[3]; const float* g_idx = args.in[4];
    const float* w_out = args.in[5]; const float* g_ffn = args.in[6]; const float* w_gate = args.in[7]; const float* w_up = args.in[8]; const float* w_down = args.in[9];
    const float* g_ple = args.in[10]; const float* w_pg = args.in[11]; const float* w_pp = args.in[12]; const float* g_final = args.in[13];
    h16* Wt_in = (h16*)(ws + WS_WIN); h16* Wt_out = (h16*)(ws + WS_WOUT); h16* Wt_gu = (h16*)(ws + WS_WGU); h16* Wt_dn = (h16*)(ws + WS_WDN); h16* Wt_pg = (h16*)(ws + WS_WPG); h16* Wt_pp = (h16*)(ws + WS_WPP);
    float* rope = (float*)(ws + WS_ROPE); float* rs0 = (float*)(ws + WS_RS0); float* ssp1 = (float*)(ws + WS_SSP1); float* ssp2 = (float*)(ws + WS_SSP2); float* ssp3 = (float*)(ws + WS_SSP3);
    float* kmp = (float*)(ws + WS_KMP); float* WI = (float*)(ws + WS_WI);
    h16* PH = (h16*)(ws + WS_PH); h16* PP = (h16*)(ws + WS_PP); h16* XH = (h16*)(ws + WS_XH); h16* H1 = XH; h16* H3 = XH; h16* Y = (h16*)(ws + WS_Y); h16* H2 = Y;
    h16* QA = (h16*)(ws + WS_QA); h16* KA = (h16*)(ws + WS_KA); h16* VA = (h16*)(ws + WS_VA); h16* QI = (h16*)(ws + WS_QI); h16* KI = (h16*)(ws + WS_KI);
    h16* QB = (h16*)(ws + WS_QB); h16* KB = (h16*)(ws + WS_KB); h16* VB = (h16*)(ws + WS_VB); h16* ACT = (h16*)(ws + WS_ACT);
    const int lo = args.ph_lo, hi_ph = args.ph_hi;
#ifndef PH_MASK
#define PH_MASK 0xff
#endif
#define IN(k) (((PH_MASK >> (k)) & 1) && lo <= (k) && (k) < hi_ph)
    volatile LAS unsigned* MISC = (volatile LAS unsigned*)(lds + LDS_BYTES - 256);
    unsigned* barw = (unsigned*)(ws + 0);
    XcdBarrier xbar; xbar.bar = barw; xbar.x = 0; xbar.st = MISC;
#define SEAM(k) do { if (IN(k) && IN((k) + 1)) xcd_barrier(xbar); } while (0)
    if (args.ph_lo < 0) grid.sync();
    if (tid == 0) { MISC[0] = 0u; MISC[1] = 0u; }
    __syncthreads();
    xbar = xcd_barrier_post(barw, MISC);
#ifdef PROBE_PH
    unsigned long long pr_t0 = 0ull, pr_dt = 0ull;
#define PR_BEGIN(k) do { if ((k) == PROBE_PH) pr_t0 = __builtin_amdgcn_s_memrealtime(); } while (0)
#define PR_END(k) do { if ((k) == PROBE_PH) pr_dt = __builtin_amdgcn_s_memrealtime() - pr_t0; } while (0)
#else
#define PR_BEGIN(k) do {} while (0)
#define PR_END(k) do {} while (0)
#endif
    PR_BEGIN(0);
    if (IN(0)) for (int rep_ph = 0; rep_ph < 1 + (REPMASK & 1); ++rep_ph) {
        LAS float* scr = (LAS float*)(lds + wave * 16384);
        const int gw = bx * 8 + wave, NGW = G * 8;
        transpose_items(DM, NIN_SRC, Wt_in, NIN, [=](int np) -> const float* { const int c = win_colmap(np); return c >= 0 ? w_in + c : nullptr; }, g_attn, scr, gw, NGW, lane);
        transpose_items(DM, DM, Wt_out, DM, [=](int np) -> const float* { return w_out + np; }, nullptr, scr, gw, NGW, lane);
        transpose_items(DM, DFF, Wt_gu, 2 * DFF, [=](int np) -> const float* { const int p = np & 255, t = np >> 8; return (p < 128) ? (w_gate + t * 128 + p) : (w_up + t * 128 + p - 128); }, g_ffn, scr, gw, NGW, lane);
        transpose_items(DFF, DM, Wt_dn, DM, [=](int np) -> const float* { return w_down + np; }, nullptr, scr, gw, NGW, lane);
        transpose_items(DM, DM, Wt_pg, DM, [=](int np) -> const float* { return w_pg + np; }, g_ple, scr, gw, NGW, lane);
        transpose_items(DPLE, DM, Wt_pp, DM, [=](int np) -> const float* { return w_pp + np; }, nullptr, scr, gw, NGW, lane);
        for (int m0 = 2 * gw; m0 < NTOK; m0 += 2 * NGW) {
            f32x4 v[2][4]; float s[2];
#pragma unroll
            for (int r2 = 0; r2 < 2; ++r2) { const f32x4* xr = (const f32x4*)(x + (size_t)(m0 + r2) * DM) + lane;
#pragma unroll
                for (int jj = 0; jj < 4; ++jj) v[r2][jj] = __builtin_nontemporal_load(xr + 64 * jj); }
#pragma unroll
            for (int r2 = 0; r2 < 2; ++r2) { float t = 0.f;
#pragma unroll
                for (int jj = 0; jj < 4; ++jj) t += (v[r2][jj].x * v[r2][jj].x + v[r2][jj].y * v[r2][jj].y) + (v[r2][jj].z * v[r2][jj].z + v[r2][jj].w * v[r2][jj].w);
                s[r2] = wave_sum(t); }
#pragma unroll
            for (int r2 = 0; r2 < 2; ++r2) {
                if (lane == 0) rs0[m0 + r2] = 1.0f / sqrtf(s[r2] * (1.0f / DM) + EPS);
                u32x2* o8 = (u32x2*)(XH + (size_t)(m0 + r2) * DM) + lane;
#pragma unroll
                for (int jj = 0; jj < 4; ++jj) { u32x2 w; w.x = pkh(v[r2][jj].x, v[r2][jj].y); w.y = pkh(v[r2][jj].z, v[r2][jj].w); o8[64 * jj] = w; } }
        }
        for (int m0 = 4 * gw; m0 < NTOK; m0 += 4 * NGW) {
            f32x4 v[4];
#pragma unroll
            for (int r4 = 0; r4 < 4; ++r4) v[r4] = __builtin_nontemporal_load((const f32x4*)(p_in + (size_t)(m0 + r4) * DPLE) + lane);
#pragma unroll
            for (int r4 = 0; r4 < 4; ++r4) { u32x2 w; w.x = pkh(v[r4].x, v[r4].y); w.y = pkh(v[r4].z, v[r4].w); *((u32x2*)(PH + (size_t)(m0 + r4) * DPLE) + lane) = w; }
        }
        for (int i = bx * 512 + tid; i < SEQ * 32; i += G * 512) {
            const int pos = i >> 5, jx = i & 31;
            const float inv = ROPE_INV[jx];
            const float ang = (float)pos * inv;
            const double a = (double)ang; const double kq = __builtin_rint(a * 0.15915494309189535);
            double r = __builtin_fma(-kq, 6.283185307179586, a); r = __builtin_fma(-kq, 2.4492935982947064e-16, r);
            const double r2 = r * r; double sn = 0.0, cs = 0.0;
            double ts = 1.0, tc = 1.0;
#pragma unroll
            for (int n = 13; n >= 1; --n) { ts = 1.0 - ts * r2 / (double)((2 * n) * (2 * n + 1)); tc = 1.0 - tc * r2 / (double)((2 * n - 1) * (2 * n)); }
            sn = r * ts; cs = tc;
            rope[(size_t)i * 2] = (float)cs; rope[(size_t)i * 2 + 1] = (float)sn;
        }
    }
    SEAM(0);
    PR_END(0);
    PR_BEGIN(1);
    if (IN(1)) for (int rep_ph = 0; rep_ph < 1 + ((REPMASK >> 1) & 1); ++rep_ph) {
        { pg8::Gemm g{XH, Wt_in, NTOK, NIN, DM}; pg8::StaticOrder S; S.init(NTOK, NIN, G, bx);
          pg8::EpiInProj E{rs0, rope, g_idx, QA, KA, VA, QI, KI, QB, KB, VB, WI, kmp};
          pg8::gemm_phase(lds, g, S, E); }
        { pg8::Gemm g{PH, Wt_pp, NTOK, DM, DPLE}; pg8::StaticOrder S; S.init(NTOK, DM, G, bx);
          pg8::EpiPlain E{PP, DM};
          pg8::gemm_phase(lds, g, S, E); }
    }
    SEAM(1);
    PR_END(1);
    PR_BEGIN(2);
    if (IN(2)) {
        AttnPtrs P{QA, KA, VA, QI, KI, QB, KB, VB, WI, kmp, Y};
        const int b = bx & 7, r = bx >> 3;
        const int nr = G >> 3;
#ifndef NO_DSA
        for (int rep = 0; rep < REP_DSA; ++rep)
        for (int s = r; s < 128; s += nr) { dsa_unit2(lds, P, b, s, wave); dsa_unit2(lds, P, b, 255 - s, wave); }
#endif
#ifndef NO_MOBA
        for (int rep = 0; rep < REP_MOBA; ++rep)
        for (int uu = r; uu < 64; uu += nr) { const int h = uu >> 3, s = uu & 7; moba_unit_fast((char*)lds_raw, lds, P, b, h, s, wave); moba_unit_fast((char*)lds_raw, lds, P, b, h, 15 - s, wave); }
#endif
    }
    SEAM(2);
    PR_END(2);
    PR_BEGIN(3);
    if (IN(3)) for (int rep_ph = 0; rep_ph < 1 + ((REPMASK >> 3) & 1); ++rep_ph) {
        pg8::Gemm g{Y, Wt_out, NTOK, DM, DM}; pg8::StaticOrder S; S.init(NTOK, DM, G, bx);
        pg8::EpiRes<false> E{XH, H1, ssp1};
        pg8::gemm_phase(lds, g, S, E);
    }
    SEAM(3);
    PR_END(3);
    PR_BEGIN(4);
    if (IN(4)) for (int rep_ph = 0; rep_ph < 1 + ((REPMASK >> 4) & 1); ++rep_ph) {
        pg8::Gemm g{H1, Wt_gu, NTOK, 2 * DFF, DM}; pg8::StaticOrder S; S.init(NTOK, 2 * DFF, G, bx);
        pg8::EpiSwiGLU E{ssp1, ACT};
        pg8::gemm_phase(lds, g, S, E);
    }
    SEAM(4);
    PR_END(4);
    PR_BEGIN(5);
    if (IN(5)) for (int rep_ph = 0; rep_ph < 1 + ((REPMASK >> 5) & 1); ++rep_ph) {
        pg8::Gemm g{ACT, Wt_dn, NTOK, DM, DFF}; pg8::StaticOrder S; S.init(NTOK, DM, G, bx);
        pg8::EpiRes<false> E{H1, H2, ssp2};
        pg8::gemm_phase(lds, g, S, E);
    }
    SEAM(5);
    PR_END(5);
    PR_BEGIN(6);
    if (IN(6)) for (int rep_ph = 0; rep_ph < 1 + ((REPMASK >> 6) & 1); ++rep_ph) {
        pg8::Gemm g{H2, Wt_pg, NTOK, DM, DM}; pg8::StaticOrder S; S.init(NTOK, DM, G, bx);
        pg8::EpiPLE E{ssp2, H2, PP, H3, ssp3};
        pg8::gemm_phase(lds, g, S, E);
    }
    SEAM(6);
    PR_END(6);
    PR_BEGIN(7);
    if (IN(7)) {
        const int gw = bx * 8 + wave, NGW = G * 8;
        f32x4 gf[2][2];
#pragma unroll
        for (int hh = 0; hh < 2; ++hh) { gf[hh][0] = *(const f32x4*)(g_final + 512 * hh + 8 * lane); gf[hh][1] = *(const f32x4*)(g_final + 512 * hh + 8 * lane + 4); }
        for (int m = gw; m < NTOK; m += NGW) {
            const float s = pg8::row_rstd(ssp3, m);
#pragma unroll
            for (int hh = 0; hh < 2; ++hh) {
                const h16x8 hv = *(const h16x8*)(H3 + (size_t)m * DM + 512 * hh + 8 * lane);
                float* o = args.out + (size_t)m * DM + 512 * hh + 8 * lane;
                f32x4 v0 = {(float)hv[0], (float)hv[1], (float)hv[2], (float)hv[3]}, v1 = {(float)hv[4], (float)hv[5], (float)hv[6], (float)hv[7]};
                v0 = v0 * s * gf[hh][0]; v1 = v1 * s * gf[hh][1];
                *(f32x4*)o = v0; *(f32x4*)(o + 4) = v1;
            }
        }
    }
    PR_END(7);
#ifdef PROBE_PH
    if (bx == 0 && wave == 0) { const unsigned long long te = __builtin_amdgcn_s_memrealtime(); while (__builtin_amdgcn_s_memrealtime() - te < (unsigned long long)PROBE_MULT * pr_dt) __builtin_amdgcn_s_sleep(8); }
#endif
#undef IN
#undef SEAM
}

extern "C" void kernel_launch(void* const* d_in, const int* in_sizes, int n_in, void* d_out, int out_size, void* d_ws, size_t ws_size, hipStream_t stream) {
    static int grid = 0;
    if (grid == 0) {
        if (n_in != 14 || out_size != NTOK * DM || ws_size < WS_END) { fprintf(stderr, "kernel_launch: unexpected shapes (n_in %d out %d ws %zu)\n", n_in, out_size, ws_size); grid = -1; return; }
        int dev = 0, cus = 0, per_cu = 0;
        (void)hipGetDevice(&dev);
        (void)hipDeviceGetAttribute(&cus, hipDeviceAttributeMultiprocessorCount, dev);
        (void)hipFuncSetAttribute((const void*)hymba_fwd, hipFuncAttributeMaxDynamicSharedMemorySize, LDS_BYTES);
        (void)hipOccupancyMaxActiveBlocksPerMultiprocessor(&per_cu, (const void*)hymba_fwd, 512, LDS_BYTES);
        if (per_cu < 1) { fprintf(stderr, "kernel_launch: occupancy query says %d blocks/CU\n", per_cu); }
        grid = cus;
        if (grid % 8 != 0 || grid > 256) grid = (grid / 8) * 8 > 256 ? 256 : (grid / 8) * 8;
    }
    if (grid <= 0) return;
    (void)hipMemsetAsync(d_ws, 0, 16384, stream);
    Args a{};
    for (int i = 0; i < 14; ++i) a.in[i] = (const float*)d_in[i];
    a.out = (float*)d_out; a.ws = (unsigned char*)d_ws;
#if MK_COOP
    a.ph_lo = 0; a.ph_hi = 8;
    void* kargs[] = {&a};
    hipError_t e = hipLaunchCooperativeKernel((const void*)hymba_fwd, dim3(grid), dim3(512), kargs, LDS_BYTES, stream);
    if (e != hipSuccess) fprintf(stderr, "cooperative launch failed: %s (grid %d)\n", hipGetErrorString(e), grid);
#else
    for (int ph = 0; ph < 8; ++ph) { a.ph_lo = ph; a.ph_hi = ph + 1; hipLaunchKernelGGL(hymba_fwd, dim3(grid), dim3(512), LDS_BYTES, stream, a); }
#endif
}
```
